# Optimizing an MI355X kernel written in HIP

```python
import jax, jax.numpy as jnp
from jax import lax
import numpy as np

D_MODEL = 1024
BATCH = 2
SEQ = 8192
DEPTH = 1

HEAD_DIM = 64
N_RWKV_HEADS = 8
RWKV_WIDTH = N_RWKV_HEADS * HEAD_DIM
DECAY_LORA = 64
AAA_LORA = 64
GATE_LORA = 128
GN_EPS = 64e-5
N_Q_HEADS = 8
N_KV_HEADS = 2
Q_PER_KV = N_Q_HEADS // N_KV_HEADS
ATTN_WIDTH = N_Q_HEADS * HEAD_DIM
KV_WIDTH = N_KV_HEADS * HEAD_DIM
WINDOW = 128
BLOCK = 128
RWKV_COLS = 3 * RWKV_WIDTH + DECAY_LORA + AAA_LORA + GATE_LORA
ATTN_COLS = ATTN_WIDTH + 2 * KV_WIDTH
IN_COLS = RWKV_COLS + ATTN_COLS
MIX_WIDTH = RWKV_WIDTH + ATTN_WIDTH
D_FF = 2816
NORM_EPS = 1e-5

kernel_name = 'hymba_rwkv7_swa_sink_macaron'


def rms_norm(x, g):
    xf = x.astype(jnp.float32)
    y = xf * lax.rsqrt(jnp.mean(xf * xf, axis=-1, keepdims=True) + NORM_EPS)
    return (y * g.astype(jnp.float32)).astype(x.dtype)


def swiglu(x, w_gate, w_up, w_down):
    return (jax.nn.silu(x @ w_gate) * (x @ w_up)) @ w_down


def rwkv7_time_mix(p, shift_mix, w0, w2, a0, a2, g2, k_k, k_a, r_k, ln_w, ln_b):
    f32 = jnp.float32
    B, S, _ = p.shape
    H, N = N_RWKV_HEADS, HEAD_DIM
    p = p.astype(f32)
    p_prev = jnp.pad(p, ((0, 0), (1, 0), (0, 0)))[:, :-1]
    p = p + (p_prev - p) * shift_mix.astype(f32)
    cuts = [RWKV_WIDTH, 2 * RWKV_WIDTH, 3 * RWKV_WIDTH,
            3 * RWKV_WIDTH + DECAY_LORA, 3 * RWKV_WIDTH + DECAY_LORA + AAA_LORA]
    r, k, v, w_lo, a_lo, g_lo = jnp.split(p, cuts, axis=-1)
    w = -jax.nn.softplus(-(w0.astype(f32) + jnp.tanh(w_lo) @ w2.astype(f32))) - 0.5
    a = jax.nn.sigmoid(a0.astype(f32) + a_lo @ a2.astype(f32))
    g = jax.nn.sigmoid(g_lo) @ g2.astype(f32)
    kk = (k * k_k.astype(f32)).reshape(B, S, H, N)
    kk = kk / jnp.maximum(jnp.sqrt(jnp.sum(kk * kk, axis=-1, keepdims=True)), 1e-12)
    k = k * (1.0 + (a - 1.0) * k_a.astype(f32))
    rh, kh, vh, ah = [t.reshape(B, S, H, N) for t in (r, k, v, a)]
    decay = jnp.exp(-jnp.exp(w)).reshape(B, S, H, N)
    bh = kk * ah

    def step(state, inp):
        r_t, w_t, k_t, v_t, kk_t, b_t = inp
        sa = jnp.einsum('bhvk,bhk->bhv', state, -kk_t)
        state = (state * w_t[:, :, None, :] + sa[..., None] * b_t[:, :, None, :]
                 + v_t[..., None] * k_t[:, :, None, :])
        return state, jnp.einsum('bhvk,bhk->bhv', state, r_t)

    seq_first = lambda t: jnp.moveaxis(t, 1, 0)
    s0 = jnp.zeros((B, H, N, N), f32)
    _, o = lax.scan(step, s0, tuple(seq_first(t) for t in (rh, decay, kh, vh, kk, bh)))
    o = jnp.moveaxis(o, 0, 1)
    mu = jnp.mean(o, axis=-1, keepdims=True)
    var = jnp.mean(jnp.square(o - mu), axis=-1, keepdims=True)
    o = ((o - mu) * lax.rsqrt(var + GN_EPS)).reshape(B, S, RWKV_WIDTH)
    o = o * ln_w.astype(f32) + ln_b.astype(f32)
    bonus = jnp.sum(rh * kh * r_k.astype(f32), axis=-1, keepdims=True) * vh
    return (o + bonus.reshape(B, S, RWKV_WIDTH)) * g


def sliding_window_sink_attention(q, k, v, sinks):
    f32 = jnp.float32
    B, S, _ = q.shape
    nb = S // BLOCK
    qb = q.astype(f32).reshape(B, nb, BLOCK, N_KV_HEADS, Q_PER_KV, HEAD_DIM)
    kb = k.astype(f32).reshape(B, nb, BLOCK, N_KV_HEADS, HEAD_DIM)
    vb = v.astype(f32).reshape(B, nb, BLOCK, N_KV_HEADS, HEAD_DIM)

    def with_prev_block(t):
        prev = jnp.pad(t, ((0, 0), (1, 0), (0, 0), (0, 0), (0, 0)))[:, :-1]
        return jnp.concatenate([prev, t], axis=2)

    kb, vb = with_prev_block(kb), with_prev_block(vb)
    scores = jnp.einsum('bnqhgd,bnkhd->bnhgqk', qb, kb) * (HEAD_DIM ** -0.5)
    qi = jnp.arange(BLOCK)[:, None]
    kj = jnp.arange(2 * BLOCK)[None, :]
    dist = qi + BLOCK - kj
    band = (dist >= 0) & (dist < WINDOW)
    valid = band[None] & ((jnp.arange(nb)[:, None, None] > 0) | (kj[None] >= BLOCK))
    scores = jnp.where(valid[None, :, None, None], scores, -jnp.inf)
    sink = jnp.broadcast_to(sinks.astype(f32).reshape(N_KV_HEADS, Q_PER_KV, 1, 1),
                            scores.shape[:-1] + (1,))
    probs = jax.nn.softmax(jnp.concatenate([scores, sink], axis=-1), axis=-1)[..., :-1]
    out = jnp.einsum('bnhgqk,bnkhd->bnqhgd', probs, vb)
    return out.reshape(B, S, ATTN_WIDTH)


def setup_inputs(seed: int = 0) -> dict:
    key = jax.random.key(seed)
    ks = jax.random.split(key, 26)
    L, D, F, R = DEPTH, D_MODEL, D_FF, RWKV_WIDTH
    nrm = lambda i, shape, scale: scale * jax.random.normal(ks[i], shape, jnp.float32)
    chan = jnp.arange(R, dtype=jnp.float32) / (R - 1)
    w0_base = -5.5 + 5.0 * chan ** 0.85
    return {
        'x': nrm(0, (BATCH, SEQ, D), 1.0),
        'norm_ffn1': 1.0 + nrm(1, (L, D), 0.01),
        'ffn1_gate': nrm(2, (L, D, F), D ** -0.5),
        'ffn1_up': nrm(3, (L, D, F), D ** -0.5),
        'ffn1_down': nrm(4, (L, F, D), F ** -0.5),
        'norm_mix': 1.0 + nrm(5, (L, D), 0.01),
        'w_in': nrm(6, (L, D, IN_COLS), D ** -0.5),
        'b_in_attn': nrm(7, (L, ATTN_COLS), 0.01),
        'rwkv_shift_mix': jax.random.uniform(ks[8], (L, RWKV_COLS), jnp.float32),
        'rwkv_w0': w0_base[None, :] + nrm(9, (L, R), 0.1),
        'rwkv_w2': nrm(10, (L, DECAY_LORA, R), 0.1 * DECAY_LORA ** -0.5),
        'rwkv_a0': nrm(11, (L, R), 0.1),
        'rwkv_a2': nrm(12, (L, AAA_LORA, R), AAA_LORA ** -0.5),
        'rwkv_g2': nrm(13, (L, GATE_LORA, R), GATE_LORA ** -0.5),
        'rwkv_k_k': 0.85 + nrm(14, (L, R), 0.05),
        'rwkv_k_a': 1.0 + nrm(15, (L, R), 0.05),
        'rwkv_r_k': nrm(16, (L, N_RWKV_HEADS, HEAD_DIM), 0.1),
        'rwkv_ln_w': 1.0 + nrm(17, (L, R), 0.01),
        'rwkv_ln_b': nrm(18, (L, R), 0.01),
        'attn_sinks': nrm(19, (L, N_Q_HEADS), 1.0),
        'w_out': nrm(20, (L, MIX_WIDTH, D), 0.5 * MIX_WIDTH ** -0.5),
        'norm_ffn2': 1.0 + nrm(21, (L, D), 0.01),
        'ffn2_gate': nrm(22, (L, D, F), D ** -0.5),
        'ffn2_up': nrm(23, (L, D, F), D ** -0.5),
        'ffn2_down': nrm(24, (L, F, D), F ** -0.5),
        'norm_final': 1.0 + nrm(25, (D,), 0.01),
    }


def reference(x, norm_ffn1, ffn1_gate, ffn1_up, ffn1_down, norm_mix, w_in, b_in_attn,
              rwkv_shift_mix, rwkv_w0, rwkv_w2, rwkv_a0, rwkv_a2, rwkv_g2, rwkv_k_k, rwkv_k_a,
              rwkv_r_k, rwkv_ln_w, rwkv_ln_b, attn_sinks, w_out, norm_ffn2, ffn2_gate, ffn2_up,
              ffn2_down, norm_final):
    for l in range(DEPTH):
        h = rms_norm(x, norm_ffn1[l])
        x = x + 0.5 * swiglu(h, ffn1_gate[l], ffn1_up[l], ffn1_down[l])
        h = rms_norm(x, norm_mix[l])
        p = h @ w_in[l]
        p_rwkv = p[..., :RWKV_COLS]
        p_attn = p[..., RWKV_COLS:] + b_in_attn[l]
        q, k, v = jnp.split(p_attn, [ATTN_WIDTH, ATTN_WIDTH + KV_WIDTH], axis=-1)
        o_rwkv = rwkv7_time_mix(p_rwkv, rwkv_shift_mix[l], rwkv_w0[l], rwkv_w2[l], rwkv_a0[l],
                                rwkv_a2[l], rwkv_g2[l], rwkv_k_k[l], rwkv_k_a[l], rwkv_r_k[l],
                                rwkv_ln_w[l], rwkv_ln_b[l])
        o_attn = sliding_window_sink_attention(q, k, v, attn_sinks[l])
        mixed = jnp.concatenate([o_rwkv.astype(x.dtype), o_attn.astype(x.dtype)], axis=-1)
        x = x + mixed @ w_out[l]
        h = rms_norm(x, norm_ffn2[l])
        x = x + 0.5 * swiglu(h, ffn2_gate[l], ffn2_up[l], ffn2_down[l])
    return rms_norm(x, norm_final)
```

```cpp
#include <hip/hip_runtime.h>
#include <hip/hip_cooperative_groups.h>
#include <cstdio>
#include <cstdint>
namespace cg = cooperative_groups;
namespace pg8 {
#define PG8_LAS __attribute__((address_space(3)))
typedef unsigned short bf16_t;
typedef short bf16x8 __attribute__((ext_vector_type(8)));
typedef float f32x4 __attribute__((ext_vector_type(4)));
typedef unsigned u32x4 __attribute__((ext_vector_type(4)));
constexpr int BM = 256, BK = 64, HALF = 128, HTB = HALF * BK * 2  , STAGE_BYTES = 8 * HTB, NXCD = 8, WGM = 8;

__host__ __device__ __forceinline__ int lds_byte(int r, int c) { const int st = (r >> 4) * 2 + (c >> 5), rr = r & 15, cc = c & 31, ob = rr * 64 + cc * 2; return st * 1024 + (ob ^ (((ob >> 9) & 1) << 5)); }
__host__ __device__ __forceinline__ void stage_rc(int b, int& R, int& C) { const int st = b / 1024, sb = b % 1024, swz = sb ^ (((sb >> 9) & 1) << 5); R = (st >> 1) * 16 + swz / 64; C = (st & 1) * 32 + (swz % 64) / 2; }
__host__ __device__ __forceinline__ int perm32(int rho) { const int n = rho >> 4, i = rho & 15; return 8 * (i >> 2) + 4 * n + (i & 3); }

struct Unit { int pm, pn; };
struct Gemm { const bf16_t* A; const bf16_t* Bt; int M, N, K; };

struct StaticOrder {
    int nM, nN, nwg, G, c;
    __host__ __device__ void init(int M, int N, int G_, int c_) { nM = M / BM; nN = N / BM; nwg = nM * nN; G = G_; c = c_; }
    __host__ __device__ bool next(int i, Unit& u) const {
        const long L = (long)i * G + c; if (L >= nwg) return false;
        int wgid = (int)L; { const int q = nwg / NXCD, r = nwg % NXCD, xcd = wgid % NXCD, off = wgid / NXCD; wgid = (xcd < r ? xcd * (q + 1) : r * (q + 1) + (xcd - r) * q) + off; }
        const int nig = WGM * nN, gid = wgid / nig, fm = gid * WGM, gsz = (nM - fm) < WGM ? (nM - fm) : WGM;
        u.pm = fm + ((wgid % nig) % gsz); u.pn = (wgid % nig) / gsz; return true;
    }
    __device__ __forceinline__ void a_ready(const Unit&) const {}
    __device__ __forceinline__ void done(const Unit&) const {}
};

typedef float f32x2 __attribute__((ext_vector_type(2)));
typedef __bf16 bf16x2_t __attribute__((ext_vector_type(2)));
typedef unsigned u32x2 __attribute__((ext_vector_type(2)));
__device__ __forceinline__ unsigned cvt_pk_bf16(float lo, float hi) { f32x2 v = {lo, hi}; bf16x2_t b = __builtin_convertvector(v, bf16x2_t); return __builtin_bit_cast(unsigned, b); }
__device__ __forceinline__ float row_rstd(const float* ss, int row) {
    const f32x4* p = (const f32x4*)(ss + (size_t)row * 16); const f32x4 a = p[0], b = p[1], c = p[2], d = p[3];
    const float s = (((a[0] + a[1]) + (a[2] + a[3])) + ((b[0] + b[1]) + (b[2] + b[3]))) + (((c[0] + c[1]) + (c[2] + c[3])) + ((d[0] + d[1]) + (d[2] + d[3])));
    return 1.0f / sqrtf(s * (1.0f / 1024.0f) + 1e-5f);
}
__device__ __forceinline__ float silu_mul(float g, float u) { return g * __builtin_amdgcn_rcpf(1.0f + __expf(-g)) * u; }

struct EpiSwiGLU {
    static constexpr bool PERM = true, AFTER_DRAIN = false;
    bf16_t* O; const float* ss; int ldo;
    __device__ __forceinline__ void operator()(const f32x4 (&acc)[2][2][4][2], const Unit& u, int wr, int wc, int fr, int fq) const {
        const int row0 = u.pm * BM + wr * 64 + fr; const int col0 = u.pn * HALF + wc * 32 + 8 * fq;
#pragma unroll
        for (int ai = 0; ai < 2; ++ai)
#pragma unroll
            for (int m = 0; m < 4; ++m) { const int row = row0 + ai * HALF + m * 16; const float rs = row_rstd(ss, row);
                const f32x4 g0 = acc[ai][0][m][0] * rs, g1 = acc[ai][0][m][1] * rs, u0 = acc[ai][1][m][0] * rs, u1 = acc[ai][1][m][1] * rs;
                u32x4 w; w.x = cvt_pk_bf16(silu_mul(g0[0], u0[0]), silu_mul(g0[1], u0[1])); w.y = cvt_pk_bf16(silu_mul(g0[2], u0[2]), silu_mul(g0[3], u0[3]));
                w.z = cvt_pk_bf16(silu_mul(g1[0], u1[0]), silu_mul(g1[1], u1[1])); w.w = cvt_pk_bf16(silu_mul(g1[2], u1[2]), silu_mul(g1[3], u1[3]));
                *(u32x4*)(O + (size_t)row * ldo + col0) = w; }
    }
};
struct EpiRes {
    static constexpr bool PERM = false, AFTER_DRAIN = false;
    const float* base; float* out; bf16_t* xb; float* ss; float alpha;
    __device__ __forceinline__ void operator()(const f32x4 (&acc)[2][2][4][2], const Unit& u, int wr, int wc, int fr, int fq) const {
        const int row0 = u.pm * BM + wr * 64 + fr; const int col0 = u.pn * BM + wc * 32 + 4 * fq;
#pragma unroll
        for (int ai = 0; ai < 2; ++ai)
#pragma unroll
            for (int m = 0; m < 4; ++m) { const int row = row0 + ai * HALF + m * 16; const size_t off = (size_t)row * 1024 + col0; float sq = 0.f;
#pragma unroll
                for (int bj = 0; bj < 2; ++bj)
#pragma unroll
                    for (int n = 0; n < 2; ++n) { const f32x4 bs = *(const f32x4*)(base + off + bj * HALF + n * 16); const f32x4 o = bs + acc[ai][bj][m][n] * alpha;
                        *(f32x4*)(out + off + bj * HALF + n * 16) = o; sq += (o[0] * o[0] + o[1] * o[1]) + (o[2] * o[2] + o[3] * o[3]);
                        if (xb) { u32x2 w; w.x = cvt_pk_bf16(o[0], o[1]); w.y = cvt_pk_bf16(o[2], o[3]); *(u32x2*)(xb + off + bj * HALF + n * 16) = w; } }
                sq += __shfl_xor(sq, 16); sq += __shfl_xor(sq, 32);
                if (fq == 0) ss[(size_t)row * 16 + u.pn * 4 + wc] = sq; }
    }
};
struct EpiWin {
    static constexpr bool PERM = true, AFTER_DRAIN = false;
    bf16_t* O; const float* ss; const float* bias; int bias_from; int ldo;
    __device__ __forceinline__ void operator()(const f32x4 (&acc)[2][2][4][2], const Unit& u, int wr, int wc, int fr, int fq) const {
        const int row0 = u.pm * BM + wr * 64 + fr; const int col0 = u.pn * BM + wc * 32 + 8 * fq;
        f32x4 bv[2][2];
#pragma unroll
        for (int bj = 0; bj < 2; ++bj)
#pragma unroll
            for (int n = 0; n < 2; ++n) { const int c = col0 + bj * HALF + 4 * n; bv[bj][n] = (c >= bias_from) ? *(const f32x4*)(bias + (c - bias_from)) : (f32x4){0.f, 0.f, 0.f, 0.f}; }
#pragma unroll
        for (int ai = 0; ai < 2; ++ai)
#pragma unroll
            for (int m = 0; m < 4; ++m) { const int row = row0 + ai * HALF + m * 16; const float rs = row_rstd(ss, row);
#pragma unroll
                for (int bj = 0; bj < 2; ++bj) { const f32x4 v0 = acc[ai][bj][m][0] * rs + bv[bj][0], v1 = acc[ai][bj][m][1] * rs + bv[bj][1];
                    u32x4 w; w.x = cvt_pk_bf16(v0[0], v0[1]); w.y = cvt_pk_bf16(v0[2], v0[3]); w.z = cvt_pk_bf16(v1[0], v1[1]); w.w = cvt_pk_bf16(v1[2], v1[3]);
                    *(u32x4*)(O + (size_t)row * ldo + col0 + bj * HALF) = w; } }
    }
};
struct EpiLora {
    static constexpr bool PERM = true, AFTER_DRAIN = false;
    float* DEC; bf16_t* AA; bf16_t* GG; const float* w0; const float* a0;
    __device__ __forceinline__ void operator()(const f32x4 (&acc)[2][2][4][2], const Unit& u, int wr, int wc, int fr, int fq) const {
        const int row0 = u.pm * BM + wr * 64 + fr; const int kind = u.pn >> 1; const int col0 = (u.pn & 1) * BM + wc * 32 + 8 * fq;
#pragma unroll
        for (int bj = 0; bj < 2; ++bj) { const int c = col0 + bj * HALF;
            f32x4 b0 = (f32x4){0.f, 0.f, 0.f, 0.f}, b1 = b0;
            if (kind == 0) { b0 = *(const f32x4*)(w0 + c); b1 = *(const f32x4*)(w0 + c + 4); } else if (kind == 1) { b0 = *(const f32x4*)(a0 + c); b1 = *(const f32x4*)(a0 + c + 4); }
#pragma unroll
            for (int ai = 0; ai < 2; ++ai)
#pragma unroll
                for (int m = 0; m < 4; ++m) { const int row = row0 + ai * HALF + m * 16; f32x4 v0 = acc[ai][bj][m][0] + b0, v1 = acc[ai][bj][m][1] + b1;
                    if (kind == 0) {
#pragma unroll
                        for (int e = 0; e < 4; ++e) { v0[e] = expf(-0.60653065971f / (1.0f + expf(-v0[e]))); v1[e] = expf(-0.60653065971f / (1.0f + expf(-v1[e]))); }
                        *(f32x4*)(DEC + (size_t)row * 512 + c) = v0; *(f32x4*)(DEC + (size_t)row * 512 + c + 4) = v1;
                    } else {
                        if (kind == 1) {
#pragma unroll
                            for (int e = 0; e < 4; ++e) { v0[e] = 1.0f / (1.0f + expf(-v0[e])); v1[e] = 1.0f / (1.0f + expf(-v1[e])); } }
                        u32x4 w; w.x = cvt_pk_bf16(v0[0], v0[1]); w.y = cvt_pk_bf16(v0[2], v0[3]); w.z = cvt_pk_bf16(v1[0], v1[1]); w.w = cvt_pk_bf16(v1[2], v1[3]);
                        *(u32x4*)((kind == 1 ? AA : GG) + (size_t)row * 512 + c) = w; } }
        }
    }
};

template <class Epi, class Sched, bool ALIGN_EPI = false, bool SP2 = false>
__device__ __forceinline__ void gemm_phase(PG8_LAS unsigned char* lds, const Gemm g, const Sched& S, const Epi& E, const int wid) {
    const int lane = (int)__builtin_amdgcn_mbcnt_hi(~0u, __builtin_amdgcn_mbcnt_lo(~0u, 0u)), tid = (wid << 6) | lane, wr = wid >> 2, wc = wid & 3, fr = lane & 15, fq = lane >> 4;
    int K = g.K; asm volatile("" : "+s"(K)); const int nt = K / BK;
    unsigned voffA[2], voffB[2];
#pragma unroll
    for (int i = 0; i < 2; ++i) { int R, C; stage_rc(tid * 16 + i * 8192, R, C); const int Rb = Epi::PERM ? ((R & ~31) + perm32(R & 31)) : R;
        voffA[i] = (unsigned)(R * K + C) * 2u; voffB[i] = (unsigned)(Rb * K + C) * 2u; }
    const size_t kstep = (size_t)(BK * 2);
    const size_t hstep = (size_t)HALF * K * 2;
    const size_t tstep = 2 * hstep;
    const unsigned ldsw = (unsigned)wid * 1024u;
    const int aoff = lds_byte(wr * 64 + fr, fq * 8), boff = lds_byte(wc * 32 + fr, fq * 8);
#define PG8_SA(b, h) (((b) * 2 + (h)) * HTB)
#define PG8_SB(b, h) ((4 + (b) * 2 + (h)) * HTB)
#define PG8_STAGE(bufoff, gbase, voff) do { _Pragma("unroll") for (int _i = 0; _i < 2; ++_i) \
        __builtin_amdgcn_global_load_lds((const unsigned*)((const char*)(gbase) + (voff)[_i]), (PG8_LAS unsigned*)(lds + (bufoff) + ldsw + _i * 8192), 16, 0, 0); } while (0)
#define PG8_LDA(dst, b, h) do { _Pragma("unroll") for (int m = 0; m < 4; ++m) _Pragma("unroll") for (int k = 0; k < 2; ++k) dst[m][k] = *(const PG8_LAS bf16x8*)(lds + PG8_SA(b, h) + aoff + m * 2048 + k * 1024); } while (0)
#define PG8_LDB(dst, b, h) do { _Pragma("unroll") for (int n = 0; n < 2; ++n) _Pragma("unroll") for (int k = 0; k < 2; ++k) dst[n][k] = *(const PG8_LAS bf16x8*)(lds + PG8_SB(b, h) + boff + n * 2048 + k * 1024); } while (0)
#define PG8_MMA(ai, bj, At, Bt) do { __builtin_amdgcn_s_setprio(1); _Pragma("unroll") for (int m = 0; m < 4; ++m) _Pragma("unroll") for (int n = 0; n < 2; ++n) _Pragma("unroll") for (int k = 0; k < 2; ++k) \
        acc[ai][bj][m][n] = __builtin_amdgcn_mfma_f32_16x16x32_bf16(Bt[n][k], At[m][k], acc[ai][bj][m][n], 0, 0, 0); __builtin_amdgcn_s_setprio(0); } while (0)
#define PG8_WAIT_V(n) asm volatile("s_waitcnt vmcnt(" #n ")" ::: "memory")
#define PG8_WAIT_L(n) asm volatile("s_waitcnt lgkmcnt(" #n ")" ::: "memory")
#define PG8_BAR __builtin_amdgcn_s_barrier()
#define PG8_SCHED __builtin_amdgcn_sched_barrier(0)
    Unit cur, nxt; int ui = 0;
    if (!S.next(0, cur)) return;
    f32x4 acc[2][2][4][2];
#pragma unroll
    for (int a = 0; a < 2; ++a)
#pragma unroll
        for (int b = 0; b < 2; ++b)
#pragma unroll
            for (int m = 0; m < 4; ++m)
#pragma unroll
                for (int n = 0; n < 2; ++n) acc[a][b][m][n] = (f32x4){0.f, 0.f, 0.f, 0.f};
    bf16x8 At[4][2], B0[2][2], B1[2][2];
    const char* cA = (const char*)g.A + (size_t)cur.pm * tstep; const char* cB = (const char*)g.Bt + (size_t)cur.pn * tstep;
    S.a_ready(cur);
    if constexpr (SP2) {
        PG8_STAGE(PG8_SB(0, 0), cB, voffB); PG8_STAGE(PG8_SB(0, 1), cB + hstep, voffB); PG8_STAGE(PG8_SA(0, 0), cA, voffA); PG8_STAGE(PG8_SA(0, 1), cA + hstep, voffA);
        if (wr == 1) PG8_BAR;
        PG8_WAIT_V(2); PG8_BAR;
        PG8_STAGE(PG8_SB(1, 0), cB + kstep, voffB); PG8_STAGE(PG8_SA(1, 0), cA + kstep, voffA); PG8_STAGE(PG8_SB(1, 1), cB + hstep + kstep, voffB);
        PG8_WAIT_V(6); PG8_BAR;
    } else {
        PG8_STAGE(PG8_SB(0, 0), cB, voffB); PG8_STAGE(PG8_SA(0, 0), cA, voffA); PG8_STAGE(PG8_SB(0, 1), cB + hstep, voffB); PG8_STAGE(PG8_SA(0, 1), cA + hstep, voffA);
        if (wr == 1) PG8_BAR;
        PG8_WAIT_V(4); PG8_BAR;
        PG8_STAGE(PG8_SB(1, 0), cB + kstep, voffB); PG8_STAGE(PG8_SA(1, 0), cA + kstep, voffA); PG8_STAGE(PG8_SB(1, 1), cB + hstep + kstep, voffB);
        PG8_WAIT_V(6); PG8_BAR;
    }
    for (;;) {
        const bool has_next = S.next(ui + 1, nxt);
        const char* nA = has_next ? (const char*)g.A + (size_t)nxt.pm * tstep : cA; const char* nB = has_next ? (const char*)g.Bt + (size_t)nxt.pn * tstep : cB;
        for (int t = 0; t < nt; t += 2) {
            const bool last = (t == nt - 2);
            const char* a1 = cA + (size_t)(t + 1) * kstep;
            const char* a2 = last ? nA : cA + (size_t)(t + 2) * kstep; const char* b2 = last ? nB : cB + (size_t)(t + 2) * kstep;
            const char* a3 = a2 + kstep; const char* b3 = b2 + kstep;
            if (last && has_next) S.a_ready(nxt);
            if constexpr (SP2) {
            PG8_LDB(B0, 0, 0); PG8_LDB(B1, 0, 1); PG8_SCHED; PG8_LDA(At, 0, 0); PG8_STAGE(PG8_SA(1, 1), a1 + hstep, voffA);
            PG8_WAIT_V(8); PG8_WAIT_L(0); PG8_BAR; PG8_MMA(0, 0, At, B0); PG8_MMA(0, 1, At, B1); PG8_BAR; PG8_SCHED;
            PG8_LDA(At, 0, 1); PG8_STAGE(PG8_SB(0, 0), b2, voffB); PG8_STAGE(PG8_SB(0, 1), b2 + hstep, voffB); PG8_STAGE(PG8_SA(0, 0), a2, voffA);
            PG8_WAIT_V(8); PG8_WAIT_L(0); PG8_BAR; PG8_MMA(1, 0, At, B0); PG8_MMA(1, 1, At, B1); PG8_BAR; PG8_SCHED;
            PG8_LDB(B0, 1, 0); PG8_LDB(B1, 1, 1); PG8_SCHED; PG8_LDA(At, 1, 0); PG8_STAGE(PG8_SA(0, 1), a2 + hstep, voffA);
            PG8_WAIT_V(8); PG8_WAIT_L(0); PG8_BAR; PG8_MMA(0, 0, At, B0); PG8_MMA(0, 1, At, B1); PG8_BAR; PG8_SCHED;
            PG8_LDA(At, 1, 1); PG8_STAGE(PG8_SB(1, 0), b3, voffB); PG8_STAGE(PG8_SB(1, 1), b3 + hstep, voffB); PG8_STAGE(PG8_SA(1, 0), a3, voffA);
            PG8_WAIT_V(8); PG8_WAIT_L(0); PG8_BAR; PG8_MMA(1, 0, At, B0); PG8_MMA(1, 1, At, B1); PG8_BAR; PG8_SCHED;
            } else {
            PG8_LDB(B0, 0, 0); PG8_SCHED; PG8_LDA(At, 0, 0); PG8_STAGE(PG8_SA(1, 1), a1 + hstep, voffA);
            PG8_WAIT_L(8); PG8_BAR; PG8_WAIT_L(0); PG8_MMA(0, 0, At, B0); PG8_BAR; PG8_SCHED;
            PG8_LDB(B1, 0, 1); PG8_STAGE(PG8_SB(0, 0), b2, voffB);
            PG8_BAR; PG8_WAIT_L(0); PG8_MMA(0, 1, At, B1); PG8_BAR;
            PG8_LDA(At, 0, 1); PG8_STAGE(PG8_SA(0, 0), a2, voffA);
            PG8_BAR; PG8_WAIT_L(0); PG8_MMA(1, 0, At, B0); PG8_BAR; PG8_SCHED;
            PG8_STAGE(PG8_SB(0, 1), b2 + hstep, voffB);
            PG8_WAIT_V(6); PG8_BAR; PG8_MMA(1, 1, At, B1); PG8_BAR;
            PG8_LDB(B0, 1, 0); PG8_SCHED; PG8_LDA(At, 1, 0); PG8_STAGE(PG8_SA(0, 1), a2 + hstep, voffA);
            PG8_WAIT_L(8); PG8_BAR; PG8_WAIT_L(0); PG8_MMA(0, 0, At, B0); PG8_BAR; PG8_SCHED;
            PG8_LDB(B1, 1, 1); PG8_STAGE(PG8_SB(1, 0), b3, voffB);
            PG8_BAR; PG8_WAIT_L(0); PG8_MMA(0, 1, At, B1); PG8_BAR;
            PG8_LDA(At, 1, 1); PG8_STAGE(PG8_SA(1, 0), a3, voffA);
            PG8_BAR; PG8_WAIT_L(0); PG8_MMA(1, 0, At, B0); PG8_BAR; PG8_SCHED;
            PG8_STAGE(PG8_SB(1, 1), b3 + hstep, voffB);
            PG8_WAIT_V(6); PG8_BAR; PG8_MMA(1, 1, At, B1); PG8_BAR;
            }
        }
        if constexpr (ALIGN_EPI) { if (wr == 0) PG8_BAR; }
        if constexpr (!Epi::AFTER_DRAIN) { E(acc, cur, wr, wc, fr, fq); S.done(cur); }
        if (!has_next) break;
#pragma unroll
        for (int a = 0; a < 2; ++a)
#pragma unroll
            for (int b = 0; b < 2; ++b)
#pragma unroll
                for (int m = 0; m < 4; ++m)
#pragma unroll
                    for (int n = 0; n < 2; ++n) acc[a][b][m][n] = (f32x4){0.f, 0.f, 0.f, 0.f};
        cur = nxt; cA = nA; cB = nB; ++ui;
        if constexpr (ALIGN_EPI) { if (wr == 1) PG8_BAR; }
    }
    PG8_WAIT_V(0);
    if constexpr (!ALIGN_EPI) { if (wr == 0) PG8_BAR; }
    PG8_BAR;
    if constexpr (Epi::AFTER_DRAIN) { E.fused(acc, cur, wr, wc, fr, fq, lds, wid, lane); S.done(cur); }
#undef PG8_SA
#undef PG8_SB
#undef PG8_STAGE
#undef PG8_LDA
#undef PG8_LDB
#undef PG8_MMA
#undef PG8_WAIT_V
#undef PG8_WAIT_L
#undef PG8_BAR
#undef PG8_SCHED
}
}

constexpr int BATCH = 2, SEQ = 8192, DM = 1024, FF = 2816, NIN = 2560, RW = 512, M = BATCH * SEQ;
constexpr int NWAVES = 8, NTHR = 512;
constexpr int CH = 128, NCH = SEQ / CH;
constexpr size_t MiB = 1u << 20;
constexpr size_t WS_WGU1 = 0, WS_WD1 = 11 * MiB, WS_WIN = WS_WD1 + 11 * MiB / 2, WS_WOUT = WS_WIN + 5 * MiB, WS_WGU2 = WS_WOUT + 2 * MiB, WS_WD2 = WS_WGU2 + 11 * MiB, WS_WL = 40 * MiB;
constexpr size_t WS_GG = 0;
constexpr size_t WS_XB = 44 * MiB;
constexpr size_t WS_PST = 44 * MiB, WS_LST = 60 * MiB;
constexpr size_t WS_BIG = 76 * MiB;
constexpr size_t WS_LIN = WS_BIG + 80 * MiB;
constexpr size_t WS_DEC = 164 * MiB, WS_AA = 196 * MiB, WS_MIX = 212 * MiB, WS_SS = 244 * MiB, WS_CTL = 248 * MiB, WS_END = 249 * MiB;
static_assert(WS_WD2 + 11 * MiB / 2 <= WS_WL && WS_WL + MiB <= WS_XB, "weights map");

#define LAS __attribute__((address_space(3)))
typedef unsigned short bf16;
typedef unsigned v4u __attribute__((ext_vector_type(4)));
typedef unsigned v2u __attribute__((ext_vector_type(2)));
typedef float f32x4 __attribute__((ext_vector_type(4)));
typedef float f32x2 __attribute__((ext_vector_type(2)));
typedef short bf16x8 __attribute__((ext_vector_type(8)));
using pg8::cvt_pk_bf16;
__device__ __forceinline__ float bflo(unsigned u) { return __uint_as_float(u << 16); }
__device__ __forceinline__ float bfhi(unsigned u) { return __uint_as_float(u & 0xffff0000u); }
template <int CTRL> __device__ __forceinline__ float dpp_mov(float x) { return __builtin_bit_cast(float, __builtin_amdgcn_update_dpp(0, __builtin_bit_cast(int, x), CTRL, 0xF, 0xF, true)); }
__device__ __forceinline__ float sum16(float x) { x += dpp_mov<0xB1>(x); x += dpp_mov<0x4E>(x); x += dpp_mov<0x141>(x); x += dpp_mov<0x140>(x); return x; }
__device__ __forceinline__ float max16(float x) { x = fmaxf(x, dpp_mov<0xB1>(x)); x = fmaxf(x, dpp_mov<0x4E>(x)); x = fmaxf(x, dpp_mov<0x141>(x)); x = fmaxf(x, dpp_mov<0x140>(x)); return x; }
__device__ __forceinline__ float sum8(float x) { x += dpp_mov<0xB1>(x); x += dpp_mov<0x4E>(x); x += dpp_mov<0x141>(x); return x; }
__device__ __forceinline__ float wave_sum(float v) {
#pragma unroll
    for (int o = 1; o < 64; o <<= 1) v += __shfl_xor(v, o);
    return v;
}

__device__ __forceinline__ int lane_id() { return (int)__builtin_amdgcn_mbcnt_hi(~0u, __builtin_amdgcn_mbcnt_lo(~0u, 0u)); }
#define TIDX ((wave << 6) | lane_id())
struct Params {
    const float* in[26]; float* out; unsigned char* ws; int ph_lo, ph_hi;
};


#define GAS __attribute__((address_space(1)))
__device__ __forceinline__ const float* inp(int i) {
    const __attribute__((address_space(4))) char* ka = (const __attribute__((address_space(4))) char*)__builtin_amdgcn_kernarg_segment_ptr();
    int off = i * 8; asm volatile("" : "+s"(off));
    const float* q = *(const float* const __attribute__((address_space(4)))*)(ka + off);
    return (const float*)(const GAS float*)q;
}

__device__ __forceinline__ void conv_item(const float* W, int K, int N, const float* sc, bf16* WT, int k0, int n0, int drow0, float* scr, int lane) {
#pragma unroll 8
    for (int i = 0; i < 32; ++i) { const int kk = 2 * i + (lane >> 5); float v = W[(size_t)(k0 + kk) * N + n0 + (lane & 31)]; if (sc) v *= sc[k0 + kk]; scr[kk * 33 + (lane & 31)] = v; }
    __builtin_amdgcn_fence(__ATOMIC_RELEASE, "wavefront"); asm volatile("s_waitcnt lgkmcnt(0)" ::: "memory");
    const int c = lane & 7;
#pragma unroll
    for (int j = 0; j < 4; ++j) { const int n = (lane >> 3) + 8 * j; const float* s = scr + (8 * c) * 33 + n;
        v4u o; o.x = cvt_pk_bf16(s[0 * 33], s[1 * 33]); o.y = cvt_pk_bf16(s[2 * 33], s[3 * 33]); o.z = cvt_pk_bf16(s[4 * 33], s[5 * 33]); o.w = cvt_pk_bf16(s[6 * 33], s[7 * 33]);
        *(v4u*)(WT + (size_t)(drow0 + n) * K + k0 + 8 * c) = o; }
    asm volatile("s_waitcnt lgkmcnt(0)" ::: "memory");
}
__device__ __forceinline__ void conv_plain(const float* W, int K, int N, const float* sc, bf16* WT, int item, float* scr, int lane) {
    const int nblk = N / 32, kb = item / nblk, nb = item % nblk; conv_item(W, K, N, sc, WT, 64 * kb, 32 * nb, 32 * nb, scr, lane);
}
__device__ __forceinline__ void conv_gu(const float* W, const float* sc, bf16* WT, int item, int up, float* scr, int lane) {
    const int nblk = FF / 32, kb = item / nblk, nb = item % nblk, n0 = 32 * nb; conv_item(W, DM, FF, sc, WT, 64 * kb, n0, (n0 >> 7) * 256 + up * 128 + (n0 & 127), scr, lane);
}
__device__ __forceinline__ void p0_prologue(const Params& p, unsigned char* lds, int wave, int lane) {
    float* scr = (float*)(lds + wave * 16384);
    unsigned char* ws = p.ws;
    const int gw = blockIdx.x * NWAVES + wave, NGW = gridDim.x * NWAVES;
    constexpr int I_GU = (DM / 64) * (FF / 32), I_DN = (FF / 64) * (DM / 32), I_IN = (DM / 64) * (NIN / 32), I_OUT = (DM / 64) * (DM / 32);
    constexpr int NITEMS = 4 * I_GU + 2 * I_DN + I_IN + I_OUT;
    for (int it = gw; it < NITEMS; it += NGW) {
        int r = it;
        if (r < I_GU) { conv_gu(inp(2), inp(1), (bf16*)(ws + WS_WGU1), r, 0, scr, lane); continue; } r -= I_GU;
        if (r < I_GU) { conv_gu(inp(3), inp(1), (bf16*)(ws + WS_WGU1), r, 1, scr, lane); continue; } r -= I_GU;
        if (r < I_DN) { conv_plain(inp(4), FF, DM, nullptr, (bf16*)(ws + WS_WD1), r, scr, lane); continue; } r -= I_DN;
        if (r < I_IN) { conv_plain(inp(6), DM, NIN, inp(5), (bf16*)(ws + WS_WIN), r, scr, lane); continue; } r -= I_IN;
        if (r < I_OUT) { conv_plain(inp(20), DM, DM, nullptr, (bf16*)(ws + WS_WOUT), r, scr, lane); continue; } r -= I_OUT;
        if (r < I_GU) { conv_gu(inp(22), inp(21), (bf16*)(ws + WS_WGU2), r, 0, scr, lane); continue; } r -= I_GU;
        if (r < I_GU) { conv_gu(inp(23), inp(21), (bf16*)(ws + WS_WGU2), r, 1, scr, lane); continue; } r -= I_GU;
        conv_plain(inp(24), FF, DM, nullptr, (bf16*)(ws + WS_WD2), r, scr, lane);
    }
    { bf16* WL = (bf16*)(ws + WS_WL); const float* w2 = inp(10); const float* a2 = inp(12); const float* g2 = inp(13);
      for (int idx = (blockIdx.x * NTHR + TIDX); idx < 1536 * 128; idx += gridDim.x * NTHR) {
          const int n = idx >> 7, k = (idx & 127) * 2; float v0 = 0.f, v1 = 0.f;
          if (n < 512) { if (k < 64) { v0 = w2[k * 512 + n]; v1 = w2[(k + 1) * 512 + n]; } }
          else if (n < 1024) { if (k >= 64 && k < 128) { v0 = a2[(k - 64) * 512 + n - 512]; v1 = a2[(k - 63) * 512 + n - 512]; } }
          else { if (k >= 128) { v0 = g2[(k - 128) * 512 + n - 1024]; v1 = g2[(k - 127) * 512 + n - 1024]; } }
          *(unsigned*)(WL + (size_t)n * 256 + k) = cvt_pk_bf16(v0, v1); } }
    { const float* x = inp(0); bf16* XB = (bf16*)(ws + WS_XB); float* ss0 = (float*)(ws + WS_SS);
      for (int m = gw; m < M; m += NGW) { const f32x4* xr = (const f32x4*)(x + (size_t)m * DM) + lane; float s = 0.f; f32x4 v[4];
#pragma unroll
          for (int j = 0; j < 4; ++j) { v[j] = xr[64 * j]; s += (v[j][0] * v[j][0] + v[j][1] * v[j][1]) + (v[j][2] * v[j][2] + v[j][3] * v[j][3]); }
          s = wave_sum(s);
          v2u* o8 = (v2u*)(XB + (size_t)m * DM) + lane;
#pragma unroll
          for (int j = 0; j < 4; ++j) { v2u w; w.x = cvt_pk_bf16(v[j][0], v[j][1]); w.y = cvt_pk_bf16(v[j][2], v[j][3]); o8[64 * j] = w; }
          if (lane < 16) ss0[(size_t)m * 16 + lane] = (lane == 0) ? s : 0.f; } }
}

__device__ __forceinline__ void r1_phase(const Params& p, int wave) {
    const bf16* P = (const bf16*)(p.ws + WS_BIG); bf16* LIN = (bf16*)(p.ws + WS_LIN); const float* mix = inp(8);
    for (int idx = blockIdx.x * NTHR + TIDX; idx < M * 32; idx += gridDim.x * NTHR) {
        const int row = idx >> 5, g8 = idx & 31, col = 1536 + 8 * g8; const bool hp = (row & (SEQ - 1)) != 0;
        const v4u c = *(const v4u*)(P + (size_t)row * NIN + col); v4u q = (v4u){0u, 0u, 0u, 0u}; if (hp) q = *(const v4u*)(P + (size_t)(row - 1) * NIN + col);
        const f32x4 m0 = *(const f32x4*)(mix + col), m1 = *(const f32x4*)(mix + col + 4);
        float x[8];
#pragma unroll
        for (int e = 0; e < 4; ++e) { const float c0 = bflo(c[e]), c1 = bfhi(c[e]), q0 = bflo(q[e]), q1 = bfhi(q[e]); const float ma = (e < 2) ? m0[2 * e] : m1[2 * e - 4], mb = (e < 2) ? m0[2 * e + 1] : m1[2 * e - 3];
            x[2 * e] = c0 + (q0 - c0) * ma; x[2 * e + 1] = c1 + (q1 - c1) * mb; }
        if (g8 < 8) {
#pragma unroll
            for (int e = 0; e < 8; ++e) x[e] = tanhf(x[e]);
        } else if (g8 >= 16) {
#pragma unroll
            for (int e = 0; e < 8; ++e) x[e] = 1.0f / (1.0f + expf(-x[e]));
        }
        v4u o; o.x = cvt_pk_bf16(x[0], x[1]); o.y = cvt_pk_bf16(x[2], x[3]); o.z = cvt_pk_bf16(x[4], x[5]); o.w = cvt_pk_bf16(x[6], x[7]);
        *(v4u*)(LIN + (size_t)row * 256 + 8 * g8) = o;
    }
}

constexpr int SC_W = 0, SC_B = 1, SC_K = 2, SC_KK = 3, SC_V = 4, SC_R = 5, SC_O = 6, SC_BC = 7;
template <bool P3> __device__ __forceinline__ void scan_load(const Params& p, float* sm, int b, int h, int t0, int wave) {
    const int tid = TIDX, tt = tid >> 3, c8 = (tid & 7) * 8, hc = h * 64 + c8;
    const bf16* P = (const bf16*)(p.ws + WS_BIG); const float* DEC = (const float*)(p.ws + WS_DEC); const bf16* AA = (const bf16*)(p.ws + WS_AA);
    const float* mix = inp(8); const float* k_k = inp(14); const float* k_a = inp(15); const float* r_k = inp(16);
    const int gr = b * SEQ + t0 + tt; const bool hp = (t0 + tt) > 0;
    const bf16* prow = P + (size_t)gr * NIN + hc;
    float r[8], k[8], v[8];
#define SHIFT_LOAD(dst, off) do { const v4u c_ = *(const v4u*)(prow + (off)); v4u q_ = (v4u){0u, 0u, 0u, 0u}; if (hp) q_ = *(const v4u*)(prow + (off) - NIN); \
        const f32x4 m0_ = *(const f32x4*)(mix + hc + (off)), m1_ = *(const f32x4*)(mix + hc + (off) + 4); \
        _Pragma("unroll") for (int e = 0; e < 4; ++e) { const float c0 = bflo(c_[e]), c1 = bfhi(c_[e]), q0 = bflo(q_[e]), q1 = bfhi(q_[e]); const float ma = (e < 2) ? m0_[2 * e] : m1_[2 * e - 4], mb = (e < 2) ? m0_[2 * e + 1] : m1_[2 * e - 3]; \
            dst[2 * e] = c0 + (q0 - c0) * ma; dst[2 * e + 1] = c1 + (q1 - c1) * mb; } } while (0)
    SHIFT_LOAD(k, 512); SHIFT_LOAD(v, 1024);
    if (P3) SHIFT_LOAD(r, 0);
#undef SHIFT_LOAD
    const f32x4 d0 = *(const f32x4*)(DEC + (size_t)gr * RW + hc), d1 = *(const f32x4*)(DEC + (size_t)gr * RW + hc + 4);
    const v4u av = *(const v4u*)(AA + (size_t)gr * RW + hc);
    const f32x4 kk0 = *(const f32x4*)(k_k + hc), kk1 = *(const f32x4*)(k_k + hc + 4), ka0 = *(const f32x4*)(k_a + hc), ka1 = *(const f32x4*)(k_a + hc + 4);
    float a[8], kk[8], kp[8], bb[8]; float ssq = 0.f;
#pragma unroll
    for (int e = 0; e < 4; ++e) { a[2 * e] = bflo(av[e]); a[2 * e + 1] = bfhi(av[e]); }
#pragma unroll
    for (int e = 0; e < 8; ++e) { const float kkw = (e < 4) ? kk0[e] : kk1[e - 4], kaw = (e < 4) ? ka0[e] : ka1[e - 4];
        kk[e] = k[e] * kkw; ssq += kk[e] * kk[e]; kp[e] = k[e] * (1.0f + (a[e] - 1.0f) * kaw); }
    ssq = sum8(ssq);
    const float inv = 1.0f / fmaxf(sqrtf(ssq), 1e-12f);
#pragma unroll
    for (int e = 0; e < 8; ++e) { kk[e] *= inv; bb[e] = kk[e] * a[e]; }
    float* base = sm + tt * 64 + c8;
    *(f32x4*)(base + SC_W * 4096) = d0; *(f32x4*)(base + SC_W * 4096 + 4) = d1;
    *(f32x4*)(base + SC_B * 4096) = (f32x4){bb[0], bb[1], bb[2], bb[3]}; *(f32x4*)(base + SC_B * 4096 + 4) = (f32x4){bb[4], bb[5], bb[6], bb[7]};
    *(f32x4*)(base + SC_K * 4096) = (f32x4){kp[0], kp[1], kp[2], kp[3]}; *(f32x4*)(base + SC_K * 4096 + 4) = (f32x4){kp[4], kp[5], kp[6], kp[7]};
    *(f32x4*)(base + SC_KK * 4096) = (f32x4){kk[0], kk[1], kk[2], kk[3]}; *(f32x4*)(base + SC_KK * 4096 + 4) = (f32x4){kk[4], kk[5], kk[6], kk[7]};
    *(f32x4*)(base + SC_V * 4096) = (f32x4){v[0], v[1], v[2], v[3]}; *(f32x4*)(base + SC_V * 4096 + 4) = (f32x4){v[4], v[5], v[6], v[7]};
    if (P3) {
        *(f32x4*)(base + SC_R * 4096) = (f32x4){r[0], r[1], r[2], r[3]}; *(f32x4*)(base + SC_R * 4096 + 4) = (f32x4){r[4], r[5], r[6], r[7]};
        const f32x4 rk0 = *(const f32x4*)(r_k + hc), rk1 = *(const f32x4*)(r_k + hc + 4); float bc = 0.f;
#pragma unroll
        for (int e = 0; e < 8; ++e) bc += r[e] * kp[e] * ((e < 4) ? rk0[e] : rk1[e - 4]);
        bc = sum8(bc);
        if ((tid & 7) == 0) sm[SC_BC * 4096 + tt] = bc;
    }
}
template <int RPL, bool WITH_O, bool REAL> __device__ __forceinline__ void scan_run(const float* sm, float (&S)[RPL][4], int cs, int rowbase) {
#pragma unroll 2
    for (int t = 0; t < 64; ++t) {
        const float* st = sm + t * 64 + 4 * cs;
        const f32x4 w4 = *(const f32x4*)(st + SC_W * 4096), b4 = *(const f32x4*)(st + SC_B * 4096), k4 = *(const f32x4*)(st + SC_K * 4096), kk4 = *(const f32x4*)(st + SC_KK * 4096);
        f32x4 r4 = (f32x4){0.f, 0.f, 0.f, 0.f}; if (WITH_O) r4 = *(const f32x4*)(st + SC_R * 4096);
        float vv[RPL];
#pragma unroll
        for (int j = 0; j < RPL; ++j) vv[j] = REAL ? sm[SC_V * 4096 + t * 64 + rowbase + j] : 0.f;
        float oo[RPL];
#pragma unroll
        for (int j = 0; j < RPL; ++j) {
            float sa = (S[j][0] * kk4[0] + S[j][1] * kk4[1]) + (S[j][2] * kk4[2] + S[j][3] * kk4[3]);
            sa = sum16(sa);
#pragma unroll
            for (int c = 0; c < 4; ++c) S[j][c] = S[j][c] * w4[c] + (vv[j] * k4[c] - sa * b4[c]);
            if (WITH_O) { float o = (S[j][0] * r4[0] + S[j][1] * r4[1]) + (S[j][2] * r4[2] + S[j][3] * r4[3]); oo[j] = sum16(o); }
        }
        if (WITH_O) { if (cs == 0) {
#pragma unroll
            for (int j = 0; j < RPL; ++j) ((float*)sm)[SC_O * 4096 + t * 64 + rowbase + j] = oo[j]; } }
    }
}
__device__ __forceinline__ void scan_pass1(const Params& p, float* sm, int wave, int lane) {
    float* PST = (float*)(p.ws + WS_PST); float* LST = (float*)(p.ws + WS_LST);
    const int cs = lane & 15, rg = lane >> 4; const bool real = wave < 4; const int rowbase = (wave & 3) * 16 + rg * 4;
    constexpr int NU = BATCH * (NCH - 1) * 8;
    for (int u = blockIdx.x; u < NU; u += gridDim.x) {
        const int h = u & 7, bc = u >> 3, c = bc % (NCH - 1), b = bc / (NCH - 1);
        float S[4][4];
#pragma unroll
        for (int j = 0; j < 4; ++j)
#pragma unroll
            for (int e = 0; e < 4; ++e) S[j][e] = (!real && (rowbase + j == 4 * cs + e)) ? 1.0f : 0.0f;
        for (int sub = 0; sub < 2; ++sub) {
            __syncthreads();
            scan_load<false>(p, sm, b, h, c * CH + sub * 64, wave);
            __syncthreads();
            if (real) scan_run<4, false, true>(sm, S, cs, rowbase); else scan_run<4, false, false>(sm, S, cs, rowbase);
        }
        float* dst = (real ? LST : PST) + ((size_t)((b * NCH + c) * 8 + h)) * 4096 + rowbase * 64 + 4 * cs;
#pragma unroll
        for (int j = 0; j < 4; ++j) *(f32x4*)(dst + j * 64) = (f32x4){S[j][0], S[j][1], S[j][2], S[j][3]};
    }
}
__device__ __forceinline__ void scan_pass2(const Params& p, float* sm, int wave) {
    const float* PST = (const float*)(p.ws + WS_PST); float* LST = (float*)(p.ws + WS_LST);
    const int lane = lane_id(), tid = (wave << 6) | lane, vb = (blockIdx.x & 7) * (gridDim.x >> 3) + (blockIdx.x >> 3);
    if (vb >= 128) return;
    const int chain = vb >> 3, row = (vb & 7) * 8 + wave, b = chain >> 3, h = chain & 7;
    float* Pb = sm; float* Sw = sm + 8192 + wave * 64;
    constexpr int NS = NCH - 1;
#define UOFF(c) ((size_t)((b * NCH + (c)) * 8 + h) * 4096)
#define LDP(X0, X1, LX, c) do { X0 = *(const f32x4*)(PST + UOFF(c) + tid * 8); X1 = *(const f32x4*)(PST + UOFF(c) + tid * 8 + 4); LX = LST[UOFF(c) + row * 64 + lane]; } while (0)
    f32x4 A0, A1, B0, B1, C0, C1; float LA = 0.f, LB = 0.f, LC = 0.f, Lcur;
    __syncthreads();
    LDP(A0, A1, LA, 0);
    *(f32x4*)(Pb + tid * 8) = A0; *(f32x4*)(Pb + tid * 8 + 4) = A1; Lcur = LA;
    Sw[lane] = 0.f;
    LDP(B0, B1, LB, 1); LDP(C0, C1, LC, 2); LDP(A0, A1, LA, 3);
    __syncthreads();
#define P2STEP(c, X0, X1, LX) do { float Lnx = 0.f; \
        if ((c) + 1 < NS) { float* Pn = Pb + (((c) + 1) & 1) * 4096; *(f32x4*)(Pn + tid * 8) = X0; *(f32x4*)(Pn + tid * 8 + 4) = X1; Lnx = LX; } \
        if ((c) + 4 < NS) LDP(X0, X1, LX, (c) + 4); \
        const float* Pc = Pb + ((c) & 1) * 4096 + lane; float a0 = 0.f, a1 = 0.f, a2 = 0.f, a3 = 0.f; \
        _Pragma("unroll") for (int i = 0; i < 64; i += 4) { const f32x4 s4 = *(const f32x4*)(Sw + i); \
            a0 += s4[0] * Pc[(i + 0) * 64]; a1 += s4[1] * Pc[(i + 1) * 64]; a2 += s4[2] * Pc[(i + 2) * 64]; a3 += s4[3] * Pc[(i + 3) * 64]; } \
        const float sn = ((a0 + a1) + (a2 + a3)) + Lcur; LST[UOFF(c) + row * 64 + lane] = sn; Sw[lane] = sn; Lcur = Lnx; \
        __syncthreads(); } while (0)
    for (int c = 0; c < NS; c += 3) { P2STEP(c, B0, B1, LB); P2STEP(c + 1, C0, C1, LC); P2STEP(c + 2, A0, A1, LA); }
    static_assert(NS % 3 == 0, "pass 2 is unrolled by 3");
#undef P2STEP
#undef LDP
#undef UOFF
}
__device__ __forceinline__ void scan_pass3(const Params& p, float* sm, int wave, int lane) {
    const float* LST = (const float*)(p.ws + WS_LST); const bf16* GG = (const bf16*)(p.ws + WS_GG); bf16* MIX = (bf16*)(p.ws + WS_MIX);
    const float* ln_w = inp(17); const float* ln_b = inp(18);
    const int tid = TIDX, cs = lane & 15, rg = lane >> 4, rowbase = wave * 8 + rg * 2;
    constexpr int NU = BATCH * NCH * 8;
    for (int u = blockIdx.x; u < NU; u += gridDim.x) {
        const int h = u & 7, bc = u >> 3, c = bc % NCH, b = bc / NCH;
        float S[2][4];
        if (c > 0) { const float* src = LST + ((size_t)((b * NCH + c - 1) * 8 + h)) * 4096 + rowbase * 64 + 4 * cs;
#pragma unroll
            for (int j = 0; j < 2; ++j) { const f32x4 s4 = *(const f32x4*)(src + j * 64); S[j][0] = s4[0]; S[j][1] = s4[1]; S[j][2] = s4[2]; S[j][3] = s4[3]; } }
        else {
#pragma unroll
            for (int j = 0; j < 2; ++j) { S[j][0] = 0.f; S[j][1] = 0.f; S[j][2] = 0.f; S[j][3] = 0.f; } }
        for (int sub = 0; sub < 2; ++sub) {
            __syncthreads();
            scan_load<true>(p, sm, b, h, c * CH + sub * 64, wave);
            __syncthreads();
            scan_run<2, true, true>(sm, S, cs, rowbase);
            __syncthreads();
            const int tt = tid >> 3, c8 = (tid & 7) * 8, hc = h * 64 + c8; const int gr = b * SEQ + c * CH + sub * 64 + tt;
            const f32x4 o0 = *(const f32x4*)(sm + SC_O * 4096 + tt * 64 + c8), o1 = *(const f32x4*)(sm + SC_O * 4096 + tt * 64 + c8 + 4);
            const f32x4 v0 = *(const f32x4*)(sm + SC_V * 4096 + tt * 64 + c8), v1 = *(const f32x4*)(sm + SC_V * 4096 + tt * 64 + c8 + 4);
            const float bcv = sm[SC_BC * 4096 + tt];
            float mu = ((o0[0] + o0[1]) + (o0[2] + o0[3])) + ((o1[0] + o1[1]) + (o1[2] + o1[3])); mu = sum8(mu) * (1.0f / 64.0f);
            const f32x4 e0 = o0 - mu, e1 = o1 - mu;
            float var = ((e0[0] * e0[0] + e0[1] * e0[1]) + (e0[2] * e0[2] + e0[3] * e0[3])) + ((e1[0] * e1[0] + e1[1] * e1[1]) + (e1[2] * e1[2] + e1[3] * e1[3])); var = sum8(var) * (1.0f / 64.0f);
            const float rs = 1.0f / sqrtf(var + 64e-5f);
            const f32x4 lw0 = *(const f32x4*)(ln_w + hc), lw1 = *(const f32x4*)(ln_w + hc + 4), lb0 = *(const f32x4*)(ln_b + hc), lb1 = *(const f32x4*)(ln_b + hc + 4);
            const v4u gv = *(const v4u*)(GG + (size_t)gr * RW + hc);
            f32x4 y0 = (e0 * rs) * lw0 + lb0 + v0 * bcv, y1 = (e1 * rs) * lw1 + lb1 + v1 * bcv;
            y0[0] *= bflo(gv[0]); y0[1] *= bfhi(gv[0]); y0[2] *= bflo(gv[1]); y0[3] *= bfhi(gv[1]); y1[0] *= bflo(gv[2]); y1[1] *= bfhi(gv[2]); y1[2] *= bflo(gv[3]); y1[3] *= bfhi(gv[3]);
            v4u w; w.x = cvt_pk_bf16(y0[0], y0[1]); w.y = cvt_pk_bf16(y0[2], y0[3]); w.z = cvt_pk_bf16(y1[0], y1[1]); w.w = cvt_pk_bf16(y1[2], y1[3]);
            *(v4u*)(MIX + (size_t)gr * DM + hc) = w;
        }
    }
}

constexpr int AT_KS = 0, AT_VT = 256 * 72 * 2, AT_PS = AT_VT + 64 * 280 * 2, AT_PSW = 16 * 168 * 2;
__device__ __forceinline__ void attn_phase(const Params& p, unsigned char* lds, int wave, int lane) {
    const bf16* P = (const bf16*)(p.ws + WS_BIG); bf16* MIX = (bf16*)(p.ws + WS_MIX); const float* sinks = inp(19);
    const int tid = TIDX; bf16* Ks = (bf16*)(lds + AT_KS); bf16* Vt = (bf16*)(lds + AT_VT); bf16* Ps = (bf16*)(lds + AT_PS + wave * AT_PSW);
    const int fr = lane & 15, fq = lane >> 4;
    for (int u = blockIdx.x; u < BATCH * 64 * 2; u += gridDim.x) {
        const int g = u & 1, qb = (u >> 1) & 63, b = u >> 7, q0 = qb * 128;
        __syncthreads();
        { const int key = tid >> 1, half = tid & 1; const bool valid = (qb > 0) || (key >= 128);
          const bf16* src = P + (size_t)(b * SEQ + q0 - 128 + key) * NIN + 1792 + 512 + g * 64 + half * 32;
#pragma unroll
          for (int i = 0; i < 4; ++i) { v4u kx = (v4u){0u, 0u, 0u, 0u}, vx = kx; if (valid) { kx = *(const v4u*)(src + 8 * i); vx = *(const v4u*)(src + 128 + 8 * i); }
              *(v4u*)(Ks + key * 72 + half * 32 + 8 * i) = kx;
#pragma unroll
              for (int e = 0; e < 4; ++e) { const int d = half * 32 + 8 * i + 2 * e; Vt[d * 280 + key] = (bf16)(vx[e] & 0xffffu); Vt[(d + 1) * 280 + key] = (bf16)(vx[e] >> 16); } }
          if (tid < 64 * 3) { const int d = tid / 3, part = tid % 3; *(v4u*)(Vt + d * 280 + 256 + 8 * part) = (v4u){0u, 0u, 0u, 0u}; } }
        __syncthreads();
        for (int hq4 = 0; hq4 < 4; ++hq4) {
            const int hq = g * 4 + hq4; const float sink = sinks[hq];
            const bf16* qp = P + (size_t)(b * SEQ + q0 + 16 * wave + fr) * NIN + 1792 + hq * 64 + 8 * fq;
            const bf16x8 qa0 = *(const bf16x8*)qp, qa1 = *(const bf16x8*)(qp + 32);
            f32x4 sc[9]; float mx[4] = {-1e30f, -1e30f, -1e30f, -1e30f};
#pragma unroll
            for (int nt = 0; nt < 9; ++nt) { const int jt = 16 * (wave + nt); const bf16* kp = Ks + (jt + fr) * 72 + 8 * fq;
                const bf16x8 kb0 = *(const bf16x8*)kp, kb1 = *(const bf16x8*)(kp + 32);
                f32x4 a = (f32x4){0.f, 0.f, 0.f, 0.f}; a = __builtin_amdgcn_mfma_f32_16x16x32_bf16(qa0, kb0, a, 0, 0, 0); a = __builtin_amdgcn_mfma_f32_16x16x32_bf16(qa1, kb1, a, 0, 0, 0);
                const int j = jt + fr;
#pragma unroll
                for (int r = 0; r < 4; ++r) { const int i = 16 * wave + 4 * fq + r, dist = i + 128 - j; const bool ok = (dist >= 0) && (dist < 128) && ((qb > 0) || (j >= 128));
                    a[r] = ok ? a[r] * 0.125f : -1e30f; mx[r] = fmaxf(mx[r], a[r]); }
                sc[nt] = a; }
            float sm_[4];
#pragma unroll
            for (int r = 0; r < 4; ++r) { mx[r] = fmaxf(max16(mx[r]), sink); sm_[r] = 0.f; }
#pragma unroll
            for (int nt = 0; nt < 9; ++nt) {
#pragma unroll
                for (int r = 0; r < 4; ++r) { const float e = __expf(sc[nt][r] - mx[r]); sm_[r] += e; Ps[(4 * fq + r) * 168 + nt * 16 + fr] = (bf16)(cvt_pk_bf16(e, 0.f) & 0xffffu); } }
#pragma unroll
            for (int r = 0; r < 4; ++r) { Ps[(4 * fq + r) * 168 + 144 + fr] = 0; sm_[r] = 1.0f / (sum16(sm_[r]) + __expf(sink - mx[r])); }
            __builtin_amdgcn_fence(__ATOMIC_RELEASE, "wavefront"); asm volatile("s_waitcnt lgkmcnt(0)" ::: "memory");
            f32x4 o[4];
#pragma unroll
            for (int dt = 0; dt < 4; ++dt) o[dt] = (f32x4){0.f, 0.f, 0.f, 0.f};
#pragma unroll
            for (int ks = 0; ks < 5; ++ks) { const bf16x8 pa = *(const bf16x8*)(Ps + fr * 168 + ks * 32 + 8 * fq);
#pragma unroll
                for (int dt = 0; dt < 4; ++dt) { const bf16x8 vb = *(const bf16x8*)(Vt + (dt * 16 + fr) * 280 + 16 * wave + ks * 32 + 8 * fq);
                    o[dt] = __builtin_amdgcn_mfma_f32_16x16x32_bf16(pa, vb, o[dt], 0, 0, 0); } }
            bf16* op = MIX + (size_t)(b * SEQ + q0 + 16 * wave + 4 * fq) * DM + 512 + hq * 64 + fr;
#pragma unroll
            for (int r = 0; r < 4; ++r)
#pragma unroll
                for (int dt = 0; dt < 4; ++dt) op[(size_t)r * DM + dt * 16] = (bf16)(cvt_pk_bf16(o[dt][r] * sm_[r], 0.f) & 0xffffu);
            asm volatile("s_waitcnt lgkmcnt(0)" ::: "memory");
        }
    }
}

__device__ __forceinline__ void final_norm(const Params& p, int wave, int lane) {
    const float* ss3 = (const float*)(p.ws + WS_SS) + (size_t)3 * M * 16; const float* gf = inp(25);
    const int gw = blockIdx.x * NWAVES + wave, NGW = gridDim.x * NWAVES;
    f32x4 gfv[4];
#pragma unroll
    for (int j = 0; j < 4; ++j) gfv[j] = ((const f32x4*)gf)[lane + 64 * j];
    for (int m = gw; m < M; m += NGW) { const float rs = pg8::row_rstd(ss3, m); f32x4* xr = (f32x4*)(p.out + (size_t)m * DM) + lane;
#pragma unroll
        for (int j = 0; j < 4; ++j) { const f32x4 v = xr[64 * j]; xr[64 * j] = v * rs * gfv[j]; } }
}


__device__ __forceinline__ void grid_bar(unsigned* ctr, unsigned target, int wave) {
    asm volatile("s_waitcnt vmcnt(0)" ::: "memory");
    __syncthreads();
    if (TIDX == 0) {
        __builtin_amdgcn_fence(__ATOMIC_RELEASE, "agent");
        asm volatile("s_waitcnt vmcnt(0)" ::: "memory");
        __hip_atomic_fetch_add(ctr, 1u, __ATOMIC_RELAXED, __HIP_MEMORY_SCOPE_AGENT);
        while (__hip_atomic_load(ctr, __ATOMIC_RELAXED, __HIP_MEMORY_SCOPE_AGENT) < target) __builtin_amdgcn_s_sleep(1);
        __builtin_amdgcn_fence(__ATOMIC_ACQUIRE, "agent");
        asm volatile("s_waitcnt vmcnt(0)" ::: "memory");
    }
    __syncthreads();
}

constexpr int LDS_BYTES = 147456;
constexpr int NPHASE = 12;
#ifndef DUPMASK
#define DUPMASK 0
#endif
__global__ void __launch_bounds__(NTHR, 2) hymba_fwd(Params p) {
    extern __shared__ __attribute__((aligned(16))) unsigned char lds[];
    cg::grid_group grid = cg::this_grid();
    const int wave = __builtin_amdgcn_readfirstlane((int)threadIdx.x >> 6); const int lane = lane_id(); const int tid = (wave << 6) | lane;
    unsigned char* ws = p.ws;
    PG8_LAS unsigned char* lds3 = (PG8_LAS unsigned char*)lds;
    float* ss = (float*)(ws + WS_SS);
    bf16* XB = (bf16*)(ws + WS_XB); bf16* ACT = (bf16*)(ws + WS_BIG); bf16* PB = (bf16*)(ws + WS_BIG);
    const int lo = p.ph_lo, hi = p.ph_hi;
#define IN(k) (lo <= (k) && (k) < hi)
#define REP(k) for (int rep_ = 0; rep_ < 1 + ((DUPMASK >> (k)) & 1); ++rep_)
#define SEAM(k) do { if (IN(k) && IN((k) + 1)) { ++nbar; grid_bar(bctr, nbar * gridDim.x, wave); } } while (0)
    unsigned* bctr = (unsigned*)(ws + WS_CTL); unsigned nbar = 0;
    if (IN(0)) REP(0) { p0_prologue(p, lds, wave, lane_id()); }
    if (blockIdx.x == 0 && wave == 0 && lane_id() == 0) __hip_atomic_store(bctr, 0u, __ATOMIC_RELAXED, __HIP_MEMORY_SCOPE_AGENT);
    grid.sync();
    if (IN(1)) REP(1) { pg8::Gemm g{XB, (const bf16*)(ws + WS_WGU1), M, 2 * FF, DM}; pg8::StaticOrder S; S.init(M, 2 * FF, gridDim.x, blockIdx.x);
        pg8::EpiSwiGLU E{ACT, ss, FF}; pg8::gemm_phase<pg8::EpiSwiGLU, pg8::StaticOrder, true, true>(lds3, g, S, E, wave); } SEAM(1);
    if (IN(2)) REP(2) { pg8::Gemm g{ACT, (const bf16*)(ws + WS_WD1), M, DM, FF}; pg8::StaticOrder S; S.init(M, DM, gridDim.x, blockIdx.x);
        pg8::EpiRes E{inp(0), p.out, XB, ss + (size_t)M * 16, 0.5f}; pg8::gemm_phase<pg8::EpiRes, pg8::StaticOrder, true, true>(lds3, g, S, E, wave); } SEAM(2);
    if (IN(3)) REP(3) { pg8::Gemm g{XB, (const bf16*)(ws + WS_WIN), M, NIN, DM}; pg8::StaticOrder S; S.init(M, NIN, gridDim.x, blockIdx.x);
        pg8::EpiWin E{PB, ss + (size_t)M * 16, inp(7), 1792, NIN}; pg8::gemm_phase<pg8::EpiWin, pg8::StaticOrder, true, true>(lds3, g, S, E, wave); } SEAM(3);
    if (IN(4)) REP(4) { r1_phase(p, wave); } SEAM(4);
    if (IN(5)) REP(5) { pg8::Gemm g{(const bf16*)(ws + WS_LIN), (const bf16*)(ws + WS_WL), M, 1536, 256}; pg8::StaticOrder S; S.init(M, 1536, gridDim.x, blockIdx.x);
        pg8::EpiLora E{(float*)(ws + WS_DEC), (bf16*)(ws + WS_AA), (bf16*)(ws + WS_GG), inp(9), inp(11)}; pg8::gemm_phase<pg8::EpiLora, pg8::StaticOrder, true, true>(lds3, g, S, E, wave); } SEAM(5);
    if (IN(6)) REP(6) { scan_pass1(p, (float*)lds, wave, lane_id()); attn_phase(p, lds, wave, lane_id()); } SEAM(6);
    if (IN(7)) REP(7) { scan_pass2(p, (float*)lds, wave); } SEAM(7);
    if (IN(8)) REP(8) { scan_pass3(p, (float*)lds, wave, lane_id()); __syncthreads(); } SEAM(8);
    if (IN(9)) REP(9) { pg8::Gemm g{(const bf16*)(ws + WS_MIX), (const bf16*)(ws + WS_WOUT), M, DM, DM}; pg8::StaticOrder S; S.init(M, DM, gridDim.x, blockIdx.x);
        pg8::EpiRes E{p.out, p.out, XB, ss + (size_t)2 * M * 16, 1.0f}; pg8::gemm_phase<pg8::EpiRes, pg8::StaticOrder, true, true>(lds3, g, S, E, wave); } SEAM(9);
    if (IN(10)) REP(10) { pg8::Gemm g{XB, (const bf16*)(ws + WS_WGU2), M, 2 * FF, DM}; pg8::StaticOrder S; S.init(M, 2 * FF, gridDim.x, blockIdx.x);
        pg8::EpiSwiGLU E{ACT, ss + (size_t)2 * M * 16, FF}; pg8::gemm_phase<pg8::EpiSwiGLU, pg8::StaticOrder, true, true>(lds3, g, S, E, wave); } SEAM(10);
    if (IN(11)) REP(11) { pg8::Gemm g{ACT, (const bf16*)(ws + WS_WD2), M, DM, FF}; pg8::StaticOrder S; S.init(M, DM, gridDim.x, blockIdx.x);
        pg8::EpiRes E{p.out, p.out, nullptr, ss + (size_t)3 * M * 16, 0.5f}; pg8::gemm_phase<pg8::EpiRes, pg8::StaticOrder, true, true>(lds3, g, S, E, wave); } SEAM(11);
    if (IN(12)) REP(12) { final_norm(p, wave, lane_id()); }
#undef IN
#undef SEAM
}

extern "C" void kernel_launch(void* const* d_in, const int* in_sizes, int n_in, void* d_out, int out_size, void* d_ws, size_t ws_size, hipStream_t stream) {
    static int grid = 0;
    if (grid == 0) {
        if (n_in != 26 || out_size != M * DM || ws_size < WS_END) { fprintf(stderr, "kernel_launch: unexpected sizes n_in %d out %d ws %zu\n", n_in, out_size, ws_size); grid = -1; return; }
        int dev = 0, cus = 0, per_cu = 0;
        hipGetDevice(&dev); hipDeviceGetAttribute(&cus, hipDeviceAttributeMultiprocessorCount, dev);
        hipFuncSetAttribute((const void*)hymba_fwd, hipFuncAttributeMaxDynamicSharedMemorySize, LDS_BYTES);
        hipOccupancyMaxActiveBlocksPerMultiprocessor(&per_cu, (const void*)hymba_fwd, NTHR, LDS_BYTES);
        (void)hipGetLastError();
        if (per_cu < 1) per_cu = 1;
        grid = cus * per_cu; if (grid > 256) grid = 256;
        if (grid != 256) fprintf(stderr, "kernel_launch: grid %d (cus %d per_cu %d), kernel assumes 256\n", grid, cus, per_cu);
    }
    if (grid < 0) return;
    Params p{};
    for (int i = 0; i < 26; ++i) p.in[i] = (const float*)d_in[i];
    p.out = (float*)d_out; p.ws = (unsigned char*)d_ws; p.ph_lo = 0; p.ph_hi = NPHASE + 1;
    void* args[] = {&p};
    hipError_t e = hipLaunchCooperativeKernel((const void*)hymba_fwd, dim3(grid), dim3(NTHR), args, LDS_BYTES, stream);
    if (e != hipSuccess) fprintf(stderr, "cooperative launch failed: %s (grid %d)\n", hipGetErrorString(e), grid);
}
```

```cpp
#include <hip/hip_runtime.h>
#include <hip/hip_cooperative_groups.h>
#include <cstdio>
#include <cstdint>
namespace cg = cooperative_groups;
namespace pg8 {
#define PG8_LAS __attribute__((address_space(3)))
typedef unsigned short bf16_t;
typedef short bf16x8 __attribute__((ext_vector_type(8)));
typedef float f32x4 __attribute__((ext_vector_type(4)));
typedef unsigned u32x4 __attribute__((ext_vector_type(4)));
constexpr int BM = 256, BK = 64, HALF = 128, HTB = HALF * BK * 2  , STAGE_BYTES = 8 * HTB, NXCD = 8, WGM = 8;

__host__ __device__ __forceinline__ int lds_byte(int r, int c) { const int st = (r >> 4) * 2 + (c >> 5), rr = r & 15, cc = c & 31, ob = rr * 64 + cc * 2; return st * 1024 + (ob ^ (((ob >> 9) & 1) << 5)); }
__host__ __device__ __forceinline__ void stage_rc(int b, int& R, int& C) { const int st = b / 1024, sb = b % 1024, swz = sb ^ (((sb >> 9) & 1) << 5); R = (st >> 1) * 16 + swz / 64; C = (st & 1) * 32 + (swz % 64) / 2; }
__host__ __device__ __forceinline__ int perm32(int rho) { const int n = rho >> 4, i = rho & 15; return 8 * (i >> 2) + 4 * n + (i & 3); }

struct Unit { int pm, pn; };
struct Gemm { const bf16_t* A; const bf16_t* Bt; int M, N, K; };

struct StaticOrder {
    int nM, nN, nwg, G, c;
    __host__ __device__ void init(int M, int N, int G_, int c_) { nM = M / BM; nN = N / BM; nwg = nM * nN; G = G_; c = c_; }
    __host__ __device__ bool next(int i, Unit& u) const {
        const long L = (long)i * G + c; if (L >= nwg) return false;
        int wgid = (int)L; { const int q = nwg / NXCD, r = nwg % NXCD, xcd = wgid % NXCD, off = wgid / NXCD; wgid = (xcd < r ? xcd * (q + 1) : r * (q + 1) + (xcd - r) * q) + off; }
        const int nig = WGM * nN, gid = wgid / nig, fm = gid * WGM, gsz = (nM - fm) < WGM ? (nM - fm) : WGM;
        u.pm = fm + ((wgid % nig) % gsz); u.pn = (wgid % nig) / gsz; return true;
    }
    __device__ __forceinline__ void a_ready(const Unit&) const {}
    __device__ __forceinline__ void done(const Unit&) const {}
};

typedef float f32x2 __attribute__((ext_vector_type(2)));
typedef __bf16 bf16x2_t __attribute__((ext_vector_type(2)));
typedef unsigned u32x2 __attribute__((ext_vector_type(2)));
__device__ __forceinline__ unsigned cvt_pk_bf16(float lo, float hi) { f32x2 v = {lo, hi}; bf16x2_t b = __builtin_convertvector(v, bf16x2_t); return __builtin_bit_cast(unsigned, b); }
__device__ __forceinline__ float row_rstd(const float* ss, int row) {
    const f32x4* p = (const f32x4*)(ss + (size_t)row * 16); const f32x4 a = p[0], b = p[1], c = p[2], d = p[3];
    const float s = (((a[0] + a[1]) + (a[2] + a[3])) + ((b[0] + b[1]) + (b[2] + b[3]))) + (((c[0] + c[1]) + (c[2] + c[3])) + ((d[0] + d[1]) + (d[2] + d[3])));
    return 1.0f / sqrtf(s * (1.0f / 1024.0f) + 1e-5f);
}
__device__ __forceinline__ float silu_mul(float g, float u) { return g * __builtin_amdgcn_rcpf(1.0f + __expf(-g)) * u; }

struct EpiSwiGLU {
    static constexpr bool PERM = true, AFTER_DRAIN = false;
    bf16_t* O; const float* ss; int ldo;
    __device__ __forceinline__ void operator()(const f32x4 (&acc)[2][2][4][2], const Unit& u, int wr, int wc, int fr, int fq) const {
        const int row0 = u.pm * BM + wr * 64 + fr; const int col0 = u.pn * HALF + wc * 32 + 8 * fq;
#pragma unroll
        for (int ai = 0; ai < 2; ++ai)
#pragma unroll
            for (int m = 0; m < 4; ++m) { const int row = row0 + ai * HALF + m * 16; const float rs = row_rstd(ss, row);
                const f32x4 g0 = acc[ai][0][m][0] * rs, g1 = acc[ai][0][m][1] * rs, u0 = acc[ai][1][m][0] * rs, u1 = acc[ai][1][m][1] * rs;
                u32x4 w; w.x = cvt_pk_bf16(silu_mul(g0[0], u0[0]), silu_mul(g0[1], u0[1])); w.y = cvt_pk_bf16(silu_mul(g0[2], u0[2]), silu_mul(g0[3], u0[3]));
                w.z = cvt_pk_bf16(silu_mul(g1[0], u1[0]), silu_mul(g1[1], u1[1])); w.w = cvt_pk_bf16(silu_mul(g1[2], u1[2]), silu_mul(g1[3], u1[3]));
                *(u32x4*)(O + (size_t)row * ldo + col0) = w; }
    }
};
struct EpiRes {
    static constexpr bool PERM = false, AFTER_DRAIN = false;
    const float* base; float* out; bf16_t* xb; float* ss; float alpha;
    __device__ __forceinline__ void operator()(const f32x4 (&acc)[2][2][4][2], const Unit& u, int wr, int wc, int fr, int fq) const {
        const int row0 = u.pm * BM + wr * 64 + fr; const int col0 = u.pn * BM + wc * 32 + 4 * fq;
#pragma unroll
        for (int ai = 0; ai < 2; ++ai)
#pragma unroll
            for (int m = 0; m < 4; ++m) { const int row = row0 + ai * HALF + m * 16; const size_t off = (size_t)row * 1024 + col0; float sq = 0.f;
#pragma unroll
                for (int bj = 0; bj < 2; ++bj)
#pragma unroll
                    for (int n = 0; n < 2; ++n) { const f32x4 bs = *(const f32x4*)(base + off + bj * HALF + n * 16); const f32x4 o = bs + acc[ai][bj][m][n] * alpha;
                        *(f32x4*)(out + off + bj * HALF + n * 16) = o; sq += (o[0] * o[0] + o[1] * o[1]) + (o[2] * o[2] + o[3] * o[3]);
                        if (xb) { u32x2 w; w.x = cvt_pk_bf16(o[0], o[1]); w.y = cvt_pk_bf16(o[2], o[3]); *(u32x2*)(xb + off + bj * HALF + n * 16) = w; } }
                sq += __shfl_xor(sq, 16); sq += __shfl_xor(sq, 32);
                if (fq == 0) ss[(size_t)row * 16 + u.pn * 4 + wc] = sq; }
    }
};
struct EpiWin {
    static constexpr bool PERM = true, AFTER_DRAIN = false;
    bf16_t* O; const float* ss; const float* bias; int bias_from; int ldo;
    __device__ __forceinline__ void operator()(const f32x4 (&acc)[2][2][4][2], const Unit& u, int wr, int wc, int fr, int fq) const {
        const int row0 = u.pm * BM + wr * 64 + fr; const int col0 = u.pn * BM + wc * 32 + 8 * fq;
        f32x4 bv[2][2];
#pragma unroll
        for (int bj = 0; bj < 2; ++bj)
#pragma unroll
            for (int n = 0; n < 2; ++n) { const int c = col0 + bj * HALF + 4 * n; bv[bj][n] = (c >= bias_from) ? *(const f32x4*)(bias + (c - bias_from)) : (f32x4){0.f, 0.f, 0.f, 0.f}; }
#pragma unroll
        for (int ai = 0; ai < 2; ++ai)
#pragma unroll
            for (int m = 0; m < 4; ++m) { const int row = row0 + ai * HALF + m * 16; const float rs = row_rstd(ss, row);
#pragma unroll
                for (int bj = 0; bj < 2; ++bj) { const f32x4 v0 = acc[ai][bj][m][0] * rs + bv[bj][0], v1 = acc[ai][bj][m][1] * rs + bv[bj][1];
                    u32x4 w; w.x = cvt_pk_bf16(v0[0], v0[1]); w.y = cvt_pk_bf16(v0[2], v0[3]); w.z = cvt_pk_bf16(v1[0], v1[1]); w.w = cvt_pk_bf16(v1[2], v1[3]);
                    *(u32x4*)(O + (size_t)row * ldo + col0 + bj * HALF) = w; } }
    }
};
struct EpiLora {
    static constexpr bool PERM = true, AFTER_DRAIN = false;
    float* DEC; bf16_t* AA; bf16_t* GG; const float* w0; const float* a0;
    __device__ __forceinline__ void operator()(const f32x4 (&acc)[2][2][4][2], const Unit& u, int wr, int wc, int fr, int fq) const {
        const int row0 = u.pm * BM + wr * 64 + fr; const int kind = u.pn >> 1; const int col0 = (u.pn & 1) * BM + wc * 32 + 8 * fq;
#pragma unroll
        for (int bj = 0; bj < 2; ++bj) { const int c = col0 + bj * HALF;
            f32x4 b0 = (f32x4){0.f, 0.f, 0.f, 0.f}, b1 = b0;
            if (kind == 0) { b0 = *(const f32x4*)(w0 + c); b1 = *(const f32x4*)(w0 + c + 4); } else if (kind == 1) { b0 = *(const f32x4*)(a0 + c); b1 = *(const f32x4*)(a0 + c + 4); }
#pragma unroll
            for (int ai = 0; ai < 2; ++ai)
#pragma unroll
                for (int m = 0; m < 4; ++m) { const int row = row0 + ai * HALF + m * 16; f32x4 v0 = acc[ai][bj][m][0] + b0, v1 = acc[ai][bj][m][1] + b1;
                    if (kind == 0) {
#pragma unroll
                        for (int e = 0; e < 4; ++e) { v0[e] = expf(-0.60653065971f / (1.0f + expf(-v0[e]))); v1[e] = expf(-0.60653065971f / (1.0f + expf(-v1[e]))); }
                        *(f32x4*)(DEC + (size_t)row * 512 + c) = v0; *(f32x4*)(DEC + (size_t)row * 512 + c + 4) = v1;
                    } else {
                        if (kind == 1) {
#pragma unroll
                            for (int e = 0; e < 4; ++e) { v0[e] = 1.0f / (1.0f + expf(-v0[e])); v1[e] = 1.0f / (1.0f + expf(-v1[e])); } }
                        u32x4 w; w.x = cvt_pk_bf16(v0[0], v0[1]); w.y = cvt_pk_bf16(v0[2], v0[3]); w.z = cvt_pk_bf16(v1[0], v1[1]); w.w = cvt_pk_bf16(v1[2], v1[3]);
                        *(u32x4*)((kind == 1 ? AA : GG) + (size_t)row * 512 + c) = w; } }
        }
    }
};

template <class Epi, class Sched, bool ALIGN_EPI = false, bool SP2 = false>
__device__ __forceinline__ void gemm_phase(PG8_LAS unsigned char* lds, const Gemm g, const Sched& S, const Epi& E, const int wid) {
    const int lane = (int)__builtin_amdgcn_mbcnt_hi(~0u, __builtin_amdgcn_mbcnt_lo(~0u, 0u)), tid = (wid << 6) | lane, wr = wid >> 2, wc = wid & 3, fr = lane & 15, fq = lane >> 4;
    int K = g.K; asm volatile("" : "+s"(K)); const int nt = K / BK;
    unsigned voffA[2], voffB[2];
#pragma unroll
    for (int i = 0; i < 2; ++i) { int R, C; stage_rc(tid * 16 + i * 8192, R, C); const int Rb = Epi::PERM ? ((R & ~31) + perm32(R & 31)) : R;
        voffA[i] = (unsigned)(R * K + C) * 2u; voffB[i] = (unsigned)(Rb * K + C) * 2u; }
    const size_t kstep = (size_t)(BK * 2);
    const size_t hstep = (size_t)HALF * K * 2;
    const size_t tstep = 2 * hstep;
    const unsigned ldsw = (unsigned)wid * 1024u;
    const int aoff = lds_byte(wr * 64 + fr, fq * 8), boff = lds_byte(wc * 32 + fr, fq * 8);
#define PG8_SA(b, h) (((b) * 2 + (h)) * HTB)
#define PG8_SB(b, h) ((4 + (b) * 2 + (h)) * HTB)
#define PG8_STAGE(bufoff, gbase, voff) do { _Pragma("unroll") for (int _i = 0; _i < 2; ++_i) \
        __builtin_amdgcn_global_load_lds((const unsigned*)((const char*)(gbase) + (voff)[_i]), (PG8_LAS unsigned*)(lds + (bufoff) + ldsw + _i * 8192), 16, 0, 0); } while (0)
#define PG8_LDA(dst, b, h) do { _Pragma("unroll") for (int m = 0; m < 4; ++m) _Pragma("unroll") for (int k = 0; k < 2; ++k) dst[m][k] = *(const PG8_LAS bf16x8*)(lds + PG8_SA(b, h) + aoff + m * 2048 + k * 1024); } while (0)
#define PG8_LDB(dst, b, h) do { _Pragma("unroll") for (int n = 0; n < 2; ++n) _Pragma("unroll") for (int k = 0; k < 2; ++k) dst[n][k] = *(const PG8_LAS bf16x8*)(lds + PG8_SB(b, h) + boff + n * 2048 + k * 1024); } while (0)
#define PG8_MMA(ai, bj, At, Bt) do { __builtin_amdgcn_s_setprio(1); _Pragma("unroll") for (int m = 0; m < 4; ++m) _Pragma("unroll") for (int n = 0; n < 2; ++n) _Pragma("unroll") for (int k = 0; k < 2; ++k) \
        acc[ai][bj][m][n] = __builtin_amdgcn_mfma_f32_16x16x32_bf16(Bt[n][k], At[m][k], acc[ai][bj][m][n], 0, 0, 0); __builtin_amdgcn_s_setprio(0); } while (0)
#define PG8_WAIT_V(n) asm volatile("s_waitcnt vmcnt(" #n ")" ::: "memory")
#define PG8_WAIT_L(n) asm volatile("s_waitcnt lgkmcnt(" #n ")" ::: "memory")
#define PG8_BAR __builtin_amdgcn_s_barrier()
#define PG8_SCHED __builtin_amdgcn_sched_barrier(0)
    Unit cur, nxt; int ui = 0;
    if (!S.next(0, cur)) return;
    f32x4 acc[2][2][4][2];
#pragma unroll
    for (int a = 0; a < 2; ++a)
#pragma unroll
        for (int b = 0; b < 2; ++b)
#pragma unroll
            for (int m = 0; m < 4; ++m)
#pragma unroll
                for (int n = 0; n < 2; ++n) acc[a][b][m][n] = (f32x4){0.f, 0.f, 0.f, 0.f};
    bf16x8 At[4][2], B0[2][2], B1[2][2];
    const char* cA = (const char*)g.A + (size_t)cur.pm * tstep; const char* cB = (const char*)g.Bt + (size_t)cur.pn * tstep;
    S.a_ready(cur);
    if constexpr (SP2) {
        PG8_STAGE(PG8_SB(0, 0), cB, voffB); PG8_STAGE(PG8_SB(0, 1), cB + hstep, voffB); PG8_STAGE(PG8_SA(0, 0), cA, voffA); PG8_STAGE(PG8_SA(0, 1), cA + hstep, voffA);
        if (wr == 1) PG8_BAR;
        PG8_WAIT_V(2); PG8_BAR;
        PG8_STAGE(PG8_SB(1, 0), cB + kstep, voffB); PG8_STAGE(PG8_SA(1, 0), cA + kstep, voffA); PG8_STAGE(PG8_SB(1, 1), cB + hstep + kstep, voffB);
        PG8_WAIT_V(6); PG8_BAR;
    } else {
        PG8_STAGE(PG8_SB(0, 0), cB, voffB); PG8_STAGE(PG8_SA(0, 0), cA, voffA); PG8_STAGE(PG8_SB(0, 1), cB + hstep, voffB); PG8_STAGE(PG8_SA(0, 1), cA + hstep, voffA);
        if (wr == 1) PG8_BAR;
        PG8_WAIT_V(4); PG8_BAR;
        PG8_STAGE(PG8_SB(1, 0), cB + kstep, voffB); PG8_STAGE(PG8_SA(1, 0), cA + kstep, voffA); PG8_STAGE(PG8_SB(1, 1), cB + hstep + kstep, voffB);
        PG8_WAIT_V(6); PG8_BAR;
    }
    for (;;) {
        const bool has_next = S.next(ui + 1, nxt);
        const char* nA = has_next ? (const char*)g.A + (size_t)nxt.pm * tstep : cA; const char* nB = has_next ? (const char*)g.Bt + (size_t)nxt.pn * tstep : cB;
        for (int t = 0; t < nt; t += 2) {
            const bool last = (t == nt - 2);
            const char* a1 = cA + (size_t)(t + 1) * kstep;
            const char* a2 = last ? nA : cA + (size_t)(t + 2) * kstep; const char* b2 = last ? nB : cB + (size_t)(t + 2) * kstep;
            const char* a3 = a2 + kstep; const char* b3 = b2 + kstep;
            if (last && has_next) S.a_ready(nxt);
            if constexpr (SP2) {
            PG8_LDB(B0, 0, 0); PG8_LDB(B1, 0, 1); PG8_SCHED; PG8_LDA(At, 0, 0); PG8_STAGE(PG8_SA(1, 1), a1 + hstep, voffA);
            PG8_WAIT_V(8); PG8_WAIT_L(0); PG8_BAR; PG8_MMA(0, 0, At, B0); PG8_MMA(0, 1, At, B1); PG8_BAR; PG8_SCHED;
            PG8_LDA(At, 0, 1); PG8_STAGE(PG8_SB(0, 0), b2, voffB); PG8_STAGE(PG8_SB(0, 1), b2 + hstep, voffB); PG8_STAGE(PG8_SA(0, 0), a2, voffA);
            PG8_WAIT_V(8); PG8_WAIT_L(0); PG8_BAR; PG8_MMA(1, 0, At, B0); PG8_MMA(1, 1, At, B1); PG8_BAR; PG8_SCHED;
            PG8_LDB(B0, 1, 0); PG8_LDB(B1, 1, 1); PG8_SCHED; PG8_LDA(At, 1, 0); PG8_STAGE(PG8_SA(0, 1), a2 + hstep, voffA);
            PG8_WAIT_V(8); PG8_WAIT_L(0); PG8_BAR; PG8_MMA(0, 0, At, B0); PG8_MMA(0, 1, At, B1); PG8_BAR; PG8_SCHED;
            PG8_LDA(At, 1, 1); PG8_STAGE(PG8_SB(1, 0), b3, voffB); PG8_STAGE(PG8_SB(1, 1), b3 + hstep, voffB); PG8_STAGE(PG8_SA(1, 0), a3, voffA);
            PG8_WAIT_V(8); PG8_WAIT_L(0); PG8_BAR; PG8_MMA(1, 0, At, B0); PG8_MMA(1, 1, At, B1); PG8_BAR; PG8_SCHED;
            } else {
            PG8_LDB(B0, 0, 0); PG8_SCHED; PG8_LDA(At, 0, 0); PG8_STAGE(PG8_SA(1, 1), a1 + hstep, voffA);
            PG8_WAIT_L(8); PG8_BAR; PG8_WAIT_L(0); PG8_MMA(0, 0, At, B0); PG8_BAR; PG8_SCHED;
            PG8_LDB(B1, 0, 1); PG8_STAGE(PG8_SB(0, 0), b2, voffB);
            PG8_BAR; PG8_WAIT_L(0); PG8_MMA(0, 1, At, B1); PG8_BAR;
            PG8_LDA(At, 0, 1); PG8_STAGE(PG8_SA(0, 0), a2, voffA);
            PG8_BAR; PG8_WAIT_L(0); PG8_MMA(1, 0, At, B0); PG8_BAR; PG8_SCHED;
            PG8_STAGE(PG8_SB(0, 1), b2 + hstep, voffB);
            PG8_WAIT_V(6); PG8_BAR; PG8_MMA(1, 1, At, B1); PG8_BAR;
            PG8_LDB(B0, 1, 0); PG8_SCHED; PG8_LDA(At, 1, 0); PG8_STAGE(PG8_SA(0, 1), a2 + hstep, voffA);
            PG8_WAIT_L(8); PG8_BAR; PG8_WAIT_L(0); PG8_MMA(0, 0, At, B0); PG8_BAR; PG8_SCHED;
            PG8_LDB(B1, 1, 1); PG8_STAGE(PG8_SB(1, 0), b3, voffB);
            PG8_BAR; PG8_WAIT_L(0); PG8_MMA(0, 1, At, B1); PG8_BAR;
            PG8_LDA(At, 1, 1); PG8_STAGE(PG8_SA(1, 0), a3, voffA);
            PG8_BAR; PG8_WAIT_L(0); PG8_MMA(1, 0, At, B0); PG8_BAR; PG8_SCHED;
            PG8_STAGE(PG8_SB(1, 1), b3 + hstep, voffB);
            PG8_WAIT_V(6); PG8_BAR; PG8_MMA(1, 1, At, B1); PG8_BAR;
            }
        }
        if constexpr (ALIGN_EPI) { if (wr == 0) PG8_BAR; }
        if constexpr (!Epi::AFTER_DRAIN) { E(acc, cur, wr, wc, fr, fq); S.done(cur); }
        if (!has_next) break;
#pragma unroll
        for (int a = 0; a < 2; ++a)
#pragma unroll
            for (int b = 0; b < 2; ++b)
#pragma unroll
                for (int m = 0; m < 4; ++m)
#pragma unroll
                    for (int n = 0; n < 2; ++n) acc[a][b][m][n] = (f32x4){0.f, 0.f, 0.f, 0.f};
        cur = nxt; cA = nA; cB = nB; ++ui;
        if constexpr (ALIGN_EPI) { if (wr == 1) PG8_BAR; }
    }
    PG8_WAIT_V(0);
    if constexpr (!ALIGN_EPI) { if (wr == 0) PG8_BAR; }
    PG8_BAR;
    if constexpr (Epi::AFTER_DRAIN) { E.fused(acc, cur, wr, wc, fr, fq, lds, wid, lane); S.done(cur); }
#undef PG8_SA
#undef PG8_SB
#undef PG8_STAGE
#undef PG8_LDA
#undef PG8_LDB
#undef PG8_MMA
#undef PG8_WAIT_V
#undef PG8_WAIT_L
#undef PG8_BAR
#undef PG8_SCHED
}
}

constexpr int BATCH = 2, SEQ = 8192, DM = 1024, FF = 2816, NIN = 2560, RW = 512, M = BATCH * SEQ;
constexpr int NWAVES = 8, NTHR = 512;
constexpr int CH = 128, NCH = SEQ / CH;
constexpr size_t MiB = 1u << 20;
constexpr size_t WS_WGU1 = 0, WS_WD1 = 11 * MiB, WS_WIN = WS_WD1 + 11 * MiB / 2, WS_WOUT = WS_WIN + 5 * MiB, WS_WGU2 = WS_WOUT + 2 * MiB, WS_WD2 = WS_WGU2 + 11 * MiB, WS_WL = 40 * MiB;
constexpr size_t WS_GG = 0;
constexpr size_t WS_XB = 44 * MiB;
constexpr size_t WS_PST = 44 * MiB, WS_LST = 60 * MiB;
constexpr size_t WS_BIG = 76 * MiB;
constexpr size_t WS_LIN = WS_BIG + 80 * MiB;
constexpr size_t WS_DEC = 164 * MiB, WS_AA = 196 * MiB, WS_MIX = 212 * MiB, WS_SS = 244 * MiB, WS_CTL = 248 * MiB, WS_END = 249 * MiB;
static_assert(WS_WD2 + 11 * MiB / 2 <= WS_WL && WS_WL + MiB <= WS_XB, "weights map");

#define LAS __attribute__((address_space(3)))
typedef unsigned short bf16;
typedef unsigned v4u __attribute__((ext_vector_type(4)));
typedef unsigned v2u __attribute__((ext_vector_type(2)));
typedef float f32x4 __attribute__((ext_vector_type(4)));
typedef float f32x2 __attribute__((ext_vector_type(2)));
typedef short bf16x8 __attribute__((ext_vector_type(8)));
using pg8::cvt_pk_bf16;
__device__ __forceinline__ float bflo(unsigned u) { return __uint_as_float(u << 16); }
__device__ __forceinline__ float bfhi(unsigned u) { return __uint_as_float(u & 0xffff0000u); }
template <int CTRL> __device__ __forceinline__ float dpp_mov(float x) { return __builtin_bit_cast(float, __builtin_amdgcn_update_dpp(0, __builtin_bit_cast(int, x), CTRL, 0xF, 0xF, true)); }
__device__ __forceinline__ float sum16(float x) { x += dpp_mov<0xB1>(x); x += dpp_mov<0x4E>(x); x += dpp_mov<0x141>(x); x += dpp_mov<0x140>(x); return x; }
__device__ __forceinline__ float max16(float x) { x = fmaxf(x, dpp_mov<0xB1>(x)); x = fmaxf(x, dpp_mov<0x4E>(x)); x = fmaxf(x, dpp_mov<0x141>(x)); x = fmaxf(x, dpp_mov<0x140>(x)); return x; }
__device__ __forceinline__ float sum8(float x) { x += dpp_mov<0xB1>(x); x += dpp_mov<0x4E>(x); x += dpp_mov<0x141>(x); return x; }
__device__ __forceinline__ float wave_sum(float v) {
#pragma unroll
    for (int o = 1; o < 64; o <<= 1) v += __shfl_xor(v, o);
    return v;
}

__device__ __forceinline__ int lane_id() { return (int)__builtin_amdgcn_mbcnt_hi(~0u, __builtin_amdgcn_mbcnt_lo(~0u, 0u)); }
#define TIDX ((wave << 6) | lane_id())
struct Params {
    const float* in[26]; float* out; unsigned char* ws; int ph_lo, ph_hi;
};


#define GAS __attribute__((address_space(1)))
__device__ __forceinline__ const float* inp(int i) {
    const __attribute__((address_space(4))) char* ka = (const __attribute__((address_space(4))) char*)__builtin_amdgcn_kernarg_segment_ptr();
    int off = i * 8; asm volatile("" : "+s"(off));
    const float* q = *(const float* const __attribute__((address_space(4)))*)(ka + off);
    return (const float*)(const GAS float*)q;
}

__device__ __forceinline__ void conv_item(const float* W, int K, int N, const float* sc, bf16* WT, int k0, int n0, int drow0, float* scr, int lane) {
#pragma unroll 8
    for (int i = 0; i < 32; ++i) { const int kk = 2 * i + (lane >> 5); float v = W[(size_t)(k0 + kk) * N + n0 + (lane & 31)]; if (sc) v *= sc[k0 + kk]; scr[kk * 33 + (lane & 31)] = v; }
    __builtin_amdgcn_fence(__ATOMIC_RELEASE, "wavefront"); asm volatile("s_waitcnt lgkmcnt(0)" ::: "memory");
    const int c = lane & 7;
#pragma unroll
    for (int j = 0; j < 4; ++j) { const int n = (lane >> 3) + 8 * j; const float* s = scr + (8 * c) * 33 + n;
        v4u o; o.x = cvt_pk_bf16(s[0 * 33], s[1 * 33]); o.y = cvt_pk_bf16(s[2 * 33], s[3 * 33]); o.z = cvt_pk_bf16(s[4 * 33], s[5 * 33]); o.w = cvt_pk_bf16(s[6 * 33], s[7 * 33]);
        *(v4u*)(WT + (size_t)(drow0 + n) * K + k0 + 8 * c) = o; }
    asm volatile("s_waitcnt lgkmcnt(0)" ::: "memory");
}
__device__ __forceinline__ void conv_plain(const float* W, int K, int N, const float* sc, bf16* WT, int item, float* scr, int lane) {
    const int nblk = N / 32, kb = item / nblk, nb = item % nblk; conv_item(W, K, N, sc, WT, 64 * kb, 32 * nb, 32 * nb, scr, lane);
}
__device__ __forceinline__ void conv_gu(const float* W, const float* sc, bf16* WT, int item, int up, float* scr, int lane) {
    const int nblk = FF / 32, kb = item / nblk, nb = item % nblk, n0 = 32 * nb; conv_item(W, DM, FF, sc, WT, 64 * kb, n0, (n0 >> 7) * 256 + up * 128 + (n0 & 127), scr, lane);
}
__device__ __forceinline__ void p0_prologue(const Params& p, unsigned char* lds, int wave, int lane) {
    float* scr = (float*)(lds + wave * 16384);
    unsigned char* ws = p.ws;
    const int gw = blockIdx.x * NWAVES + wave, NGW = gridDim.x * NWAVES;
    constexpr int I_GU = (DM / 64) * (FF / 32), I_DN = (FF / 64) * (DM / 32), I_IN = (DM / 64) * (NIN / 32), I_OUT = (DM / 64) * (DM / 32);
    constexpr int NITEMS = 4 * I_GU + 2 * I_DN + I_IN + I_OUT;
    for (int it = gw; it < NITEMS; it += NGW) {
        int r = it;
        if (r < I_GU) { conv_gu(inp(2), inp(1), (bf16*)(ws + WS_WGU1), r, 0, scr, lane); continue; } r -= I_GU;
        if (r < I_GU) { conv_gu(inp(3), inp(1), (bf16*)(ws + WS_WGU1), r, 1, scr, lane); continue; } r -= I_GU;
        if (r < I_DN) { conv_plain(inp(4), FF, DM, nullptr, (bf16*)(ws + WS_WD1), r, scr, lane); continue; } r -= I_DN;
        if (r < I_IN) { conv_plain(inp(6), DM, NIN, inp(5), (bf16*)(ws + WS_WIN), r, scr, lane); continue; } r -= I_IN;
        if (r < I_OUT) { conv_plain(inp(20), DM, DM, nullptr, (bf16*)(ws + WS_WOUT), r, scr, lane); continue; } r -= I_OUT;
        if (r < I_GU) { conv_gu(inp(22), inp(21), (bf16*)(ws + WS_WGU2), r, 0, scr, lane); continue; } r -= I_GU;
        if (r < I_GU) { conv_gu(inp(23), inp(21), (bf16*)(ws + WS_WGU2), r, 1, scr, lane); continue; } r -= I_GU;
        conv_plain(inp(24), FF, DM, nullptr, (bf16*)(ws + WS_WD2), r, scr, lane);
    }
    { bf16* WL = (bf16*)(ws + WS_WL); const float* w2 = inp(10); const float* a2 = inp(12); const float* g2 = inp(13);
      for (int idx = (blockIdx.x * NTHR + TIDX); idx < 1536 * 128; idx += gridDim.x * NTHR) {
          const int n = idx >> 7, k = (idx & 127) * 2; float v0 = 0.f, v1 = 0.f;
          if (n < 512) { if (k < 64) { v0 = w2[k * 512 + n]; v1 = w2[(k + 1) * 512 + n]; } }
          else if (n < 1024) { if (k >= 64 && k < 128) { v0 = a2[(k - 64) * 512 + n - 512]; v1 = a2[(k - 63) * 512 + n - 512]; } }
          else { if (k >= 128) { v0 = g2[(k - 128) * 512 + n - 1024]; v1 = g2[(k - 127) * 512 + n - 1024]; } }
          *(unsigned*)(WL + (size_t)n * 256 + k) = cvt_pk_bf16(v0, v1); } }
    { const float* x = inp(0); bf16* XB = (bf16*)(ws + WS_XB); float* ss0 = (float*)(ws + WS_SS);
      for (int m = gw; m < M; m += NGW) { const f32x4* xr = (const f32x4*)(x + (size_t)m * DM) + lane; float s = 0.f; f32x4 v[4];
#pragma unroll
          for (int j = 0; j < 4; ++j) { v[j] = xr[64 * j]; s += (v[j][0] * v[j][0] + v[j][1] * v[j][1]) + (v[j][2] * v[j][2] + v[j][3] * v[j][3]); }
          s = wave_sum(s);
          v2u* o8 = (v2u*)(XB + (size_t)m * DM) + lane;
#pragma unroll
          for (int j = 0; j < 4; ++j) { v2u w; w.x = cvt_pk_bf16(v[j][0], v[j][1]); w.y = cvt_pk_bf16(v[j][2], v[j][3]); o8[64 * j] = w; }
          if (lane < 16) ss0[(size_t)m * 16 + lane] = (lane == 0) ? s : 0.f; } }
}

__device__ __forceinline__ void r1_phase(const Params& p, int wave) {
    const bf16* P = (const bf16*)(p.ws + WS_BIG); bf16* LIN = (bf16*)(p.ws + WS_LIN); const float* mix = inp(8);
    for (int idx = blockIdx.x * NTHR + TIDX; idx < M * 32; idx += gridDim.x * NTHR) {
        const int row = idx >> 5, g8 = idx & 31, col = 1536 + 8 * g8; const bool hp = (row & (SEQ - 1)) != 0;
        const v4u c = *(const v4u*)(P + (size_t)row * NIN + col); v4u q = (v4u){0u, 0u, 0u, 0u}; if (hp) q = *(const v4u*)(P + (size_t)(row - 1) * NIN + col);
        const f32x4 m0 = *(const f32x4*)(mix + col), m1 = *(const f32x4*)(mix + col + 4);
        float x[8];
#pragma unroll
        for (int e = 0; e < 4; ++e) { const float c0 = bflo(c[e]), c1 = bfhi(c[e]), q0 = bflo(q[e]), q1 = bfhi(q[e]); const float ma = (e < 2) ? m0[2 * e] : m1[2 * e - 4], mb = (e < 2) ? m0[2 * e + 1] : m1[2 * e - 3];
            x[2 * e] = c0 + (q0 - c0) * ma; x[2 * e + 1] = c1 + (q1 - c1) * mb; }
        if (g8 < 8) {
#pragma unroll
            for (int e = 0; e < 8; ++e) x[e] = tanhf(x[e]);
        } else if (g8 >= 16) {
#pragma unroll
            for (int e = 0; e < 8; ++e) x[e] = 1.0f / (1.0f + expf(-x[e]));
        }
        v4u o; o.x = cvt_pk_bf16(x[0], x[1]); o.y = cvt_pk_bf16(x[2], x[3]); o.z = cvt_pk_bf16(x[4], x[5]); o.w = cvt_pk_bf16(x[6], x[7]);
        *(v4u*)(LIN + (size_t)row * 256 + 8 * g8) = o;
    }
}

constexpr int SC_W = 0, SC_B = 1, SC_K = 2, SC_KK = 3, SC_V = 4, SC_R = 5, SC_O = 6, SC_BC = 7;
template <bool P3> __device__ __forceinline__ void scan_load(const Params& p, float* sm, int b, int h, int t0, int wave) {
    const int tid = TIDX, tt = tid >> 3, c8 = (tid & 7) * 8, hc = h * 64 + c8;
    const bf16* P = (const bf16*)(p.ws + WS_BIG); const float* DEC = (const float*)(p.ws + WS_DEC); const bf16* AA = (const bf16*)(p.ws + WS_AA);
    const float* mix = inp(8); const float* k_k = inp(14); const float* k_a = inp(15); const float* r_k = inp(16);
    const int gr = b * SEQ + t0 + tt; const bool hp = (t0 + tt) > 0;
    const bf16* prow = P + (size_t)gr * NIN + hc;
    float r[8], k[8], v[8];
#define SHIFT_LOAD(dst, off) do { const v4u c_ = *(const v4u*)(prow + (off)); v4u q_ = (v4u){0u, 0u, 0u, 0u}; if (hp) q_ = *(const v4u*)(prow + (off) - NIN); \
        const f32x4 m0_ = *(const f32x4*)(mix + hc + (off)), m1_ = *(const f32x4*)(mix + hc + (off) + 4); \
        _Pragma("unroll") for (int e = 0; e < 4; ++e) { const float c0 = bflo(c_[e]), c1 = bfhi(c_[e]), q0 = bflo(q_[e]), q1 = bfhi(q_[e]); const float ma = (e < 2) ? m0_[2 * e] : m1_[2 * e - 4], mb = (e < 2) ? m0_[2 * e + 1] : m1_[2 * e - 3]; \
            dst[2 * e] = c0 + (q0 - c0) * ma; dst[2 * e + 1] = c1 + (q1 - c1) * mb; } } while (0)
    SHIFT_LOAD(k, 512); SHIFT_LOAD(v, 1024);
    if (P3) SHIFT_LOAD(r, 0);
#undef SHIFT_LOAD
    const f32x4 d0 = *(const f32x4*)(DEC + (size_t)gr * RW + hc), d1 = *(const f32x4*)(DEC + (size_t)gr * RW + hc + 4);
    const v4u av = *(const v4u*)(AA + (size_t)gr * RW + hc);
    const f32x4 kk0 = *(const f32x4*)(k_k + hc), kk1 = *(const f32x4*)(k_k + hc + 4), ka0 = *(const f32x4*)(k_a + hc), ka1 = *(const f32x4*)(k_a + hc + 4);
    float a[8], kk[8], kp[8], bb[8]; float ssq = 0.f;
#pragma unroll
    for (int e = 0; e < 4; ++e) { a[2 * e] = bflo(av[e]); a[2 * e + 1] = bfhi(av[e]); }
#pragma unroll
    for (int e = 0; e < 8; ++e) { const float kkw = (e < 4) ? kk0[e] : kk1[e - 4], kaw = (e < 4) ? ka0[e] : ka1[e - 4];
        kk[e] = k[e] * kkw; ssq += kk[e] * kk[e]; kp[e] = k[e] * (1.0f + (a[e] - 1.0f) * kaw); }
    ssq = sum8(ssq);
    const float inv = 1.0f / fmaxf(sqrtf(ssq), 1e-12f);
#pragma unroll
    for (int e = 0; e < 8; ++e) { kk[e] *= inv; bb[e] = kk[e] * a[e]; }
    float* base = sm + tt * 64 + c8;
    *(f32x4*)(base + SC_W * 4096) = d0; *(f32x4*)(base + SC_W * 4096 + 4) = d1;
    *(f32x4*)(base + SC_B * 4096) = (f32x4){bb[0], bb[1], bb[2], bb[3]}; *(f32x4*)(base + SC_B * 4096 + 4) = (f32x4){bb[4], bb[5], bb[6], bb[7]};
    *(f32x4*)(base + SC_K * 4096) = (f32x4){kp[0], kp[1], kp[2], kp[3]}; *(f32x4*)(base + SC_K * 4096 + 4) = (f32x4){kp[4], kp[5], kp[6], kp[7]};
    *(f32x4*)(base + SC_KK * 4096) = (f32x4){kk[0], kk[1], kk[2], kk[3]}; *(f32x4*)(base + SC_KK * 4096 + 4) = (f32x4){kk[4], kk[5], kk[6], kk[7]};
    *(f32x4*)(base + SC_V * 4096) = (f32x4){v[0], v[1], v[2], v[3]}; *(f32x4*)(base + SC_V * 4096 + 4) = (f32x4){v[4], v[5], v[6], v[7]};
    if (P3) {
        *(f32x4*)(base + SC_R * 4096) = (f32x4){r[0], r[1], r[2], r[3]}; *(f32x4*)(base + SC_R * 4096 + 4) = (f32x4){r[4], r[5], r[6], r[7]};
        const f32x4 rk0 = *(const f32x4*)(r_k + hc), rk1 = *(const f32x4*)(r_k + hc + 4); float bc = 0.f;
#pragma unroll
        for (int e = 0; e < 8; ++e) bc += r[e] * kp[e] * ((e < 4) ? rk0[e] : rk1[e - 4]);
        bc = sum8(bc);
        if ((tid & 7) == 0) sm[SC_BC * 4096 + tt] = bc;
    }
}
#define LO2(v) __builtin_shufflevector(v, v, 0, 1)
#define HI2(v) __builtin_shufflevector(v, v, 2, 3)
template <int RPL, bool WITH_O, bool REAL> __device__ __forceinline__ void scan_run(const float* sm, f32x2 (&S)[RPL][2], int cs, int rowbase) {
#pragma unroll 2
    for (int t = 0; t < 64; ++t) {
        const float* st = sm + t * 64 + 4 * cs;
        const f32x4 w4 = *(const f32x4*)(st + SC_W * 4096), b4 = *(const f32x4*)(st + SC_B * 4096), kk4 = *(const f32x4*)(st + SC_KK * 4096);
        const f32x2 w01 = LO2(w4), w23 = HI2(w4), b01 = LO2(b4), b23 = HI2(b4), kk01 = LO2(kk4), kk23 = HI2(kk4);
        f32x2 k01 = (f32x2){0.f, 0.f}, k23 = k01, r01 = k01, r23 = k01;
        if (REAL) { const f32x4 k4 = *(const f32x4*)(st + SC_K * 4096); k01 = LO2(k4); k23 = HI2(k4); }
        if (WITH_O) { const f32x4 r4 = *(const f32x4*)(st + SC_R * 4096); r01 = LO2(r4); r23 = HI2(r4); }
        float vv[RPL];
        if (REAL) {
            if (RPL == 4) { const f32x4 v4 = *(const f32x4*)(sm + SC_V * 4096 + t * 64 + rowbase); vv[0] = v4[0]; vv[1] = v4[1]; vv[RPL - 2] = v4[2]; vv[RPL - 1] = v4[3]; }
            else { const f32x2 v2 = *(const f32x2*)(sm + SC_V * 4096 + t * 64 + rowbase); vv[0] = v2[0]; vv[RPL - 1] = v2[1]; }
        }
        float oo[RPL];
#pragma unroll
        for (int j = 0; j < RPL; ++j) {
            f32x2 pp = S[j][0] * kk01; pp = S[j][1] * kk23 + pp;
            const float nsa = -sum16(pp[0] + pp[1]);
            const f32x2 nsa2 = (f32x2){nsa, nsa};
            f32x2 t01 = nsa2 * b01, t23 = nsa2 * b23;
            if (REAL) { const f32x2 v2 = (f32x2){vv[j], vv[j]}; t01 = v2 * k01 + t01; t23 = v2 * k23 + t23; }
            S[j][0] = S[j][0] * w01 + t01; S[j][1] = S[j][1] * w23 + t23;
            if (WITH_O) { f32x2 qq = S[j][0] * r01; qq = S[j][1] * r23 + qq; oo[j] = sum16(qq[0] + qq[1]); }
        }
        if (WITH_O) { if (cs == 0) {
#pragma unroll
            for (int j = 0; j < RPL; ++j) ((float*)sm)[SC_O * 4096 + t * 64 + rowbase + j] = oo[j]; } }
    }
}
__device__ __forceinline__ void scan_pass1(const Params& p, float* sm, int wave, int lane) {
    float* PST = (float*)(p.ws + WS_PST); float* LST = (float*)(p.ws + WS_LST);
    const int cs = lane & 15, rg = lane >> 4; const bool real = wave < 4; const int rowbase = (wave & 3) * 16 + rg * 4;
    constexpr int NU = BATCH * (NCH - 1) * 8;
    for (int u = blockIdx.x; u < NU; u += gridDim.x) {
        const int h = u & 7, bc = u >> 3, c = bc % (NCH - 1), b = bc / (NCH - 1);
        f32x2 S[4][2];
#pragma unroll
        for (int j = 0; j < 4; ++j)
#pragma unroll
            for (int e = 0; e < 4; ++e) S[j][e >> 1][e & 1] = (!real && (rowbase + j == 4 * cs + e)) ? 1.0f : 0.0f;
        for (int sub = 0; sub < 2; ++sub) {
            __syncthreads();
            scan_load<false>(p, sm, b, h, c * CH + sub * 64, wave);
            __syncthreads();
            if (real) scan_run<4, false, true>(sm, S, cs, rowbase); else scan_run<4, false, false>(sm, S, cs, rowbase);
        }
        float* dst = (real ? LST : PST) + ((size_t)((b * NCH + c) * 8 + h)) * 4096 + rowbase * 64 + 4 * cs;
#pragma unroll
        for (int j = 0; j < 4; ++j) *(f32x4*)(dst + j * 64) = (f32x4){S[j][0][0], S[j][0][1], S[j][1][0], S[j][1][1]};
    }
}
__device__ __forceinline__ void scan_pass2(const Params& p, float* sm, int wave) {
    const float* PST = (const float*)(p.ws + WS_PST); float* LST = (float*)(p.ws + WS_LST);
    const int lane = lane_id(), tid = (wave << 6) | lane, vb = (blockIdx.x & 7) * (gridDim.x >> 3) + (blockIdx.x >> 3);
    if (vb >= 128) return;
    const int chain = vb >> 3, row = (vb & 7) * 8 + wave, b = chain >> 3, h = chain & 7;
    float* Pb = sm; float* Sw = sm + 8192 + wave * 64;
    constexpr int NS = NCH - 1;
#define UOFF(c) ((size_t)((b * NCH + (c)) * 8 + h) * 4096)
#define LDP(X0, X1, LX, c) do { X0 = *(const f32x4*)(PST + UOFF(c) + tid * 8); X1 = *(const f32x4*)(PST + UOFF(c) + tid * 8 + 4); LX = LST[UOFF(c) + row * 64 + lane]; } while (0)
    f32x4 A0, A1, B0, B1, C0, C1; float LA = 0.f, LB = 0.f, LC = 0.f, Lcur;
    __syncthreads();
    LDP(A0, A1, LA, 0);
    *(f32x4*)(Pb + tid * 8) = A0; *(f32x4*)(Pb + tid * 8 + 4) = A1; Lcur = LA;
    Sw[lane] = 0.f;
    LDP(B0, B1, LB, 1); LDP(C0, C1, LC, 2); LDP(A0, A1, LA, 3);
    __syncthreads();
#define P2STEP(c, X0, X1, LX) do { float Lnx = 0.f; \
        if ((c) + 1 < NS) { float* Pn = Pb + (((c) + 1) & 1) * 4096; *(f32x4*)(Pn + tid * 8) = X0; *(f32x4*)(Pn + tid * 8 + 4) = X1; Lnx = LX; } \
        if ((c) + 4 < NS) LDP(X0, X1, LX, (c) + 4); \
        const float* Pc = Pb + ((c) & 1) * 4096 + lane; float a0 = 0.f, a1 = 0.f, a2 = 0.f, a3 = 0.f; \
        _Pragma("unroll") for (int i = 0; i < 64; i += 4) { const f32x4 s4 = *(const f32x4*)(Sw + i); \
            a0 += s4[0] * Pc[(i + 0) * 64]; a1 += s4[1] * Pc[(i + 1) * 64]; a2 += s4[2] * Pc[(i + 2) * 64]; a3 += s4[3] * Pc[(i + 3) * 64]; } \
        const float sn = ((a0 + a1) + (a2 + a3)) + Lcur; LST[UOFF(c) + row * 64 + lane] = sn; Sw[lane] = sn; Lcur = Lnx; \
        __syncthreads(); } while (0)
    for (int c = 0; c < NS; c += 3) { P2STEP(c, B0, B1, LB); P2STEP(c + 1, C0, C1, LC); P2STEP(c + 2, A0, A1, LA); }
    static_assert(NS % 3 == 0, "pass 2 is unrolled by 3");
#undef P2STEP
#undef LDP
#undef UOFF
}
__device__ __forceinline__ void scan_pass3(const Params& p, float* sm, int wave, int lane) {
    const float* LST = (const float*)(p.ws + WS_LST); const bf16* GG = (const bf16*)(p.ws + WS_GG); bf16* MIX = (bf16*)(p.ws + WS_MIX);
    const float* ln_w = inp(17); const float* ln_b = inp(18);
    const int tid = TIDX, cs = lane & 15, rg = lane >> 4, rowbase = wave * 8 + rg * 2;
    constexpr int NU = BATCH * NCH * 8;
    for (int u = blockIdx.x; u < NU; u += gridDim.x) {
        const int h = u & 7, bc = u >> 3, c = bc % NCH, b = bc / NCH;
        f32x2 S[2][2];
        if (c > 0) { const float* src = LST + ((size_t)((b * NCH + c - 1) * 8 + h)) * 4096 + rowbase * 64 + 4 * cs;
#pragma unroll
            for (int j = 0; j < 2; ++j) { const f32x4 s4 = *(const f32x4*)(src + j * 64); S[j][0] = LO2(s4); S[j][1] = HI2(s4); } }
        else {
#pragma unroll
            for (int j = 0; j < 2; ++j) { S[j][0] = (f32x2){0.f, 0.f}; S[j][1] = (f32x2){0.f, 0.f}; } }
        for (int sub = 0; sub < 2; ++sub) {
            __syncthreads();
            scan_load<true>(p, sm, b, h, c * CH + sub * 64, wave);
            __syncthreads();
            scan_run<2, true, true>(sm, S, cs, rowbase);
            __syncthreads();
            const int tt = tid >> 3, c8 = (tid & 7) * 8, hc = h * 64 + c8; const int gr = b * SEQ + c * CH + sub * 64 + tt;
            const f32x4 o0 = *(const f32x4*)(sm + SC_O * 4096 + tt * 64 + c8), o1 = *(const f32x4*)(sm + SC_O * 4096 + tt * 64 + c8 + 4);
            const f32x4 v0 = *(const f32x4*)(sm + SC_V * 4096 + tt * 64 + c8), v1 = *(const f32x4*)(sm + SC_V * 4096 + tt * 64 + c8 + 4);
            const float bcv = sm[SC_BC * 4096 + tt];
            float mu = ((o0[0] + o0[1]) + (o0[2] + o0[3])) + ((o1[0] + o1[1]) + (o1[2] + o1[3])); mu = sum8(mu) * (1.0f / 64.0f);
            const f32x4 e0 = o0 - mu, e1 = o1 - mu;
            float var = ((e0[0] * e0[0] + e0[1] * e0[1]) + (e0[2] * e0[2] + e0[3] * e0[3])) + ((e1[0] * e1[0] + e1[1] * e1[1]) + (e1[2] * e1[2] + e1[3] * e1[3])); var = sum8(var) * (1.0f / 64.0f);
            const float rs = 1.0f / sqrtf(var + 64e-5f);
            const f32x4 lw0 = *(const f32x4*)(ln_w + hc), lw1 = *(const f32x4*)(ln_w + hc + 4), lb0 = *(const f32x4*)(ln_b + hc), lb1 = *(const f32x4*)(ln_b + hc + 4);
            const v4u gv = *(const v4u*)(GG + (size_t)gr * RW + hc);
            f32x4 y0 = (e0 * rs) * lw0 + lb0 + v0 * bcv, y1 = (e1 * rs) * lw1 + lb1 + v1 * bcv;
            y0[0] *= bflo(gv[0]); y0[1] *= bfhi(gv[0]); y0[2] *= bflo(gv[1]); y0[3] *= bfhi(gv[1]); y1[0] *= bflo(gv[2]); y1[1] *= bfhi(gv[2]); y1[2] *= bflo(gv[3]); y1[3] *= bfhi(gv[3]);
            v4u w; w.x = cvt_pk_bf16(y0[0], y0[1]); w.y = cvt_pk_bf16(y0[2], y0[3]); w.z = cvt_pk_bf16(y1[0], y1[1]); w.w = cvt_pk_bf16(y1[2], y1[3]);
            *(v4u*)(MIX + (size_t)gr * DM + hc) = w;
        }
    }
}

constexpr int AT_KS = 0, AT_VT = 256 * 72 * 2, AT_PS = AT_VT + 64 * 280 * 2, AT_PSW = 16 * 168 * 2;
__device__ __forceinline__ void attn_phase(const Params& p, unsigned char* lds, int wave, int lane) {
    const bf16* P = (const bf16*)(p.ws + WS_BIG); bf16* MIX = (bf16*)(p.ws + WS_MIX); const float* sinks = inp(19);
    const int tid = TIDX; bf16* Ks = (bf16*)(lds + AT_KS); bf16* Vt = (bf16*)(lds + AT_VT); bf16* Ps = (bf16*)(lds + AT_PS + wave * AT_PSW);
    const int fr = lane & 15, fq = lane >> 4;
    for (int u = blockIdx.x; u < BATCH * 64 * 2; u += gridDim.x) {
        const int g = u & 1, qb = (u >> 1) & 63, b = u >> 7, q0 = qb * 128;
        __syncthreads();
        { const int key = tid >> 1, half = tid & 1; const bool valid = (qb > 0) || (key >= 128);
          const bf16* src = P + (size_t)(b * SEQ + q0 - 128 + key) * NIN + 1792 + 512 + g * 64 + half * 32;
#pragma unroll
          for (int i = 0; i < 4; ++i) { v4u kx = (v4u){0u, 0u, 0u, 0u}, vx = kx; if (valid) { kx = *(const v4u*)(src + 8 * i); vx = *(const v4u*)(src + 128 + 8 * i); }
              *(v4u*)(Ks + key * 72 + half * 32 + 8 * i) = kx;
#pragma unroll
              for (int e = 0; e < 4; ++e) { const int d = half * 32 + 8 * i + 2 * e; Vt[d * 280 + key] = (bf16)(vx[e] & 0xffffu); Vt[(d + 1) * 280 + key] = (bf16)(vx[e] >> 16); } }
          if (tid < 64 * 3) { const int d = tid / 3, part = tid % 3; *(v4u*)(Vt + d * 280 + 256 + 8 * part) = (v4u){0u, 0u, 0u, 0u}; } }
        __syncthreads();
        for (int hq4 = 0; hq4 < 4; ++hq4) {
            const int hq = g * 4 + hq4; const float sink = sinks[hq];
            const bf16* qp = P + (size_t)(b * SEQ + q0 + 16 * wave + fr) * NIN + 1792 + hq * 64 + 8 * fq;
            const bf16x8 qa0 = *(const bf16x8*)qp, qa1 = *(const bf16x8*)(qp + 32);
            f32x4 sc[9]; float mx[4] = {-1e30f, -1e30f, -1e30f, -1e30f};
#pragma unroll
            for (int nt = 0; nt < 9; ++nt) { const int jt = 16 * (wave + nt); const bf16* kp = Ks + (jt + fr) * 72 + 8 * fq;
                const bf16x8 kb0 = *(const bf16x8*)kp, kb1 = *(const bf16x8*)(kp + 32);
                f32x4 a = (f32x4){0.f, 0.f, 0.f, 0.f}; a = __builtin_amdgcn_mfma_f32_16x16x32_bf16(qa0, kb0, a, 0, 0, 0); a = __builtin_amdgcn_mfma_f32_16x16x32_bf16(qa1, kb1, a, 0, 0, 0);
                const int j = jt + fr;
#pragma unroll
                for (int r = 0; r < 4; ++r) { const int i = 16 * wave + 4 * fq + r, dist = i + 128 - j; const bool ok = (dist >= 0) && (dist < 128) && ((qb > 0) || (j >= 128));
                    a[r] = ok ? a[r] * 0.125f : -1e30f; mx[r] = fmaxf(mx[r], a[r]); }
                sc[nt] = a; }
            float sm_[4];
#pragma unroll
            for (int r = 0; r < 4; ++r) { mx[r] = fmaxf(max16(mx[r]), sink); sm_[r] = 0.f; }
#pragma unroll
            for (int nt = 0; nt < 9; ++nt) {
#pragma unroll
                for (int r = 0; r < 4; ++r) { const float e = __expf(sc[nt][r] - mx[r]); sm_[r] += e; Ps[(4 * fq + r) * 168 + nt * 16 + fr] = (bf16)(cvt_pk_bf16(e, 0.f) & 0xffffu); } }
#pragma unroll
            for (int r = 0; r < 4; ++r) { Ps[(4 * fq + r) * 168 + 144 + fr] = 0; sm_[r] = 1.0f / (sum16(sm_[r]) + __expf(sink - mx[r])); }
            __builtin_amdgcn_fence(__ATOMIC_RELEASE, "wavefront"); asm volatile("s_waitcnt lgkmcnt(0)" ::: "memory");
            f32x4 o[4];
#pragma unroll
            for (int dt = 0; dt < 4; ++dt) o[dt] = (f32x4){0.f, 0.f, 0.f, 0.f};
#pragma unroll
            for (int ks = 0; ks < 5; ++ks) { const bf16x8 pa = *(const bf16x8*)(Ps + fr * 168 + ks * 32 + 8 * fq);
#pragma unroll
                for (int dt = 0; dt < 4; ++dt) { const bf16x8 vb = *(const bf16x8*)(Vt + (dt * 16 + fr) * 280 + 16 * wave + ks * 32 + 8 * fq);
                    o[dt] = __builtin_amdgcn_mfma_f32_16x16x32_bf16(pa, vb, o[dt], 0, 0, 0); } }
            bf16* op = MIX + (size_t)(b * SEQ + q0 + 16 * wave + 4 * fq) * DM + 512 + hq * 64 + fr;
#pragma unroll
            for (int r = 0; r < 4; ++r)
#pragma unroll
                for (int dt = 0; dt < 4; ++dt) op[(size_t)r * DM + dt * 16] = (bf16)(cvt_pk_bf16(o[dt][r] * sm_[r], 0.f) & 0xffffu);
            asm volatile("s_waitcnt lgkmcnt(0)" ::: "memory");
        }
    }
}

__device__ __forceinline__ void final_norm(const Params& p, int wave, int lane) {
    const float* ss3 = (const float*)(p.ws + WS_SS) + (size_t)3 * M * 16; const float* gf = inp(25);
    const int gw = blockIdx.x * NWAVES + wave, NGW = gridDim.x * NWAVES;
    f32x4 gfv[4];
#pragma unroll
    for (int j = 0; j < 4; ++j) gfv[j] = ((const f32x4*)gf)[lane + 64 * j];
    for (int m = gw; m < M; m += NGW) { const float rs = pg8::row_rstd(ss3, m); f32x4* xr = (f32x4*)(p.out + (size_t)m * DM) + lane;
#pragma unroll
        for (int j = 0; j < 4; ++j) { const f32x4 v = xr[64 * j]; xr[64 * j] = v * rs * gfv[j]; } }
}


#define XB_TMO      128
#define XB_XCNT(j)  (256  + 64 * (j))
#define XB_XSUB(j)  (1280 + 64 * (j))
#define XB_XGEN(j)  (2304 + 64 * (j))
#define XB_TOP      3328
#define XB_TOPGEN   3392
#define XCD_BAR_WORDS 3456
#define XB_SPIN_CAP (1u << 18)

__device__ __forceinline__ unsigned xb_ld(unsigned* p)              { return __hip_atomic_load(p, __ATOMIC_RELAXED, __HIP_MEMORY_SCOPE_AGENT); }
__device__ __forceinline__ unsigned xb_add(unsigned* p, unsigned v) { return __hip_atomic_fetch_add(p, v, __ATOMIC_RELAXED, __HIP_MEMORY_SCOPE_AGENT); }
__device__ __forceinline__ unsigned xb_xcc_id() { return (unsigned)__builtin_amdgcn_s_getreg((3 << 11) | 20) & 0xFu; }
#define XB_SPIN(cond, bar) do { unsigned _sp = 0; while (cond) { __builtin_amdgcn_s_sleep(1); \
    if ((++_sp & 255u) == 0u) { if (xb_ld(&(bar)[XB_TMO])) break; if (_sp > XB_SPIN_CAP) { atomicAdd(&(bar)[XB_TMO], 1u); break; } } } } while (0)

struct XcdBarrier {
    unsigned* bar; unsigned x;
    volatile LAS unsigned* st; int wave;
};

__device__ __forceinline__ XcdBarrier xcd_barrier_post(unsigned* bar, volatile LAS unsigned* st, int wave) {
    XcdBarrier b; b.bar = bar; b.x = xb_xcc_id(); b.st = st; b.wave = wave;
    if (wave == 0 && lane_id() == 0) (void)xb_add(&bar[XB_XCNT(b.x)], 1u);
    return b;
}
__device__ __forceinline__ void xcd_barrier_complete(unsigned* bar, unsigned x, unsigned& nloc, unsigned& nx) {
    const unsigned G = gridDim.x * gridDim.y * gridDim.z;
    unsigned sum, cnt, mine, sp = 0u;
    for (;;) {
        sum = 0u; cnt = 0u; mine = 0u;
#pragma unroll
        for (unsigned j = 0; j < 16; ++j) { const unsigned c = xb_ld(&bar[XB_XCNT(j)]); sum += c; cnt += (c > 0u) ? 1u : 0u; mine = (j == x) ? c : mine; }
        if (sum == G) break;
        __builtin_amdgcn_s_sleep(1);
        if ((++sp & 255u) == 0u) { if (xb_ld(&bar[XB_TMO])) break; if (sp > XB_SPIN_CAP) { atomicAdd(&bar[XB_TMO], 1u); break; } }
    }
    nloc = mine > 0u ? mine : 1u; nx = cnt > 0u ? cnt : 1u;
}

__device__ __forceinline__ void xcd_barrier(const XcdBarrier& b) {
    asm volatile("s_waitcnt vmcnt(0)" ::: "memory");
    __syncthreads();
    if (b.wave == 0 && lane_id() == 0) {
        unsigned* bar = b.bar;
        __builtin_amdgcn_s_waitcnt(0);
        unsigned nloc = b.st[0], nx = b.st[1];
        if (nloc == 0u) { xcd_barrier_complete(bar, b.x, nloc, nx); b.st[0] = nloc; b.st[1] = nx; }
        const unsigned old = xb_add(&bar[XB_XSUB(b.x)], 1u);
        const unsigned gen = old / nloc;
        if (old + 1u == (gen + 1u) * nloc) {
            __builtin_amdgcn_fence(__ATOMIC_RELEASE, "agent");
            asm volatile("s_waitcnt vmcnt(0)" ::: "memory");
            const unsigned og = xb_add(&bar[XB_TOP], 1u);
            const unsigned tg = og / nx;
            if (og + 1u == (tg + 1u) * nx) xb_add(&bar[XB_TOPGEN], 1u);
            else XB_SPIN(xb_ld(&bar[XB_TOPGEN]) == tg, bar);
            __builtin_amdgcn_fence(__ATOMIC_ACQUIRE, "agent");
            xb_add(&bar[XB_XGEN(b.x)], 1u);
            asm volatile("s_waitcnt vmcnt(0)" ::: "memory");
        } else {
            XB_SPIN(xb_ld(&bar[XB_XGEN(b.x)]) == gen, bar);
            __builtin_amdgcn_fence(__ATOMIC_ACQUIRE, "agent");
            asm volatile("s_waitcnt vmcnt(0)" ::: "memory");
        }
    }
    __syncthreads();
}

constexpr int LDS_BYTES = 147456;
constexpr int NPHASE = 12;
#ifndef DUPMASK
#define DUPMASK 0
#endif
__global__ void __launch_bounds__(NTHR, 2) hymba_fwd(Params p) {
    extern __shared__ __attribute__((aligned(16))) unsigned char lds[];
    cg::grid_group grid = cg::this_grid();
    const int wave = __builtin_amdgcn_readfirstlane((int)threadIdx.x >> 6); const int lane = lane_id(); const int tid = (wave << 6) | lane;
    unsigned char* ws = p.ws;
    PG8_LAS unsigned char* lds3 = (PG8_LAS unsigned char*)lds;
    float* ss = (float*)(ws + WS_SS);
    bf16* XB = (bf16*)(ws + WS_XB); bf16* ACT = (bf16*)(ws + WS_BIG); bf16* PB = (bf16*)(ws + WS_BIG);
    const int lo = p.ph_lo, hi = p.ph_hi;
#define IN(k) (lo <= (k) && (k) < hi)
#define REP(k) for (int rep_ = 0; rep_ < 1 + ((DUPMASK >> (k)) & 1); ++rep_)
#ifndef DUPBAR
#define DUPBAR 0
#endif
#define SEAM(k) do { if (IN(k) && IN((k) + 1)) { for (int rb_ = 0; rb_ <= DUPBAR; ++rb_) xcd_barrier(xbar); } } while (0)
    unsigned* bctr = (unsigned*)(ws + WS_CTL);
    volatile LAS unsigned* misc = (volatile LAS unsigned*)(lds3 + 131072 + 1024);
    if (wave == 0 && lane < 2) misc[lane] = 0u;
    if (blockIdx.x == 0) for (int i = tid; i < XCD_BAR_WORDS; i += NTHR) __hip_atomic_store(bctr + i, 0u, __ATOMIC_RELAXED, __HIP_MEMORY_SCOPE_AGENT);
    if (IN(0)) REP(0) { p0_prologue(p, lds, wave, lane_id()); }
    grid.sync();
    XcdBarrier xbar = xcd_barrier_post(bctr, misc, wave);
    if (IN(1)) REP(1) { pg8::Gemm g{XB, (const bf16*)(ws + WS_WGU1), M, 2 * FF, DM}; pg8::StaticOrder S; S.init(M, 2 * FF, gridDim.x, blockIdx.x);
        pg8::EpiSwiGLU E{ACT, ss, FF}; pg8::gemm_phase<pg8::EpiSwiGLU, pg8::StaticOrder, true, true>(lds3, g, S, E, wave); } SEAM(1);
    if (IN(2)) REP(2) { pg8::Gemm g{ACT, (const bf16*)(ws + WS_WD1), M, DM, FF}; pg8::StaticOrder S; S.init(M, DM, gridDim.x, blockIdx.x);
        pg8::EpiRes E{inp(0), p.out, XB, ss + (size_t)M * 16, 0.5f}; pg8::gemm_phase<pg8::EpiRes, pg8::StaticOrder, true, true>(lds3, g, S, E, wave); } SEAM(2);
    if (IN(3)) REP(3) { pg8::Gemm g{XB, (const bf16*)(ws + WS_WIN), M, NIN, DM}; pg8::StaticOrder S; S.init(M, NIN, gridDim.x, blockIdx.x);
        pg8::EpiWin E{PB, ss + (size_t)M * 16, inp(7), 1792, NIN}; pg8::gemm_phase<pg8::EpiWin, pg8::StaticOrder, true, true>(lds3, g, S, E, wave); } SEAM(3);
    if (IN(4)) REP(4) { r1_phase(p, wave); } SEAM(4);
    if (IN(5)) REP(5) { pg8::Gemm g{(const bf16*)(ws + WS_LIN), (const bf16*)(ws + WS_WL), M, 1536, 256}; pg8::StaticOrder S; S.init(M, 1536, gridDim.x, blockIdx.x);
        pg8::EpiLora E{(float*)(ws + WS_DEC), (bf16*)(ws + WS_AA), (bf16*)(ws + WS_GG), inp(9), inp(11)}; pg8::gemm_phase<pg8::EpiLora, pg8::StaticOrder, true, true>(lds3, g, S, E, wave); } SEAM(5);
    if (IN(6)) REP(6) { scan_pass1(p, (float*)lds, wave, lane_id()); attn_phase(p, lds, wave, lane_id()); } SEAM(6);
    if (IN(7)) REP(7) { scan_pass2(p, (float*)lds, wave); } SEAM(7);
    if (IN(8)) REP(8) { scan_pass3(p, (float*)lds, wave, lane_id()); __syncthreads(); } SEAM(8);
    if (IN(9)) REP(9) { pg8::Gemm g{(const bf16*)(ws + WS_MIX), (const bf16*)(ws + WS_WOUT), M, DM, DM}; pg8::StaticOrder S; S.init(M, DM, gridDim.x, blockIdx.x);
        pg8::EpiRes E{p.out, p.out, XB, ss + (size_t)2 * M * 16, 1.0f}; pg8::gemm_phase<pg8::EpiRes, pg8::StaticOrder, true, true>(lds3, g, S, E, wave); } SEAM(9);
    if (IN(10)) REP(10) { pg8::Gemm g{XB, (const bf16*)(ws + WS_WGU2), M, 2 * FF, DM}; pg8::StaticOrder S; S.init(M, 2 * FF, gridDim.x, blockIdx.x);
        pg8::EpiSwiGLU E{ACT, ss + (size_t)2 * M * 16, FF}; pg8::gemm_phase<pg8::EpiSwiGLU, pg8::StaticOrder, true, true>(lds3, g, S, E, wave); } SEAM(10);
    if (IN(11)) REP(11) { pg8::Gemm g{ACT, (const bf16*)(ws + WS_WD2), M, DM, FF}; pg8::StaticOrder S; S.init(M, DM, gridDim.x, blockIdx.x);
        pg8::EpiRes E{p.out, p.out, nullptr, ss + (size_t)3 * M * 16, 0.5f}; pg8::gemm_phase<pg8::EpiRes, pg8::StaticOrder, true, true>(lds3, g, S, E, wave); } SEAM(11);
    if (IN(12)) REP(12) { final_norm(p, wave, lane_id()); }
#undef IN
#undef SEAM
}

extern "C" void kernel_launch(void* const* d_in, const int* in_sizes, int n_in, void* d_out, int out_size, void* d_ws, size_t ws_size, hipStream_t stream) {
    static int grid = 0;
    if (grid == 0) {
        if (n_in != 26 || out_size != M * DM || ws_size < WS_END) { fprintf(stderr, "kernel_launch: unexpected sizes n_in %d out %d ws %zu\n", n_in, out_size, ws_size); grid = -1; return; }
        int dev = 0, cus = 0, per_cu = 0;
        hipGetDevice(&dev); hipDeviceGetAttribute(&cus, hipDeviceAttributeMultiprocessorCount, dev);
        hipFuncSetAttribute((const void*)hymba_fwd, hipFuncAttributeMaxDynamicSharedMemorySize, LDS_BYTES);
        hipOccupancyMaxActiveBlocksPerMultiprocessor(&per_cu, (const void*)hymba_fwd, NTHR, LDS_BYTES);
        (void)hipGetLastError();
        if (per_cu < 1) per_cu = 1;
        grid = cus * per_cu; if (grid > 256) grid = 256;
        if (grid != 256) fprintf(stderr, "kernel_launch: grid %d (cus %d per_cu %d), kernel assumes 256\n", grid, cus, per_cu);
    }
    if (grid < 0) return;
    Params p{};
    for (int i = 0; i < 26; ++i) p.in[i] = (const float*)d_in[i];
    p.out = (float*)d_out; p.ws = (unsigned char*)d_ws; p.ph_lo = 0; p.ph_hi = NPHASE + 1;
    void* args[] = {&p};
    hipError_t e = hipLaunchCooperativeKernel((const void*)hymba_fwd, dim3(grid), dim3(NTHR), args, LDS_BYTES, stream);
    if (e != hipSuccess) fprintf(stderr, "cooperative launch failed: %s (grid %d)\n", hipGetErrorString(e), grid);
}
```

```cpp
#include <hip/hip_runtime.h>
#include <hip/hip_cooperative_groups.h>
#include <cstdio>
#include <cstdint>
namespace cg = cooperative_groups;
namespace pg8 {
#define PG8_LAS __attribute__((address_space(3)))
typedef unsigned short bf16_t;
typedef short bf16x8 __attribute__((ext_vector_type(8)));
typedef float f32x4 __attribute__((ext_vector_type(4)));
typedef unsigned u32x4 __attribute__((ext_vector_type(4)));
constexpr int BM = 256, BK = 64, HALF = 128, HTB = HALF * BK * 2  , STAGE_BYTES = 8 * HTB, NXCD = 8, WGM = 8;

__host__ __device__ __forceinline__ int lds_byte(int r, int c) { const int st = (r >> 4) * 2 + (c >> 5), rr = r & 15, cc = c & 31, ob = rr * 64 + cc * 2; return st * 1024 + (ob ^ (((ob >> 9) & 1) << 5)); }
__host__ __device__ __forceinline__ void stage_rc(int b, int& R, int& C) { const int st = b / 1024, sb = b % 1024, swz = sb ^ (((sb >> 9) & 1) << 5); R = (st >> 1) * 16 + swz / 64; C = (st & 1) * 32 + (swz % 64) / 2; }
__host__ __device__ __forceinline__ int perm32(int rho) { const int n = rho >> 4, i = rho & 15; return 8 * (i >> 2) + 4 * n + (i & 3); }

struct Unit { int pm, pn; };
struct Gemm { const bf16_t* A; const bf16_t* Bt; int M, N, K; };

struct StaticOrder {
    int nM, nN, nwg, G, c;
    __host__ __device__ void init(int M, int N, int G_, int c_) { nM = M / BM; nN = N / BM; nwg = nM * nN; G = G_; c = c_; }
    __host__ __device__ bool next(int i, Unit& u) const {
        const long L = (long)i * G + c; if (L >= nwg) return false;
        int wgid = (int)L; { const int q = nwg / NXCD, r = nwg % NXCD, xcd = wgid % NXCD, off = wgid / NXCD; wgid = (xcd < r ? xcd * (q + 1) : r * (q + 1) + (xcd - r) * q) + off; }
        const int nig = WGM * nN, gid = wgid / nig, fm = gid * WGM, gsz = (nM - fm) < WGM ? (nM - fm) : WGM;
        u.pm = fm + ((wgid % nig) % gsz); u.pn = (wgid % nig) / gsz; return true;
    }
    __device__ __forceinline__ void a_ready(const Unit&) const {}
    __device__ __forceinline__ void done(const Unit&) const {}
};

typedef float f32x2 __attribute__((ext_vector_type(2)));
typedef __bf16 bf16x2_t __attribute__((ext_vector_type(2)));
typedef unsigned u32x2 __attribute__((ext_vector_type(2)));
__device__ __forceinline__ unsigned cvt_pk_bf16(float lo, float hi) { f32x2 v = {lo, hi}; bf16x2_t b = __builtin_convertvector(v, bf16x2_t); return __builtin_bit_cast(unsigned, b); }
__device__ __forceinline__ float row_rstd(const float* ss, int row) {
    const f32x4* p = (const f32x4*)(ss + (size_t)row * 16); const f32x4 a = p[0], b = p[1], c = p[2], d = p[3];
    const float s = (((a[0] + a[1]) + (a[2] + a[3])) + ((b[0] + b[1]) + (b[2] + b[3]))) + (((c[0] + c[1]) + (c[2] + c[3])) + ((d[0] + d[1]) + (d[2] + d[3])));
    return 1.0f / sqrtf(s * (1.0f / 1024.0f) + 1e-5f);
}
__device__ __forceinline__ float silu_mul(float g, float u) { return g * __builtin_amdgcn_rcpf(1.0f + __expf(-g)) * u; }

struct EpiSwiGLU {
    static constexpr bool PERM = true, AFTER_DRAIN = false;
    bf16_t* O; const float* ss; int ldo;
    __device__ __forceinline__ void operator()(const f32x4 (&acc)[2][2][4][2], const Unit& u, int wr, int wc, int fr, int fq) const {
        const int row0 = u.pm * BM + wr * 64 + fr; const int col0 = u.pn * HALF + wc * 32 + 8 * fq;
#pragma unroll
        for (int ai = 0; ai < 2; ++ai)
#pragma unroll
            for (int m = 0; m < 4; ++m) { const int row = row0 + ai * HALF + m * 16; const float rs = row_rstd(ss, row);
                const f32x4 g0 = acc[ai][0][m][0] * rs, g1 = acc[ai][0][m][1] * rs, u0 = acc[ai][1][m][0] * rs, u1 = acc[ai][1][m][1] * rs;
                u32x4 w; w.x = cvt_pk_bf16(silu_mul(g0[0], u0[0]), silu_mul(g0[1], u0[1])); w.y = cvt_pk_bf16(silu_mul(g0[2], u0[2]), silu_mul(g0[3], u0[3]));
                w.z = cvt_pk_bf16(silu_mul(g1[0], u1[0]), silu_mul(g1[1], u1[1])); w.w = cvt_pk_bf16(silu_mul(g1[2], u1[2]), silu_mul(g1[3], u1[3]));
                *(u32x4*)(O + (size_t)row * ldo + col0) = w; }
    }
};
struct EpiRes {
    static constexpr bool PERM = false, AFTER_DRAIN = false;
    const float* base; float* out; bf16_t* xb; float* ss; float alpha;
    __device__ __forceinline__ void operator()(const f32x4 (&acc)[2][2][4][2], const Unit& u, int wr, int wc, int fr, int fq) const {
        const int row0 = u.pm * BM + wr * 64 + fr; const int col0 = u.pn * BM + wc * 32 + 4 * fq;
#pragma unroll
        for (int ai = 0; ai < 2; ++ai)
#pragma unroll
            for (int m = 0; m < 4; ++m) { const int row = row0 + ai * HALF + m * 16; const size_t off = (size_t)row * 1024 + col0; float sq = 0.f;
#pragma unroll
                for (int bj = 0; bj < 2; ++bj)
#pragma unroll
                    for (int n = 0; n < 2; ++n) { const f32x4 bs = *(const f32x4*)(base + off + bj * HALF + n * 16); const f32x4 o = bs + acc[ai][bj][m][n] * alpha;
                        *(f32x4*)(out + off + bj * HALF + n * 16) = o; sq += (o[0] * o[0] + o[1] * o[1]) + (o[2] * o[2] + o[3] * o[3]);
                        if (xb) { u32x2 w; w.x = cvt_pk_bf16(o[0], o[1]); w.y = cvt_pk_bf16(o[2], o[3]); *(u32x2*)(xb + off + bj * HALF + n * 16) = w; } }
                sq += __shfl_xor(sq, 16); sq += __shfl_xor(sq, 32);
                if (fq == 0) ss[(size_t)row * 16 + u.pn * 4 + wc] = sq; }
    }
};
struct EpiWin {
    static constexpr bool PERM = true, AFTER_DRAIN = false;
    bf16_t* O; const float* ss; const float* bias; int bias_from; int ldo;
    __device__ __forceinline__ void operator()(const f32x4 (&acc)[2][2][4][2], const Unit& u, int wr, int wc, int fr, int fq) const {
        const int row0 = u.pm * BM + wr * 64 + fr; const int col0 = u.pn * BM + wc * 32 + 8 * fq;
        f32x4 bv[2][2];
#pragma unroll
        for (int bj = 0; bj < 2; ++bj)
#pragma unroll
            for (int n = 0; n < 2; ++n) { const int c = col0 + bj * HALF + 4 * n; bv[bj][n] = (c >= bias_from) ? *(const f32x4*)(bias + (c - bias_from)) : (f32x4){0.f, 0.f, 0.f, 0.f}; }
#pragma unroll
        for (int ai = 0; ai < 2; ++ai)
#pragma unroll
            for (int m = 0; m < 4; ++m) { const int row = row0 + ai * HALF + m * 16; const float rs = row_rstd(ss, row);
#pragma unroll
                for (int bj = 0; bj < 2; ++bj) { const f32x4 v0 = acc[ai][bj][m][0] * rs + bv[bj][0], v1 = acc[ai][bj][m][1] * rs + bv[bj][1];
                    u32x4 w; w.x = cvt_pk_bf16(v0[0], v0[1]); w.y = cvt_pk_bf16(v0[2], v0[3]); w.z = cvt_pk_bf16(v1[0], v1[1]); w.w = cvt_pk_bf16(v1[2], v1[3]);
                    *(u32x4*)(O + (size_t)row * ldo + col0 + bj * HALF) = w; } }
    }
};
struct EpiLora {
    static constexpr bool PERM = true, AFTER_DRAIN = false;
    float* DEC; bf16_t* AA; bf16_t* GG; const float* w0; const float* a0;
    __device__ __forceinline__ void operator()(const f32x4 (&acc)[2][2][4][2], const Unit& u, int wr, int wc, int fr, int fq) const {
        const int row0 = u.pm * BM + wr * 64 + fr; const int kind = u.pn >> 1; const int col0 = (u.pn & 1) * BM + wc * 32 + 8 * fq;
#pragma unroll
        for (int bj = 0; bj < 2; ++bj) { const int c = col0 + bj * HALF;
            f32x4 b0 = (f32x4){0.f, 0.f, 0.f, 0.f}, b1 = b0;
            if (kind == 0) { b0 = *(const f32x4*)(w0 + c); b1 = *(const f32x4*)(w0 + c + 4); } else if (kind == 1) { b0 = *(const f32x4*)(a0 + c); b1 = *(const f32x4*)(a0 + c + 4); }
#pragma unroll
            for (int ai = 0; ai < 2; ++ai)
#pragma unroll
                for (int m = 0; m < 4; ++m) { const int row = row0 + ai * HALF + m * 16; f32x4 v0 = acc[ai][bj][m][0] + b0, v1 = acc[ai][bj][m][1] + b1;
                    if (kind == 0) {
#pragma unroll
                        for (int e = 0; e < 4; ++e) { v0[e] = expf(-0.60653065971f / (1.0f + expf(-v0[e]))); v1[e] = expf(-0.60653065971f / (1.0f + expf(-v1[e]))); }
                        *(f32x4*)(DEC + (size_t)row * 512 + c) = v0; *(f32x4*)(DEC + (size_t)row * 512 + c + 4) = v1;
                    } else {
                        if (kind == 1) {
#pragma unroll
                            for (int e = 0; e < 4; ++e) { v0[e] = 1.0f / (1.0f + expf(-v0[e])); v1[e] = 1.0f / (1.0f + expf(-v1[e])); } }
                        u32x4 w; w.x = cvt_pk_bf16(v0[0], v0[1]); w.y = cvt_pk_bf16(v0[2], v0[3]); w.z = cvt_pk_bf16(v1[0], v1[1]); w.w = cvt_pk_bf16(v1[2], v1[3]);
                        *(u32x4*)((kind == 1 ? AA : GG) + (size_t)row * 512 + c) = w; } }
        }
    }
};

template <class Epi, class Sched, bool ALIGN_EPI = false, bool SP2 = false>
__device__ __forceinline__ void gemm_phase(PG8_LAS unsigned char* lds, const Gemm g, const Sched& S, const Epi& E, const int wid) {
    const int lane = (int)__builtin_amdgcn_mbcnt_hi(~0u, __builtin_amdgcn_mbcnt_lo(~0u, 0u)), tid = (wid << 6) | lane, wr = wid >> 2, wc = wid & 3, fr = lane & 15, fq = lane >> 4;
    int K = g.K; asm volatile("" : "+s"(K)); const int nt = K / BK;
    unsigned voffA[2], voffB[2];
#pragma unroll
    for (int i = 0; i < 2; ++i) { int R, C; stage_rc(tid * 16 + i * 8192, R, C); const int Rb = Epi::PERM ? ((R & ~31) + perm32(R & 31)) : R;
        voffA[i] = (unsigned)(R * K + C) * 2u; voffB[i] = (unsigned)(Rb * K + C) * 2u; }
    const size_t kstep = (size_t)(BK * 2);
    const size_t hstep = (size_t)HALF * K * 2;
    const size_t tstep = 2 * hstep;
    const unsigned ldsw = (unsigned)wid * 1024u;
    const int aoff = lds_byte(wr * 64 + fr, fq * 8), boff = lds_byte(wc * 32 + fr, fq * 8);
#define PG8_SA(b, h) (((b) * 2 + (h)) * HTB)
#define PG8_SB(b, h) ((4 + (b) * 2 + (h)) * HTB)
#define PG8_STAGE(bufoff, gbase, voff) do { _Pragma("unroll") for (int _i = 0; _i < 2; ++_i) \
        __builtin_amdgcn_global_load_lds((const unsigned*)((const char*)(gbase) + (voff)[_i]), (PG8_LAS unsigned*)(lds + (bufoff) + ldsw + _i * 8192), 16, 0, 0); } while (0)
#define PG8_LDA(dst, b, h) do { _Pragma("unroll") for (int m = 0; m < 4; ++m) _Pragma("unroll") for (int k = 0; k < 2; ++k) dst[m][k] = *(const PG8_LAS bf16x8*)(lds + PG8_SA(b, h) + aoff + m * 2048 + k * 1024); } while (0)
#define PG8_LDB(dst, b, h) do { _Pragma("unroll") for (int n = 0; n < 2; ++n) _Pragma("unroll") for (int k = 0; k < 2; ++k) dst[n][k] = *(const PG8_LAS bf16x8*)(lds + PG8_SB(b, h) + boff + n * 2048 + k * 1024); } while (0)
#define PG8_MMA(ai, bj, At, Bt) do { __builtin_amdgcn_s_setprio(1); _Pragma("unroll") for (int m = 0; m < 4; ++m) _Pragma("unroll") for (int n = 0; n < 2; ++n) _Pragma("unroll") for (int k = 0; k < 2; ++k) \
        acc[ai][bj][m][n] = __builtin_amdgcn_mfma_f32_16x16x32_bf16(Bt[n][k], At[m][k], acc[ai][bj][m][n], 0, 0, 0); __builtin_amdgcn_s_setprio(0); } while (0)
#define PG8_WAIT_V(n) asm volatile("s_waitcnt vmcnt(" #n ")" ::: "memory")
#define PG8_WAIT_L(n) asm volatile("s_waitcnt lgkmcnt(" #n ")" ::: "memory")
#define PG8_BAR __builtin_amdgcn_s_barrier()
#define PG8_SCHED __builtin_amdgcn_sched_barrier(0)
    Unit cur, nxt; int ui = 0;
    if (!S.next(0, cur)) return;
    f32x4 acc[2][2][4][2];
#pragma unroll
    for (int a = 0; a < 2; ++a)
#pragma unroll
        for (int b = 0; b < 2; ++b)
#pragma unroll
            for (int m = 0; m < 4; ++m)
#pragma unroll
                for (int n = 0; n < 2; ++n) acc[a][b][m][n] = (f32x4){0.f, 0.f, 0.f, 0.f};
    bf16x8 At[4][2], B0[2][2], B1[2][2];
    const char* cA = (const char*)g.A + (size_t)cur.pm * tstep; const char* cB = (const char*)g.Bt + (size_t)cur.pn * tstep;
    S.a_ready(cur);
    if constexpr (SP2) {
        PG8_STAGE(PG8_SB(0, 0), cB, voffB); PG8_STAGE(PG8_SB(0, 1), cB + hstep, voffB); PG8_STAGE(PG8_SA(0, 0), cA, voffA); PG8_STAGE(PG8_SA(0, 1), cA + hstep, voffA);
        if (wr == 1) PG8_BAR;
        PG8_WAIT_V(2); PG8_BAR;
        PG8_STAGE(PG8_SB(1, 0), cB + kstep, voffB); PG8_STAGE(PG8_SA(1, 0), cA + kstep, voffA); PG8_STAGE(PG8_SB(1, 1), cB + hstep + kstep, voffB);
        PG8_WAIT_V(6); PG8_BAR;
    } else {
        PG8_STAGE(PG8_SB(0, 0), cB, voffB); PG8_STAGE(PG8_SA(0, 0), cA, voffA); PG8_STAGE(PG8_SB(0, 1), cB + hstep, voffB); PG8_STAGE(PG8_SA(0, 1), cA + hstep, voffA);
        if (wr == 1) PG8_BAR;
        PG8_WAIT_V(4); PG8_BAR;
        PG8_STAGE(PG8_SB(1, 0), cB + kstep, voffB); PG8_STAGE(PG8_SA(1, 0), cA + kstep, voffA); PG8_STAGE(PG8_SB(1, 1), cB + hstep + kstep, voffB);
        PG8_WAIT_V(6); PG8_BAR;
    }
    for (;;) {
        const bool has_next = S.next(ui + 1, nxt);
        const char* nA = has_next ? (const char*)g.A + (size_t)nxt.pm * tstep : cA; const char* nB = has_next ? (const char*)g.Bt + (size_t)nxt.pn * tstep : cB;
        for (int t = 0; t < nt; t += 2) {
            const bool last = (t == nt - 2);
            const char* a1 = cA + (size_t)(t + 1) * kstep;
            const char* a2 = last ? nA : cA + (size_t)(t + 2) * kstep; const char* b2 = last ? nB : cB + (size_t)(t + 2) * kstep;
            const char* a3 = a2 + kstep; const char* b3 = b2 + kstep;
            if (last && has_next) S.a_ready(nxt);
            if constexpr (SP2) {
            PG8_LDB(B0, 0, 0); PG8_LDB(B1, 0, 1); PG8_SCHED; PG8_LDA(At, 0, 0); PG8_STAGE(PG8_SA(1, 1), a1 + hstep, voffA);
            PG8_WAIT_V(8); PG8_WAIT_L(0); PG8_BAR; PG8_MMA(0, 0, At, B0); PG8_MMA(0, 1, At, B1); PG8_BAR; PG8_SCHED;
            PG8_LDA(At, 0, 1); PG8_STAGE(PG8_SB(0, 0), b2, voffB); PG8_STAGE(PG8_SB(0, 1), b2 + hstep, voffB); PG8_STAGE(PG8_SA(0, 0), a2, voffA);
            PG8_WAIT_V(8); PG8_WAIT_L(0); PG8_BAR; PG8_MMA(1, 0, At, B0); PG8_MMA(1, 1, At, B1); PG8_BAR; PG8_SCHED;
            PG8_LDB(B0, 1, 0); PG8_LDB(B1, 1, 1); PG8_SCHED; PG8_LDA(At, 1, 0); PG8_STAGE(PG8_SA(0, 1), a2 + hstep, voffA);
            PG8_WAIT_V(8); PG8_WAIT_L(0); PG8_BAR; PG8_MMA(0, 0, At, B0); PG8_MMA(0, 1, At, B1); PG8_BAR; PG8_SCHED;
            PG8_LDA(At, 1, 1); PG8_STAGE(PG8_SB(1, 0), b3, voffB); PG8_STAGE(PG8_SB(1, 1), b3 + hstep, voffB); PG8_STAGE(PG8_SA(1, 0), a3, voffA);
            PG8_WAIT_V(8); PG8_WAIT_L(0); PG8_BAR; PG8_MMA(1, 0, At, B0); PG8_MMA(1, 1, At, B1); PG8_BAR; PG8_SCHED;
            } else {
            PG8_LDB(B0, 0, 0); PG8_SCHED; PG8_LDA(At, 0, 0); PG8_STAGE(PG8_SA(1, 1), a1 + hstep, voffA);
            PG8_WAIT_L(8); PG8_BAR; PG8_WAIT_L(0); PG8_MMA(0, 0, At, B0); PG8_BAR; PG8_SCHED;
            PG8_LDB(B1, 0, 1); PG8_STAGE(PG8_SB(0, 0), b2, voffB);
            PG8_BAR; PG8_WAIT_L(0); PG8_MMA(0, 1, At, B1); PG8_BAR;
            PG8_LDA(At, 0, 1); PG8_STAGE(PG8_SA(0, 0), a2, voffA);
            PG8_BAR; PG8_WAIT_L(0); PG8_MMA(1, 0, At, B0); PG8_BAR; PG8_SCHED;
            PG8_STAGE(PG8_SB(0, 1), b2 + hstep, voffB);
            PG8_WAIT_V(6); PG8_BAR; PG8_MMA(1, 1, At, B1); PG8_BAR;
            PG8_LDB(B0, 1, 0); PG8_SCHED; PG8_LDA(At, 1, 0); PG8_STAGE(PG8_SA(0, 1), a2 + hstep, voffA);
            PG8_WAIT_L(8); PG8_BAR; PG8_WAIT_L(0); PG8_MMA(0, 0, At, B0); PG8_BAR; PG8_SCHED;
            PG8_LDB(B1, 1, 1); PG8_STAGE(PG8_SB(1, 0), b3, voffB);
            PG8_BAR; PG8_WAIT_L(0); PG8_MMA(0, 1, At, B1); PG8_BAR;
            PG8_LDA(At, 1, 1); PG8_STAGE(PG8_SA(1, 0), a3, voffA);
            PG8_BAR; PG8_WAIT_L(0); PG8_MMA(1, 0, At, B0); PG8_BAR; PG8_SCHED;
            PG8_STAGE(PG8_SB(1, 1), b3 + hstep, voffB);
            PG8_WAIT_V(6); PG8_BAR; PG8_MMA(1, 1, At, B1); PG8_BAR;
            }
        }
        if constexpr (ALIGN_EPI) { if (wr == 0) PG8_BAR; }
        if constexpr (!Epi::AFTER_DRAIN) { E(acc, cur, wr, wc, fr, fq); S.done(cur); }
        if (!has_next) break;
#pragma unroll
        for (int a = 0; a < 2; ++a)
#pragma unroll
            for (int b = 0; b < 2; ++b)
#pragma unroll
                for (int m = 0; m < 4; ++m)
#pragma unroll
                    for (int n = 0; n < 2; ++n) acc[a][b][m][n] = (f32x4){0.f, 0.f, 0.f, 0.f};
        cur = nxt; cA = nA; cB = nB; ++ui;
        if constexpr (ALIGN_EPI) { if (wr == 1) PG8_BAR; }
    }
    PG8_WAIT_V(0);
    if constexpr (!ALIGN_EPI) { if (wr == 0) PG8_BAR; }
    PG8_BAR;
    if constexpr (Epi::AFTER_DRAIN) { E.fused(acc, cur, wr, wc, fr, fq, lds, wid, lane); S.done(cur); }
#undef PG8_SA
#undef PG8_SB
#undef PG8_STAGE
#undef PG8_LDA
#undef PG8_LDB
#undef PG8_MMA
#undef PG8_WAIT_V
#undef PG8_WAIT_L
#undef PG8_BAR
#undef PG8_SCHED
}
}

constexpr int BATCH = 2, SEQ = 8192, DM = 1024, FF = 2816, NIN = 2560, RW = 512, M = BATCH * SEQ;
constexpr int NWAVES = 8, NTHR = 512;
constexpr int CH = 128, NCH = SEQ / CH;
constexpr size_t MiB = 1u << 20;
constexpr size_t WS_WGU1 = 0, WS_WD1 = 11 * MiB, WS_WIN = WS_WD1 + 11 * MiB / 2, WS_WOUT = WS_WIN + 5 * MiB, WS_WGU2 = WS_WOUT + 2 * MiB, WS_WD2 = WS_WGU2 + 11 * MiB, WS_WL = 40 * MiB;
constexpr size_t WS_GG = 0;
constexpr size_t WS_XB = 44 * MiB;
constexpr size_t WS_PST = 44 * MiB, WS_LST = 60 * MiB;
constexpr size_t WS_BIG = 76 * MiB;
constexpr size_t WS_LIN = WS_BIG + 80 * MiB;
constexpr size_t WS_DEC = 164 * MiB, WS_AA = 196 * MiB, WS_MIX = 212 * MiB, WS_SS = 244 * MiB, WS_CTL = 248 * MiB, WS_END = 249 * MiB;
static_assert(WS_WD2 + 11 * MiB / 2 <= WS_WL && WS_WL + MiB <= WS_XB, "weights map");

#define LAS __attribute__((address_space(3)))
typedef unsigned short bf16;
typedef unsigned v4u __attribute__((ext_vector_type(4)));
typedef unsigned v2u __attribute__((ext_vector_type(2)));
typedef float f32x4 __attribute__((ext_vector_type(4)));
typedef float f32x2 __attribute__((ext_vector_type(2)));
typedef short bf16x8 __attribute__((ext_vector_type(8)));
using pg8::cvt_pk_bf16;
__device__ __forceinline__ float bflo(unsigned u) { return __uint_as_float(u << 16); }
__device__ __forceinline__ float bfhi(unsigned u) { return __uint_as_float(u & 0xffff0000u); }
template <int CTRL> __device__ __forceinline__ float dpp_mov(float x) { return __builtin_bit_cast(float, __builtin_amdgcn_update_dpp(0, __builtin_bit_cast(int, x), CTRL, 0xF, 0xF, true)); }
__device__ __forceinline__ float sum16(float x) { x += dpp_mov<0xB1>(x); x += dpp_mov<0x4E>(x); x += dpp_mov<0x141>(x); x += dpp_mov<0x140>(x); return x; }
__device__ __forceinline__ float max16(float x) { x = fmaxf(x, dpp_mov<0xB1>(x)); x = fmaxf(x, dpp_mov<0x4E>(x)); x = fmaxf(x, dpp_mov<0x141>(x)); x = fmaxf(x, dpp_mov<0x140>(x)); return x; }
__device__ __forceinline__ float sum8(float x) { x += dpp_mov<0xB1>(x); x += dpp_mov<0x4E>(x); x += dpp_mov<0x141>(x); return x; }
__device__ __forceinline__ float wave_sum(float v) {
#pragma unroll
    for (int o = 1; o < 64; o <<= 1) v += __shfl_xor(v, o);
    return v;
}

__device__ __forceinline__ int lane_id() { return (int)__builtin_amdgcn_mbcnt_hi(~0u, __builtin_amdgcn_mbcnt_lo(~0u, 0u)); }
#define TIDX ((wave << 6) | lane_id())
struct Params {
    const float* in[26]; float* out; unsigned char* ws; int ph_lo, ph_hi;
};


#define GAS __attribute__((address_space(1)))
__device__ __forceinline__ const float* inp(int i) {
    const __attribute__((address_space(4))) char* ka = (const __attribute__((address_space(4))) char*)__builtin_amdgcn_kernarg_segment_ptr();
    int off = i * 8; asm volatile("" : "+s"(off));
    const float* q = *(const float* const __attribute__((address_space(4)))*)(ka + off);
    return (const float*)(const GAS float*)q;
}

__device__ __forceinline__ void conv_item(const float* W, int K, int N, const float* sc, bf16* WT, int k0, int n0, int drow0, float* scr, int lane) {
#pragma unroll 8
    for (int i = 0; i < 32; ++i) { const int kk = 2 * i + (lane >> 5); float v = W[(size_t)(k0 + kk) * N + n0 + (lane & 31)]; if (sc) v *= sc[k0 + kk]; scr[kk * 33 + (lane & 31)] = v; }
    __builtin_amdgcn_fence(__ATOMIC_RELEASE, "wavefront"); asm volatile("s_waitcnt lgkmcnt(0)" ::: "memory");
    const int c = lane & 7;
#pragma unroll
    for (int j = 0; j < 4; ++j) { const int n = (lane >> 3) + 8 * j; const float* s = scr + (8 * c) * 33 + n;
        v4u o; o.x = cvt_pk_bf16(s[0 * 33], s[1 * 33]); o.y = cvt_pk_bf16(s[2 * 33], s[3 * 33]); o.z = cvt_pk_bf16(s[4 * 33], s[5 * 33]); o.w = cvt_pk_bf16(s[6 * 33], s[7 * 33]);
        *(v4u*)(WT + (size_t)(drow0 + n) * K + k0 + 8 * c) = o; }
    asm volatile("s_waitcnt lgkmcnt(0)" ::: "memory");
}
__device__ __forceinline__ void conv_plain(const float* W, int K, int N, const float* sc, bf16* WT, int item, float* scr, int lane) {
    const int nblk = N / 32, kb = item / nblk, nb = item % nblk; conv_item(W, K, N, sc, WT, 64 * kb, 32 * nb, 32 * nb, scr, lane);
}
__device__ __forceinline__ void conv_gu(const float* W, const float* sc, bf16* WT, int item, int up, float* scr, int lane) {
    const int nblk = FF / 32, kb = item / nblk, nb = item % nblk, n0 = 32 * nb; conv_item(W, DM, FF, sc, WT, 64 * kb, n0, (n0 >> 7) * 256 + up * 128 + (n0 & 127), scr, lane);
}
__device__ __forceinline__ void p0_prologue(const Params& p, unsigned char* lds, int wave, int lane) {
    float* scr = (float*)(lds + wave * 16384);
    unsigned char* ws = p.ws;
    const int gw = blockIdx.x * NWAVES + wave, NGW = gridDim.x * NWAVES;
    constexpr int I_GU = (DM / 64) * (FF / 32), I_DN = (FF / 64) * (DM / 32), I_IN = (DM / 64) * (NIN / 32), I_OUT = (DM / 64) * (DM / 32);
    constexpr int NITEMS = 4 * I_GU + 2 * I_DN + I_IN + I_OUT;
    for (int it = gw; it < NITEMS; it += NGW) {
        int r = it;
        if (r < I_GU) { conv_gu(inp(2), inp(1), (bf16*)(ws + WS_WGU1), r, 0, scr, lane); continue; } r -= I_GU;
        if (r < I_GU) { conv_gu(inp(3), inp(1), (bf16*)(ws + WS_WGU1), r, 1, scr, lane); continue; } r -= I_GU;
        if (r < I_DN) { conv_plain(inp(4), FF, DM, nullptr, (bf16*)(ws + WS_WD1), r, scr, lane); continue; } r -= I_DN;
        if (r < I_IN) { conv_plain(inp(6), DM, NIN, inp(5), (bf16*)(ws + WS_WIN), r, scr, lane); continue; } r -= I_IN;
        if (r < I_OUT) { conv_plain(inp(20), DM, DM, nullptr, (bf16*)(ws + WS_WOUT), r, scr, lane); continue; } r -= I_OUT;
        if (r < I_GU) { conv_gu(inp(22), inp(21), (bf16*)(ws + WS_WGU2), r, 0, scr, lane); continue; } r -= I_GU;
        if (r < I_GU) { conv_gu(inp(23), inp(21), (bf16*)(ws + WS_WGU2), r, 1, scr, lane); continue; } r -= I_GU;
        conv_plain(inp(24), FF, DM, nullptr, (bf16*)(ws + WS_WD2), r, scr, lane);
    }
    { bf16* WL = (bf16*)(ws + WS_WL); const float* w2 = inp(10); const float* a2 = inp(12); const float* g2 = inp(13);
      for (int idx = (blockIdx.x * NTHR + TIDX); idx < 1536 * 128; idx += gridDim.x * NTHR) {
          const int n = idx >> 7, k = (idx & 127) * 2; float v0 = 0.f, v1 = 0.f;
          if (n < 512) { if (k < 64) { v0 = w2[k * 512 + n]; v1 = w2[(k + 1) * 512 + n]; } }
          else if (n < 1024) { if (k >= 64 && k < 128) { v0 = a2[(k - 64) * 512 + n - 512]; v1 = a2[(k - 63) * 512 + n - 512]; } }
          else { if (k >= 128) { v0 = g2[(k - 128) * 512 + n - 1024]; v1 = g2[(k - 127) * 512 + n - 1024]; } }
          *(unsigned*)(WL + (size_t)n * 256 + k) = cvt_pk_bf16(v0, v1); } }
    { const float* x = inp(0); bf16* XB = (bf16*)(ws + WS_XB); float* ss0 = (float*)(ws + WS_SS);
      for (int m = gw; m < M; m += NGW) { const f32x4* xr = (const f32x4*)(x + (size_t)m * DM) + lane; float s = 0.f; f32x4 v[4];
#pragma unroll
          for (int j = 0; j < 4; ++j) { v[j] = xr[64 * j]; s += (v[j][0] * v[j][0] + v[j][1] * v[j][1]) + (v[j][2] * v[j][2] + v[j][3] * v[j][3]); }
          s = wave_sum(s);
          v2u* o8 = (v2u*)(XB + (size_t)m * DM) + lane;
#pragma unroll
          for (int j = 0; j < 4; ++j) { v2u w; w.x = cvt_pk_bf16(v[j][0], v[j][1]); w.y = cvt_pk_bf16(v[j][2], v[j][3]); o8[64 * j] = w; }
          if (lane < 16) ss0[(size_t)m * 16 + lane] = (lane == 0) ? s : 0.f; } }
}

__device__ __forceinline__ void r1_phase(const Params& p, int wave) {
    const bf16* P = (const bf16*)(p.ws + WS_BIG); bf16* LIN = (bf16*)(p.ws + WS_LIN); const float* mix = inp(8);
    for (int idx = blockIdx.x * NTHR + TIDX; idx < M * 32; idx += gridDim.x * NTHR) {
        const int row = idx >> 5, g8 = idx & 31, col = 1536 + 8 * g8; const bool hp = (row & (SEQ - 1)) != 0;
        const v4u c = *(const v4u*)(P + (size_t)row * NIN + col); v4u q = (v4u){0u, 0u, 0u, 0u}; if (hp) q = *(const v4u*)(P + (size_t)(row - 1) * NIN + col);
        const f32x4 m0 = *(const f32x4*)(mix + col), m1 = *(const f32x4*)(mix + col + 4);
        float x[8];
#pragma unroll
        for (int e = 0; e < 4; ++e) { const float c0 = bflo(c[e]), c1 = bfhi(c[e]), q0 = bflo(q[e]), q1 = bfhi(q[e]); const float ma = (e < 2) ? m0[2 * e] : m1[2 * e - 4], mb = (e < 2) ? m0[2 * e + 1] : m1[2 * e - 3];
            x[2 * e] = c0 + (q0 - c0) * ma; x[2 * e + 1] = c1 + (q1 - c1) * mb; }
        if (g8 < 8) {
#pragma unroll
            for (int e = 0; e < 8; ++e) x[e] = tanhf(x[e]);
        } else if (g8 >= 16) {
#pragma unroll
            for (int e = 0; e < 8; ++e) x[e] = 1.0f / (1.0f + expf(-x[e]));
        }
        v4u o; o.x = cvt_pk_bf16(x[0], x[1]); o.y = cvt_pk_bf16(x[2], x[3]); o.z = cvt_pk_bf16(x[4], x[5]); o.w = cvt_pk_bf16(x[6], x[7]);
        *(v4u*)(LIN + (size_t)row * 256 + 8 * g8) = o;
    }
}

constexpr int SC_W = 0, SC_B = 1, SC_K = 2, SC_KK = 3, SC_V = 4, SC_R = 5, SC_O = 6, SC_BC = 7;
template <bool P3> __device__ __forceinline__ void scan_load(const Params& p, float* sm, int b, int h, int t0, int wave) {
    const int tid = TIDX, tt = tid >> 3, c8 = (tid & 7) * 8, hc = h * 64 + c8;
    const bf16* P = (const bf16*)(p.ws + WS_BIG); const float* DEC = (const float*)(p.ws + WS_DEC); const bf16* AA = (const bf16*)(p.ws + WS_AA);
    const float* mix = inp(8); const float* k_k = inp(14); const float* k_a = inp(15); const float* r_k = inp(16);
    const int gr = b * SEQ + t0 + tt; const bool hp = (t0 + tt) > 0;
    const bf16* prow = P + (size_t)gr * NIN + hc;
    float r[8], k[8], v[8];
#define SHIFT_LOAD(dst, off) do { const v4u c_ = *(const v4u*)(prow + (off)); v4u q_ = (v4u){0u, 0u, 0u, 0u}; if (hp) q_ = *(const v4u*)(prow + (off) - NIN); \
        const f32x4 m0_ = *(const f32x4*)(mix + hc + (off)), m1_ = *(const f32x4*)(mix + hc + (off) + 4); \
        _Pragma("unroll") for (int e = 0; e < 4; ++e) { const float c0 = bflo(c_[e]), c1 = bfhi(c_[e]), q0 = bflo(q_[e]), q1 = bfhi(q_[e]); const float ma = (e < 2) ? m0_[2 * e] : m1_[2 * e - 4], mb = (e < 2) ? m0_[2 * e + 1] : m1_[2 * e - 3]; \
            dst[2 * e] = c0 + (q0 - c0) * ma; dst[2 * e + 1] = c1 + (q1 - c1) * mb; } } while (0)
    SHIFT_LOAD(k, 512); SHIFT_LOAD(v, 1024);
    if (P3) SHIFT_LOAD(r, 0);
#undef SHIFT_LOAD
    const f32x4 d0 = *(const f32x4*)(DEC + (size_t)gr * RW + hc), d1 = *(const f32x4*)(DEC + (size_t)gr * RW + hc + 4);
    const v4u av = *(const v4u*)(AA + (size_t)gr * RW + hc);
    const f32x4 kk0 = *(const f32x4*)(k_k + hc), kk1 = *(const f32x4*)(k_k + hc + 4), ka0 = *(const f32x4*)(k_a + hc), ka1 = *(const f32x4*)(k_a + hc + 4);
    float a[8], kk[8], kp[8], bb[8]; float ssq = 0.f;
#pragma unroll
    for (int e = 0; e < 4; ++e) { a[2 * e] = bflo(av[e]); a[2 * e + 1] = bfhi(av[e]); }
#pragma unroll
    for (int e = 0; e < 8; ++e) { const float kkw = (e < 4) ? kk0[e] : kk1[e - 4], kaw = (e < 4) ? ka0[e] : ka1[e - 4];
        kk[e] = k[e] * kkw; ssq += kk[e] * kk[e]; kp[e] = k[e] * (1.0f + (a[e] - 1.0f) * kaw); }
    ssq = sum8(ssq);
    const float inv = 1.0f / fmaxf(sqrtf(ssq), 1e-12f);
#pragma unroll
    for (int e = 0; e < 8; ++e) { kk[e] *= inv; bb[e] = kk[e] * a[e]; }
    float* base = sm + tt * 64 + c8;
    *(f32x4*)(base + SC_W * 4096) = d0; *(f32x4*)(base + SC_W * 4096 + 4) = d1;
    *(f32x4*)(base + SC_B * 4096) = (f32x4){bb[0], bb[1], bb[2], bb[3]}; *(f32x4*)(base + SC_B * 4096 + 4) = (f32x4){bb[4], bb[5], bb[6], bb[7]};
    *(f32x4*)(base + SC_K * 4096) = (f32x4){kp[0], kp[1], kp[2], kp[3]}; *(f32x4*)(base + SC_K * 4096 + 4) = (f32x4){kp[4], kp[5], kp[6], kp[7]};
    *(f32x4*)(base + SC_KK * 4096) = (f32x4){kk[0], kk[1], kk[2], kk[3]}; *(f32x4*)(base + SC_KK * 4096 + 4) = (f32x4){kk[4], kk[5], kk[6], kk[7]};
    *(f32x4*)(base + SC_V * 4096) = (f32x4){v[0], v[1], v[2], v[3]}; *(f32x4*)(base + SC_V * 4096 + 4) = (f32x4){v[4], v[5], v[6], v[7]};
    if (P3) {
        *(f32x4*)(base + SC_R * 4096) = (f32x4){r[0], r[1], r[2], r[3]}; *(f32x4*)(base + SC_R * 4096 + 4) = (f32x4){r[4], r[5], r[6], r[7]};
        const f32x4 rk0 = *(const f32x4*)(r_k + hc), rk1 = *(const f32x4*)(r_k + hc + 4); float bc = 0.f;
#pragma unroll
        for (int e = 0; e < 8; ++e) bc += r[e] * kp[e] * ((e < 4) ? rk0[e] : rk1[e - 4]);
        bc = sum8(bc);
        if ((tid & 7) == 0) sm[SC_BC * 4096 + tt] = bc;
    }
}
#define LO2(v) __builtin_shufflevector(v, v, 0, 1)
#define HI2(v) __builtin_shufflevector(v, v, 2, 3)
template <int RPL, bool WITH_O, bool REAL> __device__ __forceinline__ void scan_run(const float* sm, f32x2 (&S)[RPL][2], int cs, int rowbase) {
    typedef float vrow_t __attribute__((ext_vector_type(RPL)));
    const float* st0 = sm + 4 * cs;
    f32x4 w4 = *(const f32x4*)(st0 + SC_W * 4096), b4 = *(const f32x4*)(st0 + SC_B * 4096), kk4 = *(const f32x4*)(st0 + SC_KK * 4096), k4 = w4, r4 = w4;
    if (REAL) k4 = *(const f32x4*)(st0 + SC_K * 4096);
    if (WITH_O) r4 = *(const f32x4*)(st0 + SC_R * 4096);
    vrow_t v4; if (REAL) v4 = *(const vrow_t*)(sm + SC_V * 4096 + rowbase);
#pragma unroll 2
    for (int t = 0; t < 64; ++t) {
        const int tn = (t + 1) & 63;
        const float* st = st0 + tn * 64;
        const f32x4 nw4 = *(const f32x4*)(st + SC_W * 4096), nb4 = *(const f32x4*)(st + SC_B * 4096), nkk4 = *(const f32x4*)(st + SC_KK * 4096);
        f32x4 nk4 = nw4, nr4 = nw4; vrow_t nv4;
        if (REAL) { nk4 = *(const f32x4*)(st + SC_K * 4096); nv4 = *(const vrow_t*)(sm + SC_V * 4096 + tn * 64 + rowbase); }
        if (WITH_O) nr4 = *(const f32x4*)(st + SC_R * 4096);
        const f32x2 w01 = LO2(w4), w23 = HI2(w4), b01 = LO2(b4), b23 = HI2(b4), kk01 = LO2(kk4), kk23 = HI2(kk4), k01 = LO2(k4), k23 = HI2(k4), r01 = LO2(r4), r23 = HI2(r4);
        float oo[RPL];
#pragma unroll
        for (int j = 0; j < RPL; ++j) {
            f32x2 pp = S[j][0] * kk01; pp = S[j][1] * kk23 + pp;
            const float nsa = -sum16(pp[0] + pp[1]);
            const f32x2 nsa2 = (f32x2){nsa, nsa};
            f32x2 t01 = nsa2 * b01, t23 = nsa2 * b23;
            if (REAL) { const f32x2 v2 = (f32x2){v4[j], v4[j]}; t01 = v2 * k01 + t01; t23 = v2 * k23 + t23; }
            S[j][0] = S[j][0] * w01 + t01; S[j][1] = S[j][1] * w23 + t23;
            if (WITH_O) { f32x2 qq = S[j][0] * r01; qq = S[j][1] * r23 + qq; oo[j] = sum16(qq[0] + qq[1]); }
        }
        if (WITH_O) { if (cs == 0) {
#pragma unroll
            for (int j = 0; j < RPL; ++j) ((float*)sm)[SC_O * 4096 + t * 64 + rowbase + j] = oo[j]; } }
        w4 = nw4; b4 = nb4; kk4 = nkk4; k4 = nk4; r4 = nr4; if (REAL) v4 = nv4;
    }
}
__device__ __forceinline__ void scan_pass1(const Params& p, float* sm, int wave, int lane) {
    float* PST = (float*)(p.ws + WS_PST); float* LST = (float*)(p.ws + WS_LST);
    const int cs = lane & 15, rg = lane >> 4; const bool real = wave < 4; const int rowbase = (wave & 3) * 16 + rg * 4;
    constexpr int NU = BATCH * (NCH - 1) * 8;
    for (int u = blockIdx.x; u < NU; u += gridDim.x) {
        const int h = u & 7, bc = u >> 3, c = bc % (NCH - 1), b = bc / (NCH - 1);
        f32x2 S[4][2];
#pragma unroll
        for (int j = 0; j < 4; ++j)
#pragma unroll
            for (int e = 0; e < 4; ++e) S[j][e >> 1][e & 1] = (!real && (rowbase + j == 4 * cs + e)) ? 1.0f : 0.0f;
        for (int sub = 0; sub < 2; ++sub) {
            __syncthreads();
            scan_load<false>(p, sm, b, h, c * CH + sub * 64, wave);
            __syncthreads();
            if (real) scan_run<4, false, true>(sm, S, cs, rowbase); else scan_run<4, false, false>(sm, S, cs, rowbase);
        }
        float* dst = (real ? LST : PST) + ((size_t)((b * NCH + c) * 8 + h)) * 4096 + rowbase * 64 + 4 * cs;
#pragma unroll
        for (int j = 0; j < 4; ++j) *(f32x4*)(dst + j * 64) = (f32x4){S[j][0][0], S[j][0][1], S[j][1][0], S[j][1][1]};
    }
}
__device__ __forceinline__ float rowsum4(float part) {
    const f32x4 z = (f32x4){0.f, 0.f, 0.f, 0.f};
    const f32x4 d = __builtin_amdgcn_mfma_f32_16x16x4f32(1.0f, part, z, 0, 0, 0);
    return d[0];
}
template <bool P3, int TS> __device__ __forceinline__ void scanL_load(const Params& p, float* su, float* bcl, int b, int h, int t0, int tt, int c8, bool bcw) {
    const int hc = h * 64 + c8;
    const bf16* P = (const bf16*)(p.ws + WS_BIG); const float* DEC = (const float*)(p.ws + WS_DEC); const bf16* AA = (const bf16*)(p.ws + WS_AA);
    const float* mix = inp(8); const float* k_k = inp(14); const float* k_a = inp(15); const float* r_k = inp(16);
    const int gr = b * SEQ + t0 + tt; const bool hp = (t0 + tt) > 0;
    const bf16* prow = P + (size_t)gr * NIN + hc;
    float r[8], k[8], v[8];
#define SHIFT_LOAD(dst, off) do { const v4u c_ = *(const v4u*)(prow + (off)); v4u q_ = (v4u){0u, 0u, 0u, 0u}; if (hp) q_ = *(const v4u*)(prow + (off) - NIN); \
        const f32x4 m0_ = *(const f32x4*)(mix + hc + (off)), m1_ = *(const f32x4*)(mix + hc + (off) + 4); \
        _Pragma("unroll") for (int e = 0; e < 4; ++e) { const float c0 = bflo(c_[e]), c1 = bfhi(c_[e]), q0 = bflo(q_[e]), q1 = bfhi(q_[e]); const float ma = (e < 2) ? m0_[2 * e] : m1_[2 * e - 4], mb = (e < 2) ? m0_[2 * e + 1] : m1_[2 * e - 3]; \
            dst[2 * e] = c0 + (q0 - c0) * ma; dst[2 * e + 1] = c1 + (q1 - c1) * mb; } } while (0)
    SHIFT_LOAD(k, 512); SHIFT_LOAD(v, 1024);
    if (P3) SHIFT_LOAD(r, 0);
#undef SHIFT_LOAD
    const f32x4 d0 = *(const f32x4*)(DEC + (size_t)gr * RW + hc), d1 = *(const f32x4*)(DEC + (size_t)gr * RW + hc + 4);
    const v4u av = *(const v4u*)(AA + (size_t)gr * RW + hc);
    const f32x4 kk0 = *(const f32x4*)(k_k + hc), kk1 = *(const f32x4*)(k_k + hc + 4), ka0 = *(const f32x4*)(k_a + hc), ka1 = *(const f32x4*)(k_a + hc + 4);
    float a[8], kk[8], kp[8], bb[8]; float ssq = 0.f;
#pragma unroll
    for (int e = 0; e < 4; ++e) { a[2 * e] = bflo(av[e]); a[2 * e + 1] = bfhi(av[e]); }
#pragma unroll
    for (int e = 0; e < 8; ++e) { const float kkw = (e < 4) ? kk0[e] : kk1[e - 4], kaw = (e < 4) ? ka0[e] : ka1[e - 4];
        kk[e] = k[e] * kkw; ssq += kk[e] * kk[e]; kp[e] = k[e] * (1.0f + (a[e] - 1.0f) * kaw); }
    ssq = sum8(ssq);
    const float inv = 1.0f / fmaxf(sqrtf(ssq), 1e-12f);
#pragma unroll
    for (int e = 0; e < 8; ++e) { kk[e] *= inv; bb[e] = kk[e] * a[e]; }
    constexpr int AS = TS * 64;
    float* base = su + tt * 64 + c8;
    *(f32x4*)(base + SC_W * AS) = d0; *(f32x4*)(base + SC_W * AS + 4) = d1;
    *(f32x4*)(base + SC_B * AS) = (f32x4){bb[0], bb[1], bb[2], bb[3]}; *(f32x4*)(base + SC_B * AS + 4) = (f32x4){bb[4], bb[5], bb[6], bb[7]};
    *(f32x4*)(base + SC_K * AS) = (f32x4){kp[0], kp[1], kp[2], kp[3]}; *(f32x4*)(base + SC_K * AS + 4) = (f32x4){kp[4], kp[5], kp[6], kp[7]};
    *(f32x4*)(base + SC_KK * AS) = (f32x4){kk[0], kk[1], kk[2], kk[3]}; *(f32x4*)(base + SC_KK * AS + 4) = (f32x4){kk[4], kk[5], kk[6], kk[7]};
    *(f32x4*)(base + SC_V * AS) = (f32x4){v[0], v[1], v[2], v[3]}; *(f32x4*)(base + SC_V * AS + 4) = (f32x4){v[4], v[5], v[6], v[7]};
    if (P3) {
        *(f32x4*)(base + SC_R * AS) = (f32x4){r[0], r[1], r[2], r[3]}; *(f32x4*)(base + SC_R * AS + 4) = (f32x4){r[4], r[5], r[6], r[7]};
        const f32x4 rk0 = *(const f32x4*)(r_k + hc), rk1 = *(const f32x4*)(r_k + hc + 4); float bc = 0.f;
#pragma unroll
        for (int e = 0; e < 8; ++e) bc += r[e] * kp[e] * ((e < 4) ? rk0[e] : rk1[e - 4]);
        bc = sum8(bc);
        if (bcw) bcl[tt] = bc;
    }
}
#define LD16(dst, ptr) do { const f32x4 x0_ = *(const f32x4*)(ptr), x1_ = *(const f32x4*)((ptr) + 4), x2_ = *(const f32x4*)((ptr) + 8), x3_ = *(const f32x4*)((ptr) + 12); \
        dst[0] = LO2(x0_); dst[1] = HI2(x0_); dst[2] = LO2(x1_); dst[3] = HI2(x1_); dst[4] = LO2(x2_); dst[5] = HI2(x2_); dst[6] = LO2(x3_); dst[7] = HI2(x3_); } while (0)
template <int RPL, bool WITH_O, bool REAL, int TS> __device__ __forceinline__ void scanL_run(float* su, f32x2 (&S)[RPL][8], int r, int g, int rowbase) {
    constexpr int AS = TS * 64;
#pragma unroll 1
    for (int t = 0; t < TS; ++t) {
        const float* st = su + t * 64 + 16 * g;
        f32x2 w2[8], b2[8], kk2[8], k2[8], r2[8];
        LD16(kk2, st + SC_KK * AS); LD16(w2, st + SC_W * AS); LD16(b2, st + SC_B * AS);
        if (REAL) LD16(k2, st + SC_K * AS);
        if (WITH_O) LD16(r2, st + SC_R * AS);
        float vv[RPL];
#pragma unroll
        for (int j = 0; j < RPL; ++j) vv[j] = REAL ? su[SC_V * AS + t * 64 + rowbase + 16 * j + r] : 0.f;
#pragma unroll
        for (int j = 0; j < RPL; ++j) {
            f32x2 p0 = S[j][0] * kk2[0], p1 = S[j][1] * kk2[1];
#pragma unroll
            for (int i = 2; i < 8; i += 2) { p0 = S[j][i] * kk2[i] + p0; p1 = S[j][i + 1] * kk2[i + 1] + p1; }
            p0 += p1;
            const float nsa = -rowsum4(p0[0] + p0[1]);
            const f32x2 nsa2 = (f32x2){nsa, nsa}, v2 = (f32x2){vv[j], vv[j]};
            f32x2 q0 = (f32x2){0.f, 0.f}, q1 = q0;
#pragma unroll
            for (int i = 0; i < 8; ++i) { f32x2 tt_ = nsa2 * b2[i]; if (REAL) tt_ = v2 * k2[i] + tt_; S[j][i] = S[j][i] * w2[i] + tt_;
                if (WITH_O) { if (i & 1) q1 = S[j][i] * r2[i] + q1; else q0 = S[j][i] * r2[i] + q0; } }
            if (WITH_O) { q0 += q1; const float o = rowsum4(q0[0] + q0[1]); if (g == 0) su[SC_O * AS + t * 64 + rowbase + 16 * j + r] = o; }
        }
    }
}
__device__ __forceinline__ void scanL_pass1(const Params& p, float* sm, int wave) {
    constexpr int TS = 32, SLOT = 5 * TS * 64, NPAIR = BATCH * (NCH - 1) * 8 / 2;
    float* PST = (float*)(p.ws + WS_PST); float* LST = (float*)(p.ws + WS_LST);
    const int lane = lane_id(), tid = (wave << 6) | lane, r = lane & 15, g = lane >> 4, u2 = wave >> 2, wq = wave & 3; const bool real = wq < 2; const int rowbase = (wq & 1) * 32;
    float* su = sm + u2 * SLOT;
    const int ltt = (tid >> 3) & 31, lc8 = (tid & 7) * 8;
    for (int up = blockIdx.x; up < NPAIR; up += gridDim.x) {
        const int u = 2 * up + u2, h = u & 7, bc = u >> 3, c = bc % (NCH - 1), b = bc / (NCH - 1);
        f32x2 S[2][8];
#pragma unroll
        for (int j = 0; j < 2; ++j)
#pragma unroll
            for (int i = 0; i < 8; ++i) { const int row = rowbase + 16 * j + r, col = 16 * g + 2 * i; S[j][i] = (f32x2){(!real && row == col) ? 1.f : 0.f, (!real && row == col + 1) ? 1.f : 0.f}; }
        for (int sub = 0; sub < CH / TS; ++sub) {
            __syncthreads();
            scanL_load<false, TS>(p, su, nullptr, b, h, c * CH + sub * TS, ltt, lc8, false);
            __syncthreads();
            if (real) scanL_run<2, false, true, TS>(su, S, r, g, rowbase); else scanL_run<2, false, false, TS>(su, S, r, g, rowbase);
        }
        float* dst = (real ? LST : PST) + ((size_t)((b * NCH + c) * 8 + h)) * 4096 + 16 * g;
#pragma unroll
        for (int j = 0; j < 2; ++j) { float* d = dst + (rowbase + 16 * j + r) * 64;
#pragma unroll
            for (int i = 0; i < 4; ++i) *(f32x4*)(d + 4 * i) = (f32x4){S[j][2 * i][0], S[j][2 * i][1], S[j][2 * i + 1][0], S[j][2 * i + 1][1]}; }
    }
}
__device__ __forceinline__ void scanL_pass3(const Params& p, float* sm, int wave) {
    constexpr int TS = 16, AS = TS * 64, SLOT = 7 * AS, NQ = BATCH * NCH * 8 / 4;
    const float* LST = (const float*)(p.ws + WS_LST); const bf16* GG = (const bf16*)(p.ws + WS_GG); bf16* MIX = (bf16*)(p.ws + WS_MIX);
    const float* ln_w = inp(17); const float* ln_b = inp(18);
    const int lane = lane_id(), tid = (wave << 6) | lane, r = lane & 15, g = lane >> 4, u4 = wave >> 1, rowbase = (wave & 1) * 32;
    float* su = sm + u4 * SLOT; float* bcl = sm + 4 * SLOT + u4 * TS;
    const int tt = (tid >> 3) & 15, c8 = (tid & 7) * 8;
    for (int uq = blockIdx.x; uq < NQ; uq += gridDim.x) {
        const int u = 4 * uq + u4, h = u & 7, bc = u >> 3, c = bc % NCH, b = bc / NCH, hc = h * 64 + c8;
        f32x2 S[2][8];
#pragma unroll
        for (int j = 0; j < 2; ++j) {
            if (c > 0) { const float* src = LST + ((size_t)((b * NCH + c - 1) * 8 + h)) * 4096 + (rowbase + 16 * j + r) * 64 + 16 * g;
#pragma unroll
                for (int i = 0; i < 4; ++i) { const f32x4 s4 = *(const f32x4*)(src + 4 * i); S[j][2 * i] = LO2(s4); S[j][2 * i + 1] = HI2(s4); } }
            else {
#pragma unroll
                for (int i = 0; i < 8; ++i) S[j][i] = (f32x2){0.f, 0.f}; } }
        for (int sub = 0; sub < CH / TS; ++sub) {
            __syncthreads();
            scanL_load<true, TS>(p, su, bcl, b, h, c * CH + sub * TS, tt, c8, (tid & 7) == 0);
            __syncthreads();
            scanL_run<2, true, true, TS>(su, S, r, g, rowbase);
            __syncthreads();
            const int gr = b * SEQ + c * CH + sub * TS + tt;
            const f32x4 o0 = *(const f32x4*)(su + SC_O * AS + tt * 64 + c8), o1 = *(const f32x4*)(su + SC_O * AS + tt * 64 + c8 + 4);
            const f32x4 v0 = *(const f32x4*)(su + SC_V * AS + tt * 64 + c8), v1 = *(const f32x4*)(su + SC_V * AS + tt * 64 + c8 + 4);
            const float bcv = bcl[tt];
            float mu = ((o0[0] + o0[1]) + (o0[2] + o0[3])) + ((o1[0] + o1[1]) + (o1[2] + o1[3])); mu = sum8(mu) * (1.0f / 64.0f);
            const f32x4 e0 = o0 - mu, e1 = o1 - mu;
            float var = ((e0[0] * e0[0] + e0[1] * e0[1]) + (e0[2] * e0[2] + e0[3] * e0[3])) + ((e1[0] * e1[0] + e1[1] * e1[1]) + (e1[2] * e1[2] + e1[3] * e1[3])); var = sum8(var) * (1.0f / 64.0f);
            const float rs = 1.0f / sqrtf(var + 64e-5f);
            const f32x4 lw0 = *(const f32x4*)(ln_w + hc), lw1 = *(const f32x4*)(ln_w + hc + 4), lb0 = *(const f32x4*)(ln_b + hc), lb1 = *(const f32x4*)(ln_b + hc + 4);
            const v4u gv = *(const v4u*)(GG + (size_t)gr * RW + hc);
            f32x4 y0 = (e0 * rs) * lw0 + lb0 + v0 * bcv, y1 = (e1 * rs) * lw1 + lb1 + v1 * bcv;
            y0[0] *= bflo(gv[0]); y0[1] *= bfhi(gv[0]); y0[2] *= bflo(gv[1]); y0[3] *= bfhi(gv[1]); y1[0] *= bflo(gv[2]); y1[1] *= bfhi(gv[2]); y1[2] *= bflo(gv[3]); y1[3] *= bfhi(gv[3]);
            v4u w; w.x = cvt_pk_bf16(y0[0], y0[1]); w.y = cvt_pk_bf16(y0[2], y0[3]); w.z = cvt_pk_bf16(y1[0], y1[1]); w.w = cvt_pk_bf16(y1[2], y1[3]);
            *(v4u*)(MIX + (size_t)gr * DM + hc) = w;
        }
    }
}

__device__ __forceinline__ void scan_pass2(const Params& p, float* sm, int wave) {
    const float* PST = (const float*)(p.ws + WS_PST); float* LST = (float*)(p.ws + WS_LST);
    const int lane = lane_id(), tid = (wave << 6) | lane, vb = (blockIdx.x & 7) * (gridDim.x >> 3) + (blockIdx.x >> 3);
    if (vb >= 128) return;
    const int chain = vb >> 3, row = (vb & 7) * 8 + wave, b = chain >> 3, h = chain & 7;
    float* Pb = sm; float* Sw = sm + 8192 + wave * 64;
    constexpr int NS = NCH - 1;
#define UOFF(c) ((size_t)((b * NCH + (c)) * 8 + h) * 4096)
#define LDP(X0, X1, LX, c) do { X0 = *(const f32x4*)(PST + UOFF(c) + tid * 8); X1 = *(const f32x4*)(PST + UOFF(c) + tid * 8 + 4); LX = LST[UOFF(c) + row * 64 + lane]; } while (0)
    f32x4 A0, A1, B0, B1, C0, C1; float LA = 0.f, LB = 0.f, LC = 0.f, Lcur;
    __syncthreads();
    LDP(A0, A1, LA, 0);
    *(f32x4*)(Pb + tid * 8) = A0; *(f32x4*)(Pb + tid * 8 + 4) = A1; Lcur = LA;
    Sw[lane] = 0.f;
    LDP(B0, B1, LB, 1); LDP(C0, C1, LC, 2); LDP(A0, A1, LA, 3);
    __syncthreads();
#define P2STEP(c, X0, X1, LX) do { float Lnx = 0.f; \
        if ((c) + 1 < NS) { float* Pn = Pb + (((c) + 1) & 1) * 4096; *(f32x4*)(Pn + tid * 8) = X0; *(f32x4*)(Pn + tid * 8 + 4) = X1; Lnx = LX; } \
        if ((c) + 4 < NS) LDP(X0, X1, LX, (c) + 4); \
        const float* Pc = Pb + ((c) & 1) * 4096 + lane; float a0 = 0.f, a1 = 0.f, a2 = 0.f, a3 = 0.f; \
        _Pragma("unroll") for (int i = 0; i < 64; i += 4) { const f32x4 s4 = *(const f32x4*)(Sw + i); \
            a0 += s4[0] * Pc[(i + 0) * 64]; a1 += s4[1] * Pc[(i + 1) * 64]; a2 += s4[2] * Pc[(i + 2) * 64]; a3 += s4[3] * Pc[(i + 3) * 64]; } \
        const float sn = ((a0 + a1) + (a2 + a3)) + Lcur; LST[UOFF(c) + row * 64 + lane] = sn; Sw[lane] = sn; Lcur = Lnx; \
        __syncthreads(); } while (0)
    for (int c = 0; c < NS; c += 3) { P2STEP(c, B0, B1, LB); P2STEP(c + 1, C0, C1, LC); P2STEP(c + 2, A0, A1, LA); }
    static_assert(NS % 3 == 0, "pass 2 is unrolled by 3");
#undef P2STEP
#undef LDP
#undef UOFF
}
__device__ __forceinline__ void scan_pass3(const Params& p, float* sm, int wave, int lane) {
    const float* LST = (const float*)(p.ws + WS_LST); const bf16* GG = (const bf16*)(p.ws + WS_GG); bf16* MIX = (bf16*)(p.ws + WS_MIX);
    const float* ln_w = inp(17); const float* ln_b = inp(18);
    const int tid = TIDX, cs = lane & 15, rg = lane >> 4, rowbase = wave * 8 + rg * 2;
    constexpr int NU = BATCH * NCH * 8;
    for (int u = blockIdx.x; u < NU; u += gridDim.x) {
        const int h = u & 7, bc = u >> 3, c = bc % NCH, b = bc / NCH;
        f32x2 S[2][2];
        if (c > 0) { const float* src = LST + ((size_t)((b * NCH + c - 1) * 8 + h)) * 4096 + rowbase * 64 + 4 * cs;
#pragma unroll
            for (int j = 0; j < 2; ++j) { const f32x4 s4 = *(const f32x4*)(src + j * 64); S[j][0] = LO2(s4); S[j][1] = HI2(s4); } }
        else {
#pragma unroll
            for (int j = 0; j < 2; ++j) { S[j][0] = (f32x2){0.f, 0.f}; S[j][1] = (f32x2){0.f, 0.f}; } }
        for (int sub = 0; sub < 2; ++sub) {
            __syncthreads();
            scan_load<true>(p, sm, b, h, c * CH + sub * 64, wave);
            __syncthreads();
            scan_run<2, true, true>(sm, S, cs, rowbase);
            __syncthreads();
            const int tt = tid >> 3, c8 = (tid & 7) * 8, hc = h * 64 + c8; const int gr = b * SEQ + c * CH + sub * 64 + tt;
            const f32x4 o0 = *(const f32x4*)(sm + SC_O * 4096 + tt * 64 + c8), o1 = *(const f32x4*)(sm + SC_O * 4096 + tt * 64 + c8 + 4);
            const f32x4 v0 = *(const f32x4*)(sm + SC_V * 4096 + tt * 64 + c8), v1 = *(const f32x4*)(sm + SC_V * 4096 + tt * 64 + c8 + 4);
            const float bcv = sm[SC_BC * 4096 + tt];
            float mu = ((o0[0] + o0[1]) + (o0[2] + o0[3])) + ((o1[0] + o1[1]) + (o1[2] + o1[3])); mu = sum8(mu) * (1.0f / 64.0f);
            const f32x4 e0 = o0 - mu, e1 = o1 - mu;
            float var = ((e0[0] * e0[0] + e0[1] * e0[1]) + (e0[2] * e0[2] + e0[3] * e0[3])) + ((e1[0] * e1[0] + e1[1] * e1[1]) + (e1[2] * e1[2] + e1[3] * e1[3])); var = sum8(var) * (1.0f / 64.0f);
            const float rs = 1.0f / sqrtf(var + 64e-5f);
            const f32x4 lw0 = *(const f32x4*)(ln_w + hc), lw1 = *(const f32x4*)(ln_w + hc + 4), lb0 = *(const f32x4*)(ln_b + hc), lb1 = *(const f32x4*)(ln_b + hc + 4);
            const v4u gv = *(const v4u*)(GG + (size_t)gr * RW + hc);
            f32x4 y0 = (e0 * rs) * lw0 + lb0 + v0 * bcv, y1 = (e1 * rs) * lw1 + lb1 + v1 * bcv;
            y0[0] *= bflo(gv[0]); y0[1] *= bfhi(gv[0]); y0[2] *= bflo(gv[1]); y0[3] *= bfhi(gv[1]); y1[0] *= bflo(gv[2]); y1[1] *= bfhi(gv[2]); y1[2] *= bflo(gv[3]); y1[3] *= bfhi(gv[3]);
            v4u w; w.x = cvt_pk_bf16(y0[0], y0[1]); w.y = cvt_pk_bf16(y0[2], y0[3]); w.z = cvt_pk_bf16(y1[0], y1[1]); w.w = cvt_pk_bf16(y1[2], y1[3]);
            *(v4u*)(MIX + (size_t)gr * DM + hc) = w;
        }
    }
}

constexpr int AT_KS = 0, AT_VT = 256 * 72 * 2, AT_PS = AT_VT + 64 * 280 * 2, AT_PSW = 16 * 168 * 2;
__device__ __forceinline__ void attn_phase(const Params& p, unsigned char* lds, int wave, int lane) {
    const bf16* P = (const bf16*)(p.ws + WS_BIG); bf16* MIX = (bf16*)(p.ws + WS_MIX); const float* sinks = inp(19);
    const int tid = TIDX; bf16* Ks = (bf16*)(lds + AT_KS); bf16* Vt = (bf16*)(lds + AT_VT); bf16* Ps = (bf16*)(lds + AT_PS + wave * AT_PSW);
    const int fr = lane & 15, fq = lane >> 4;
    for (int u = blockIdx.x; u < BATCH * 64 * 2; u += gridDim.x) {
        const int g = u & 1, qb = (u >> 1) & 63, b = u >> 7, q0 = qb * 128;
        __syncthreads();
        { const int key = tid >> 1, half = tid & 1; const bool valid = (qb > 0) || (key >= 128);
          const bf16* src = P + (size_t)(b * SEQ + q0 - 128 + key) * NIN + 1792 + 512 + g * 64 + half * 32;
#pragma unroll
          for (int i = 0; i < 4; ++i) { v4u kx = (v4u){0u, 0u, 0u, 0u}, vx = kx; if (valid) { kx = *(const v4u*)(src + 8 * i); vx = *(const v4u*)(src + 128 + 8 * i); }
              *(v4u*)(Ks + key * 72 + half * 32 + 8 * i) = kx;
#pragma unroll
              for (int e = 0; e < 4; ++e) { const int d = half * 32 + 8 * i + 2 * e; Vt[d * 280 + key] = (bf16)(vx[e] & 0xffffu); Vt[(d + 1) * 280 + key] = (bf16)(vx[e] >> 16); } }
          if (tid < 64 * 3) { const int d = tid / 3, part = tid % 3; *(v4u*)(Vt + d * 280 + 256 + 8 * part) = (v4u){0u, 0u, 0u, 0u}; } }
        __syncthreads();
        for (int hq4 = 0; hq4 < 4; ++hq4) {
            const int hq = g * 4 + hq4; const float sink = sinks[hq];
            const bf16* qp = P + (size_t)(b * SEQ + q0 + 16 * wave + fr) * NIN + 1792 + hq * 64 + 8 * fq;
            const bf16x8 qa0 = *(const bf16x8*)qp, qa1 = *(const bf16x8*)(qp + 32);
            f32x4 sc[9]; float mx[4] = {-1e30f, -1e30f, -1e30f, -1e30f};
#pragma unroll
            for (int nt = 0; nt < 9; ++nt) { const int jt = 16 * (wave + nt); const bf16* kp = Ks + (jt + fr) * 72 + 8 * fq;
                const bf16x8 kb0 = *(const bf16x8*)kp, kb1 = *(const bf16x8*)(kp + 32);
                f32x4 a = (f32x4){0.f, 0.f, 0.f, 0.f}; a = __builtin_amdgcn_mfma_f32_16x16x32_bf16(qa0, kb0, a, 0, 0, 0); a = __builtin_amdgcn_mfma_f32_16x16x32_bf16(qa1, kb1, a, 0, 0, 0);
                const int j = jt + fr;
#pragma unroll
                for (int r = 0; r < 4; ++r) { const int i = 16 * wave + 4 * fq + r, dist = i + 128 - j; const bool ok = (dist >= 0) && (dist < 128) && ((qb > 0) || (j >= 128));
                    a[r] = ok ? a[r] * 0.125f : -1e30f; mx[r] = fmaxf(mx[r], a[r]); }
                sc[nt] = a; }
            float sm_[4];
#pragma unroll
            for (int r = 0; r < 4; ++r) { mx[r] = fmaxf(max16(mx[r]), sink); sm_[r] = 0.f; }
#pragma unroll
            for (int nt = 0; nt < 9; ++nt) {
#pragma unroll
                for (int r = 0; r < 4; ++r) { const float e = __expf(sc[nt][r] - mx[r]); sm_[r] += e; Ps[(4 * fq + r) * 168 + nt * 16 + fr] = (bf16)(cvt_pk_bf16(e, 0.f) & 0xffffu); } }
#pragma unroll
            for (int r = 0; r < 4; ++r) { Ps[(4 * fq + r) * 168 + 144 + fr] = 0; sm_[r] = 1.0f / (sum16(sm_[r]) + __expf(sink - mx[r])); }
            __builtin_amdgcn_fence(__ATOMIC_RELEASE, "wavefront"); asm volatile("s_waitcnt lgkmcnt(0)" ::: "memory");
            f32x4 o[4];
#pragma unroll
            for (int dt = 0; dt < 4; ++dt) o[dt] = (f32x4){0.f, 0.f, 0.f, 0.f};
#pragma unroll
            for (int ks = 0; ks < 5; ++ks) { const bf16x8 pa = *(const bf16x8*)(Ps + fr * 168 + ks * 32 + 8 * fq);
#pragma unroll
                for (int dt = 0; dt < 4; ++dt) { const bf16x8 vb = *(const bf16x8*)(Vt + (dt * 16 + fr) * 280 + 16 * wave + ks * 32 + 8 * fq);
                    o[dt] = __builtin_amdgcn_mfma_f32_16x16x32_bf16(pa, vb, o[dt], 0, 0, 0); } }
            bf16* op = MIX + (size_t)(b * SEQ + q0 + 16 * wave + 4 * fq) * DM + 512 + hq * 64 + fr;
#pragma unroll
            for (int r = 0; r < 4; ++r)
#pragma unroll
                for (int dt = 0; dt < 4; ++dt) op[(size_t)r * DM + dt * 16] = (bf16)(cvt_pk_bf16(o[dt][r] * sm_[r], 0.f) & 0xffffu);
            asm volatile("s_waitcnt lgkmcnt(0)" ::: "memory");
        }
    }
}

__device__ __forceinline__ void final_norm(const Params& p, int wave, int lane) {
    const float* ss3 = (const float*)(p.ws + WS_SS) + (size_t)3 * M * 16; const float* gf = inp(25);
    const int gw = blockIdx.x * NWAVES + wave, NGW = gridDim.x * NWAVES;
    f32x4 gfv[4];
#pragma unroll
    for (int j = 0; j < 4; ++j) gfv[j] = ((const f32x4*)gf)[lane + 64 * j];
    for (int m = gw; m < M; m += NGW) { const float rs = pg8::row_rstd(ss3, m); f32x4* xr = (f32x4*)(p.out + (size_t)m * DM) + lane;
#pragma unroll
        for (int j = 0; j < 4; ++j) { const f32x4 v = xr[64 * j]; xr[64 * j] = v * rs * gfv[j]; } }
}


#define XB_TMO      128
#define XB_XCNT(j)  (256  + 64 * (j))
#define XB_XSUB(j)  (1280 + 64 * (j))
#define XB_XGEN(j)  (2304 + 64 * (j))
#define XB_TOP      3328
#define XB_TOPGEN   3392
#define XCD_BAR_WORDS 3456
#define XB_SPIN_CAP (1u << 18)

__device__ __forceinline__ unsigned xb_ld(unsigned* p)              { return __hip_atomic_load(p, __ATOMIC_RELAXED, __HIP_MEMORY_SCOPE_AGENT); }
__device__ __forceinline__ unsigned xb_add(unsigned* p, unsigned v) { return __hip_atomic_fetch_add(p, v, __ATOMIC_RELAXED, __HIP_MEMORY_SCOPE_AGENT); }
__device__ __forceinline__ unsigned xb_xcc_id() { return (unsigned)__builtin_amdgcn_s_getreg((3 << 11) | 20) & 0xFu; }
#define XB_SPIN(cond, bar) do { unsigned _sp = 0; while (cond) { __builtin_amdgcn_s_sleep(1); \
    if ((++_sp & 255u) == 0u) { if (xb_ld(&(bar)[XB_TMO])) break; if (_sp > XB_SPIN_CAP) { atomicAdd(&(bar)[XB_TMO], 1u); break; } } } } while (0)

struct XcdBarrier {
    unsigned* bar; unsigned x;
    volatile LAS unsigned* st; int wave;
};

__device__ __forceinline__ XcdBarrier xcd_barrier_post(unsigned* bar, volatile LAS unsigned* st, int wave) {
    XcdBarrier b; b.bar = bar; b.x = xb_xcc_id(); b.st = st; b.wave = wave;
    if (wave == 0 && lane_id() == 0) (void)xb_add(&bar[XB_XCNT(b.x)], 1u);
    return b;
}
__device__ __forceinline__ void xcd_barrier_complete(unsigned* bar, unsigned x, unsigned& nloc, unsigned& nx) {
    const unsigned G = gridDim.x * gridDim.y * gridDim.z;
    unsigned sum, cnt, mine, sp = 0u;
    for (;;) {
        sum = 0u; cnt = 0u; mine = 0u;
#pragma unroll
        for (unsigned j = 0; j < 16; ++j) { const unsigned c = xb_ld(&bar[XB_XCNT(j)]); sum += c; cnt += (c > 0u) ? 1u : 0u; mine = (j == x) ? c : mine; }
        if (sum == G) break;
        __builtin_amdgcn_s_sleep(1);
        if ((++sp & 255u) == 0u) { if (xb_ld(&bar[XB_TMO])) break; if (sp > XB_SPIN_CAP) { atomicAdd(&bar[XB_TMO], 1u); break; } }
    }
    nloc = mine > 0u ? mine : 1u; nx = cnt > 0u ? cnt : 1u;
}

__device__ __forceinline__ void xcd_barrier(const XcdBarrier& b) {
    asm volatile("s_waitcnt vmcnt(0)" ::: "memory");
    __syncthreads();
    if (b.wave == 0 && lane_id() == 0) {
        unsigned* bar = b.bar;
        __builtin_amdgcn_s_waitcnt(0);
        unsigned nloc = b.st[0], nx = b.st[1];
        if (nloc == 0u) { xcd_barrier_complete(bar, b.x, nloc, nx); b.st[0] = nloc; b.st[1] = nx; }
        const unsigned old = xb_add(&bar[XB_XSUB(b.x)], 1u);
        const unsigned gen = old / nloc;
        if (old + 1u == (gen + 1u) * nloc) {
            __builtin_amdgcn_fence(__ATOMIC_RELEASE, "agent");
            asm volatile("s_waitcnt vmcnt(0)" ::: "memory");
            const unsigned og = xb_add(&bar[XB_TOP], 1u);
            const unsigned tg = og / nx;
            if (og + 1u == (tg + 1u) * nx) xb_add(&bar[XB_TOPGEN], 1u);
            else XB_SPIN(xb_ld(&bar[XB_TOPGEN]) == tg, bar);
            __builtin_amdgcn_fence(__ATOMIC_ACQUIRE, "agent");
            xb_add(&bar[XB_XGEN(b.x)], 1u);
            asm volatile("s_waitcnt vmcnt(0)" ::: "memory");
        } else {
            XB_SPIN(xb_ld(&bar[XB_XGEN(b.x)]) == gen, bar);
            __builtin_amdgcn_fence(__ATOMIC_ACQUIRE, "agent");
            asm volatile("s_waitcnt vmcnt(0)" ::: "memory");
        }
    }
    __syncthreads();
}

constexpr int LDS_BYTES = 147456;
constexpr int NPHASE = 12;
#ifndef DUPMASK
#define DUPMASK 0
#endif
__global__ void __launch_bounds__(NTHR, 2) hymba_fwd(Params p) {
    extern __shared__ __attribute__((aligned(16))) unsigned char lds[];
    cg::grid_group grid = cg::this_grid();
    const int wave = __builtin_amdgcn_readfirstlane((int)threadIdx.x >> 6); const int lane = lane_id(); const int tid = (wave << 6) | lane;
    unsigned char* ws = p.ws;
    PG8_LAS unsigned char* lds3 = (PG8_LAS unsigned char*)lds;
    float* ss = (float*)(ws + WS_SS);
    bf16* XB = (bf16*)(ws + WS_XB); bf16* ACT = (bf16*)(ws + WS_BIG); bf16* PB = (bf16*)(ws + WS_BIG);
    const int lo = p.ph_lo, hi = p.ph_hi;
#define IN(k) (lo <= (k) && (k) < hi)
#define REP(k) for (int rep_ = 0; rep_ < 1 + ((DUPMASK >> (k)) & 1); ++rep_)
#ifndef DUPBAR
#define DUPBAR 0
#endif
#define SEAM(k) do { if (IN(k) && IN((k) + 1)) { for (int rb_ = 0; rb_ <= DUPBAR; ++rb_) xcd_barrier(xbar); } } while (0)
    unsigned* bctr = (unsigned*)(ws + WS_CTL);
    volatile LAS unsigned* misc = (volatile LAS unsigned*)(lds3 + 131072 + 1024);
    if (wave == 0 && lane < 2) misc[lane] = 0u;
    if (blockIdx.x == 0) for (int i = tid; i < XCD_BAR_WORDS; i += NTHR) __hip_atomic_store(bctr + i, 0u, __ATOMIC_RELAXED, __HIP_MEMORY_SCOPE_AGENT);
    if (IN(0)) REP(0) { p0_prologue(p, lds, wave, lane_id()); }
    grid.sync();
    XcdBarrier xbar = xcd_barrier_post(bctr, misc, wave);
    if (IN(1)) REP(1) { pg8::Gemm g{XB, (const bf16*)(ws + WS_WGU1), M, 2 * FF, DM}; pg8::StaticOrder S; S.init(M, 2 * FF, gridDim.x, blockIdx.x);
        pg8::EpiSwiGLU E{ACT, ss, FF}; pg8::gemm_phase<pg8::EpiSwiGLU, pg8::StaticOrder, true, true>(lds3, g, S, E, wave); } SEAM(1);
    if (IN(2)) REP(2) { pg8::Gemm g{ACT, (const bf16*)(ws + WS_WD1), M, DM, FF}; pg8::StaticOrder S; S.init(M, DM, gridDim.x, blockIdx.x);
        pg8::EpiRes E{inp(0), p.out, XB, ss + (size_t)M * 16, 0.5f}; pg8::gemm_phase<pg8::EpiRes, pg8::StaticOrder, true, true>(lds3, g, S, E, wave); } SEAM(2);
    if (IN(3)) REP(3) { pg8::Gemm g{XB, (const bf16*)(ws + WS_WIN), M, NIN, DM}; pg8::StaticOrder S; S.init(M, NIN, gridDim.x, blockIdx.x);
        pg8::EpiWin E{PB, ss + (size_t)M * 16, inp(7), 1792, NIN}; pg8::gemm_phase<pg8::EpiWin, pg8::StaticOrder, true, true>(lds3, g, S, E, wave); } SEAM(3);
    if (IN(4)) REP(4) { r1_phase(p, wave); } SEAM(4);
    if (IN(5)) REP(5) { pg8::Gemm g{(const bf16*)(ws + WS_LIN), (const bf16*)(ws + WS_WL), M, 1536, 256}; pg8::StaticOrder S; S.init(M, 1536, gridDim.x, blockIdx.x);
        pg8::EpiLora E{(float*)(ws + WS_DEC), (bf16*)(ws + WS_AA), (bf16*)(ws + WS_GG), inp(9), inp(11)}; pg8::gemm_phase<pg8::EpiLora, pg8::StaticOrder, true, true>(lds3, g, S, E, wave); } SEAM(5);
    if (IN(6)) REP(6) { scanL_pass1(p, (float*)lds, wave); attn_phase(p, lds, wave, lane_id()); } SEAM(6);
    if (IN(7)) REP(7) { scan_pass2(p, (float*)lds, wave); } SEAM(7);
    if (IN(8)) REP(8) { scanL_pass3(p, (float*)lds, wave); __syncthreads(); } SEAM(8);
    if (IN(9)) REP(9) { pg8::Gemm g{(const bf16*)(ws + WS_MIX), (const bf16*)(ws + WS_WOUT), M, DM, DM}; pg8::StaticOrder S; S.init(M, DM, gridDim.x, blockIdx.x);
        pg8::EpiRes E{p.out, p.out, XB, ss + (size_t)2 * M * 16, 1.0f}; pg8::gemm_phase<pg8::EpiRes, pg8::StaticOrder, true, true>(lds3, g, S, E, wave); } SEAM(9);
    if (IN(10)) REP(10) { pg8::Gemm g{XB, (const bf16*)(ws + WS_WGU2), M, 2 * FF, DM}; pg8::StaticOrder S; S.init(M, 2 * FF, gridDim.x, blockIdx.x);
        pg8::EpiSwiGLU E{ACT, ss + (size_t)2 * M * 16, FF}; pg8::gemm_phase<pg8::EpiSwiGLU, pg8::StaticOrder, true, true>(lds3, g, S, E, wave); } SEAM(10);
    if (IN(11)) REP(11) { pg8::Gemm g{ACT, (const bf16*)(ws + WS_WD2), M, DM, FF}; pg8::StaticOrder S; S.init(M, DM, gridDim.x, blockIdx.x);
        pg8::EpiRes E{p.out, p.out, nullptr, ss + (size_t)3 * M * 16, 0.5f}; pg8::gemm_phase<pg8::EpiRes, pg8::StaticOrder, true, true>(lds3, g, S, E, wave); } SEAM(11);
    if (IN(12)) REP(12) { final_norm(p, wave, lane_id()); }
#undef IN
#undef SEAM
}

extern "C" void kernel_launch(void* const* d_in, const int* in_sizes, int n_in, void* d_out, int out_size, void* d_ws, size_t ws_size, hipStream_t stream) {
    static int grid = 0;
    if (grid == 0) {
        if (n_in != 26 || out_size != M * DM || ws_size < WS_END) { fprintf(stderr, "kernel_launch: unexpected sizes n_in %d out %d ws %zu\n", n_in, out_size, ws_size); grid = -1; return; }
        int dev = 0, cus = 0, per_cu = 0;
        hipGetDevice(&dev); hipDeviceGetAttribute(&cus, hipDeviceAttributeMultiprocessorCount, dev);
        hipFuncSetAttribute((const void*)hymba_fwd, hipFuncAttributeMaxDynamicSharedMemorySize, LDS_BYTES);
        hipOccupancyMaxActiveBlocksPerMultiprocessor(&per_cu, (const void*)hymba_fwd, NTHR, LDS_BYTES);
        (void)hipGetLastError();
        if (per_cu < 1) per_cu = 1;
        grid = cus * per_cu; if (grid > 256) grid = 256;
        if (grid != 256) fprintf(stderr, "kernel_launch: grid %d (cus %d per_cu %d), kernel assumes 256\n", grid, cus, per_cu);
    }
    if (grid < 0) return;
    Params p{};
    for (int i = 0; i < 26; ++i) p.in[i] = (const float*)d_in[i];
    p.out = (float*)d_out; p.ws = (unsigned char*)d_ws; p.ph_lo = 0; p.ph_hi = NPHASE + 1;
    void* args[] = {&p};
    hipError_t e = hipLaunchCooperativeKernel((const void*)hymba_fwd, dim3(grid), dim3(NTHR), args, LDS_BYTES, stream);
    if (e != hipSuccess) fprintf(stderr, "cooperative launch failed: %s (grid %d)\n", hipGetErrorString(e), grid);
}
```

```cpp
#include <hip/hip_runtime.h>
#include <hip/hip_cooperative_groups.h>
#include <cstdio>
#include <cstdint>
namespace cg = cooperative_groups;
namespace pg8 {
#define PG8_LAS __attribute__((address_space(3)))
typedef unsigned short bf16_t;
typedef short bf16x8 __attribute__((ext_vector_type(8)));
typedef float f32x4 __attribute__((ext_vector_type(4)));
typedef unsigned u32x4 __attribute__((ext_vector_type(4)));
constexpr int BM = 256, BK = 64, HALF = 128, HTB = HALF * BK * 2  , STAGE_BYTES = 8 * HTB, NXCD = 8, WGM = 8;

__host__ __device__ __forceinline__ int lds_byte(int r, int c) { const int st = (r >> 4) * 2 + (c >> 5), rr = r & 15, cc = c & 31, ob = rr * 64 + cc * 2; return st * 1024 + (ob ^ (((ob >> 9) & 1) << 5)); }
__host__ __device__ __forceinline__ void stage_rc(int b, int& R, int& C) { const int st = b / 1024, sb = b % 1024, swz = sb ^ (((sb >> 9) & 1) << 5); R = (st >> 1) * 16 + swz / 64; C = (st & 1) * 32 + (swz % 64) / 2; }
__host__ __device__ __forceinline__ int perm32(int rho) { const int n = rho >> 4, i = rho & 15; return 8 * (i >> 2) + 4 * n + (i & 3); }

struct Unit { int pm, pn; };
struct Gemm { const bf16_t* A; const bf16_t* Bt; int M, N, K; };

struct StaticOrder {
    int nM, nN, nwg, G, c;
    __host__ __device__ void init(int M, int N, int G_, int c_) { nM = M / BM; nN = N / BM; nwg = nM * nN; G = G_; c = c_; }
    __host__ __device__ bool next(int i, Unit& u) const {
        const long L = (long)i * G + c; if (L >= nwg) return false;
        int wgid = (int)L; { const int q = nwg / NXCD, r = nwg % NXCD, xcd = wgid % NXCD, off = wgid / NXCD; wgid = (xcd < r ? xcd * (q + 1) : r * (q + 1) + (xcd - r) * q) + off; }
        const int nig = WGM * nN, gid = wgid / nig, fm = gid * WGM, gsz = (nM - fm) < WGM ? (nM - fm) : WGM;
        u.pm = fm + ((wgid % nig) % gsz); u.pn = (wgid % nig) / gsz; return true;
    }
    __device__ __forceinline__ void a_ready(const Unit&) const {}
    __device__ __forceinline__ void done(const Unit&) const {}
};

typedef float f32x2 __attribute__((ext_vector_type(2)));
typedef __bf16 bf16x2_t __attribute__((ext_vector_type(2)));
typedef unsigned u32x2 __attribute__((ext_vector_type(2)));
__device__ __forceinline__ unsigned cvt_pk_bf16(float lo, float hi) { f32x2 v = {lo, hi}; bf16x2_t b = __builtin_convertvector(v, bf16x2_t); return __builtin_bit_cast(unsigned, b); }
__device__ __forceinline__ float row_rstd(const float* ss, int row) {
    const f32x4* p = (const f32x4*)(ss + (size_t)row * 16); const f32x4 a = p[0], b = p[1], c = p[2], d = p[3];
    const float s = (((a[0] + a[1]) + (a[2] + a[3])) + ((b[0] + b[1]) + (b[2] + b[3]))) + (((c[0] + c[1]) + (c[2] + c[3])) + ((d[0] + d[1]) + (d[2] + d[3])));
    return 1.0f / sqrtf(s * (1.0f / 1024.0f) + 1e-5f);
}
__device__ __forceinline__ float silu_mul(float g, float u) { return g * __builtin_amdgcn_rcpf(1.0f + __expf(-g)) * u; }

struct EpiSwiGLU {
    static constexpr bool PERM = true, AFTER_DRAIN = false;
    bf16_t* O; const float* ss; int ldo;
    __device__ __forceinline__ void operator()(const f32x4 (&acc)[2][2][4][2], const Unit& u, int wr, int wc, int fr, int fq) const {
        const int row0 = u.pm * BM + wr * 64 + fr; const int col0 = u.pn * HALF + wc * 32 + 8 * fq;
#pragma unroll
        for (int ai = 0; ai < 2; ++ai)
#pragma unroll
            for (int m = 0; m < 4; ++m) { const int row = row0 + ai * HALF + m * 16; const float rs = row_rstd(ss, row);
                const f32x4 g0 = acc[ai][0][m][0] * rs, g1 = acc[ai][0][m][1] * rs, u0 = acc[ai][1][m][0] * rs, u1 = acc[ai][1][m][1] * rs;
                u32x4 w; w.x = cvt_pk_bf16(silu_mul(g0[0], u0[0]), silu_mul(g0[1], u0[1])); w.y = cvt_pk_bf16(silu_mul(g0[2], u0[2]), silu_mul(g0[3], u0[3]));
                w.z = cvt_pk_bf16(silu_mul(g1[0], u1[0]), silu_mul(g1[1], u1[1])); w.w = cvt_pk_bf16(silu_mul(g1[2], u1[2]), silu_mul(g1[3], u1[3]));
                *(u32x4*)(O + (size_t)row * ldo + col0) = w; }
    }
};
struct EpiRes {
    static constexpr bool PERM = false, AFTER_DRAIN = false;
    const float* base; float* out; bf16_t* xb; float* ss; float alpha;
    __device__ __forceinline__ void operator()(const f32x4 (&acc)[2][2][4][2], const Unit& u, int wr, int wc, int fr, int fq) const {
        const int row0 = u.pm * BM + wr * 64 + fr; const int col0 = u.pn * BM + wc * 32 + 4 * fq;
#pragma unroll
        for (int ai = 0; ai < 2; ++ai)
#pragma unroll
            for (int m = 0; m < 4; ++m) { const int row = row0 + ai * HALF + m * 16; const size_t off = (size_t)row * 1024 + col0; float sq = 0.f;
#pragma unroll
                for (int bj = 0; bj < 2; ++bj)
#pragma unroll
                    for (int n = 0; n < 2; ++n) { const f32x4 bs = *(const f32x4*)(base + off + bj * HALF + n * 16); const f32x4 o = bs + acc[ai][bj][m][n] * alpha;
                        *(f32x4*)(out + off + bj * HALF + n * 16) = o; sq += (o[0] * o[0] + o[1] * o[1]) + (o[2] * o[2] + o[3] * o[3]);
                        if (xb) { u32x2 w; w.x = cvt_pk_bf16(o[0], o[1]); w.y = cvt_pk_bf16(o[2], o[3]); *(u32x2*)(xb + off + bj * HALF + n * 16) = w; } }
                sq += __shfl_xor(sq, 16); sq += __shfl_xor(sq, 32);
                if (fq == 0) ss[(size_t)row * 16 + u.pn * 4 + wc] = sq; }
    }
};
struct EpiWin {
    static constexpr bool PERM = true, AFTER_DRAIN = false;
    bf16_t* O; const float* ss; const float* bias; int bias_from; int ldo;
    __device__ __forceinline__ void operator()(const f32x4 (&acc)[2][2][4][2], const Unit& u, int wr, int wc, int fr, int fq) const {
        const int row0 = u.pm * BM + wr * 64 + fr; const int col0 = u.pn * BM + wc * 32 + 8 * fq;
        f32x4 bv[2][2];
#pragma unroll
        for (int bj = 0; bj < 2; ++bj)
#pragma unroll
            for (int n = 0; n < 2; ++n) { const int c = col0 + bj * HALF + 4 * n; bv[bj][n] = (c >= bias_from) ? *(const f32x4*)(bias + (c - bias_from)) : (f32x4){0.f, 0.f, 0.f, 0.f}; }
#pragma unroll
        for (int ai = 0; ai < 2; ++ai)
#pragma unroll
            for (int m = 0; m < 4; ++m) { const int row = row0 + ai * HALF + m * 16; const float rs = row_rstd(ss, row);
#pragma unroll
                for (int bj = 0; bj < 2; ++bj) { const f32x4 v0 = acc[ai][bj][m][0] * rs + bv[bj][0], v1 = acc[ai][bj][m][1] * rs + bv[bj][1];
                    u32x4 w; w.x = cvt_pk_bf16(v0[0], v0[1]); w.y = cvt_pk_bf16(v0[2], v0[3]); w.z = cvt_pk_bf16(v1[0], v1[1]); w.w = cvt_pk_bf16(v1[2], v1[3]);
                    *(u32x4*)(O + (size_t)row * ldo + col0 + bj * HALF) = w; } }
    }
};
struct EpiLora {
    static constexpr bool PERM = true, AFTER_DRAIN = false;
    float* DEC; bf16_t* AA; bf16_t* GG; const float* w0; const float* a0;
    __device__ __forceinline__ void operator()(const f32x4 (&acc)[2][2][4][2], const Unit& u, int wr, int wc, int fr, int fq) const {
        const int row0 = u.pm * BM + wr * 64 + fr; const int kind = u.pn >> 1; const int col0 = (u.pn & 1) * BM + wc * 32 + 8 * fq;
#pragma unroll
        for (int bj = 0; bj < 2; ++bj) { const int c = col0 + bj * HALF;
            f32x4 b0 = (f32x4){0.f, 0.f, 0.f, 0.f}, b1 = b0;
            if (kind == 0) { b0 = *(const f32x4*)(w0 + c); b1 = *(const f32x4*)(w0 + c + 4); } else if (kind == 1) { b0 = *(const f32x4*)(a0 + c); b1 = *(const f32x4*)(a0 + c + 4); }
#pragma unroll
            for (int ai = 0; ai < 2; ++ai)
#pragma unroll
                for (int m = 0; m < 4; ++m) { const int row = row0 + ai * HALF + m * 16; f32x4 v0 = acc[ai][bj][m][0] + b0, v1 = acc[ai][bj][m][1] + b1;
                    if (kind == 0) {
#pragma unroll
                        for (int e = 0; e < 4; ++e) { v0[e] = expf(-0.60653065971f / (1.0f + expf(-v0[e]))); v1[e] = expf(-0.60653065971f / (1.0f + expf(-v1[e]))); }
                        *(f32x4*)(DEC + (size_t)row * 512 + c) = v0; *(f32x4*)(DEC + (size_t)row * 512 + c + 4) = v1;
                    } else {
                        if (kind == 1) {
#pragma unroll
                            for (int e = 0; e < 4; ++e) { v0[e] = 1.0f / (1.0f + expf(-v0[e])); v1[e] = 1.0f / (1.0f + expf(-v1[e])); } }
                        u32x4 w; w.x = cvt_pk_bf16(v0[0], v0[1]); w.y = cvt_pk_bf16(v0[2], v0[3]); w.z = cvt_pk_bf16(v1[0], v1[1]); w.w = cvt_pk_bf16(v1[2], v1[3]);
                        *(u32x4*)((kind == 1 ? AA : GG) + (size_t)row * 512 + c) = w; } }
        }
    }
};

template <class Epi, class Sched, bool ALIGN_EPI = false, bool SP2 = false>
__device__ __forceinline__ void gemm_phase(PG8_LAS unsigned char* lds, const Gemm g, const Sched& S, const Epi& E, const int wid) {
    const int lane = (int)__builtin_amdgcn_mbcnt_hi(~0u, __builtin_amdgcn_mbcnt_lo(~0u, 0u)), tid = (wid << 6) | lane, wr = wid >> 2, wc = wid & 3, fr = lane & 15, fq = lane >> 4;
    int K = g.K; asm volatile("" : "+s"(K)); const int nt = K / BK;
    unsigned voffA[2], voffB[2];
#pragma unroll
    for (int i = 0; i < 2; ++i) { int R, C; stage_rc(tid * 16 + i * 8192, R, C); const int Rb = Epi::PERM ? ((R & ~31) + perm32(R & 31)) : R;
        voffA[i] = (unsigned)(R * K + C) * 2u; voffB[i] = (unsigned)(Rb * K + C) * 2u; }
    const size_t kstep = (size_t)(BK * 2);
    const size_t hstep = (size_t)HALF * K * 2;
    const size_t tstep = 2 * hstep;
    const unsigned ldsw = (unsigned)wid * 1024u;
    const int aoff = lds_byte(wr * 64 + fr, fq * 8), boff = lds_byte(wc * 32 + fr, fq * 8);
#define PG8_SA(b, h) (((b) * 2 + (h)) * HTB)
#define PG8_SB(b, h) ((4 + (b) * 2 + (h)) * HTB)
#define PG8_STAGE(bufoff, gbase, voff) do { _Pragma("unroll") for (int _i = 0; _i < 2; ++_i) \
        __builtin_amdgcn_global_load_lds((const unsigned*)((const char*)(gbase) + (voff)[_i]), (PG8_LAS unsigned*)(lds + (bufoff) + ldsw + _i * 8192), 16, 0, 0); } while (0)
#define PG8_LDA(dst, b, h) do { _Pragma("unroll") for (int m = 0; m < 4; ++m) _Pragma("unroll") for (int k = 0; k < 2; ++k) dst[m][k] = *(const PG8_LAS bf16x8*)(lds + PG8_SA(b, h) + aoff + m * 2048 + k * 1024); } while (0)
#define PG8_LDB(dst, b, h) do { _Pragma("unroll") for (int n = 0; n < 2; ++n) _Pragma("unroll") for (int k = 0; k < 2; ++k) dst[n][k] = *(const PG8_LAS bf16x8*)(lds + PG8_SB(b, h) + boff + n * 2048 + k * 1024); } while (0)
#define PG8_MMA(ai, bj, At, Bt) do { __builtin_amdgcn_s_setprio(1); _Pragma("unroll") for (int m = 0; m < 4; ++m) _Pragma("unroll") for (int n = 0; n < 2; ++n) _Pragma("unroll") for (int k = 0; k < 2; ++k) \
        acc[ai][bj][m][n] = __builtin_amdgcn_mfma_f32_16x16x32_bf16(Bt[n][k], At[m][k], acc[ai][bj][m][n], 0, 0, 0); __builtin_amdgcn_s_setprio(0); } while (0)
#define PG8_WAIT_V(n) asm volatile("s_waitcnt vmcnt(" #n ")" ::: "memory")
#define PG8_WAIT_L(n) asm volatile("s_waitcnt lgkmcnt(" #n ")" ::: "memory")
#define PG8_BAR __builtin_amdgcn_s_barrier()
#define PG8_SCHED __builtin_amdgcn_sched_barrier(0)
    Unit cur, nxt; int ui = 0;
    if (!S.next(0, cur)) return;
    f32x4 acc[2][2][4][2];
#pragma unroll
    for (int a = 0; a < 2; ++a)
#pragma unroll
        for (int b = 0; b < 2; ++b)
#pragma unroll
            for (int m = 0; m < 4; ++m)
#pragma unroll
                for (int n = 0; n < 2; ++n) acc[a][b][m][n] = (f32x4){0.f, 0.f, 0.f, 0.f};
    bf16x8 At[4][2], B0[2][2], B1[2][2];
    const char* cA = (const char*)g.A + (size_t)cur.pm * tstep; const char* cB = (const char*)g.Bt + (size_t)cur.pn * tstep;
    S.a_ready(cur);
    if constexpr (SP2) {
        PG8_STAGE(PG8_SB(0, 0), cB, voffB); PG8_STAGE(PG8_SB(0, 1), cB + hstep, voffB); PG8_STAGE(PG8_SA(0, 0), cA, voffA); PG8_STAGE(PG8_SA(0, 1), cA + hstep, voffA);
        if (wr == 1) PG8_BAR;
        PG8_WAIT_V(2); PG8_BAR;
        PG8_STAGE(PG8_SB(1, 0), cB + kstep, voffB); PG8_STAGE(PG8_SA(1, 0), cA + kstep, voffA); PG8_STAGE(PG8_SB(1, 1), cB + hstep + kstep, voffB);
        PG8_WAIT_V(6); PG8_BAR;
    } else {
        PG8_STAGE(PG8_SB(0, 0), cB, voffB); PG8_STAGE(PG8_SA(0, 0), cA, voffA); PG8_STAGE(PG8_SB(0, 1), cB + hstep, voffB); PG8_STAGE(PG8_SA(0, 1), cA + hstep, voffA);
        if (wr == 1) PG8_BAR;
        PG8_WAIT_V(4); PG8_BAR;
        PG8_STAGE(PG8_SB(1, 0), cB + kstep, voffB); PG8_STAGE(PG8_SA(1, 0), cA + kstep, voffA); PG8_STAGE(PG8_SB(1, 1), cB + hstep + kstep, voffB);
        PG8_WAIT_V(6); PG8_BAR;
    }
    for (;;) {
        const bool has_next = S.next(ui + 1, nxt);
        const char* nA = has_next ? (const char*)g.A + (size_t)nxt.pm * tstep : cA; const char* nB = has_next ? (const char*)g.Bt + (size_t)nxt.pn * tstep : cB;
        for (int t = 0; t < nt; t += 2) {
            const bool last = (t == nt - 2);
            const char* a1 = cA + (size_t)(t + 1) * kstep;
            const char* a2 = last ? nA : cA + (size_t)(t + 2) * kstep; const char* b2 = last ? nB : cB + (size_t)(t + 2) * kstep;
            const char* a3 = a2 + kstep; const char* b3 = b2 + kstep;
            if (last && has_next) S.a_ready(nxt);
            if constexpr (SP2) {
            PG8_LDB(B0, 0, 0); PG8_LDB(B1, 0, 1); PG8_SCHED; PG8_LDA(At, 0, 0); PG8_STAGE(PG8_SA(1, 1), a1 + hstep, voffA);
            PG8_WAIT_V(8); PG8_WAIT_L(0); PG8_BAR; PG8_MMA(0, 0, At, B0); PG8_MMA(0, 1, At, B1); PG8_BAR; PG8_SCHED;
            PG8_LDA(At, 0, 1); PG8_STAGE(PG8_SB(0, 0), b2, voffB); PG8_STAGE(PG8_SB(0, 1), b2 + hstep, voffB); PG8_STAGE(PG8_SA(0, 0), a2, voffA);
            PG8_WAIT_V(8); PG8_WAIT_L(0); PG8_BAR; PG8_MMA(1, 0, At, B0); PG8_MMA(1, 1, At, B1); PG8_BAR; PG8_SCHED;
            PG8_LDB(B0, 1, 0); PG8_LDB(B1, 1, 1); PG8_SCHED; PG8_LDA(At, 1, 0); PG8_STAGE(PG8_SA(0, 1), a2 + hstep, voffA);
            PG8_WAIT_V(8); PG8_WAIT_L(0); PG8_BAR; PG8_MMA(0, 0, At, B0); PG8_MMA(0, 1, At, B1); PG8_BAR; PG8_SCHED;
            PG8_LDA(At, 1, 1); PG8_STAGE(PG8_SB(1, 0), b3, voffB); PG8_STAGE(PG8_SB(1, 1), b3 + hstep, voffB); PG8_STAGE(PG8_SA(1, 0), a3, voffA);
            PG8_WAIT_V(8); PG8_WAIT_L(0); PG8_BAR; PG8_MMA(1, 0, At, B0); PG8_MMA(1, 1, At, B1); PG8_BAR; PG8_SCHED;
            } else {
            PG8_LDB(B0, 0, 0); PG8_SCHED; PG8_LDA(At, 0, 0); PG8_STAGE(PG8_SA(1, 1), a1 + hstep, voffA);
            PG8_WAIT_L(8); PG8_BAR; PG8_WAIT_L(0); PG8_MMA(0, 0, At, B0); PG8_BAR; PG8_SCHED;
            PG8_LDB(B1, 0, 1); PG8_STAGE(PG8_SB(0, 0), b2, voffB);
            PG8_BAR; PG8_WAIT_L(0); PG8_MMA(0, 1, At, B1); PG8_BAR;
            PG8_LDA(At, 0, 1); PG8_STAGE(PG8_SA(0, 0), a2, voffA);
            PG8_BAR; PG8_WAIT_L(0); PG8_MMA(1, 0, At, B0); PG8_BAR; PG8_SCHED;
            PG8_STAGE(PG8_SB(0, 1), b2 + hstep, voffB);
            PG8_WAIT_V(6); PG8_BAR; PG8_MMA(1, 1, At, B1); PG8_BAR;
            PG8_LDB(B0, 1, 0); PG8_SCHED; PG8_LDA(At, 1, 0); PG8_STAGE(PG8_SA(0, 1), a2 + hstep, voffA);
            PG8_WAIT_L(8); PG8_BAR; PG8_WAIT_L(0); PG8_MMA(0, 0, At, B0); PG8_BAR; PG8_SCHED;
            PG8_LDB(B1, 1, 1); PG8_STAGE(PG8_SB(1, 0), b3, voffB);
            PG8_BAR; PG8_WAIT_L(0); PG8_MMA(0, 1, At, B1); PG8_BAR;
            PG8_LDA(At, 1, 1); PG8_STAGE(PG8_SA(1, 0), a3, voffA);
            PG8_BAR; PG8_WAIT_L(0); PG8_MMA(1, 0, At, B0); PG8_BAR; PG8_SCHED;
            PG8_STAGE(PG8_SB(1, 1), b3 + hstep, voffB);
            PG8_WAIT_V(6); PG8_BAR; PG8_MMA(1, 1, At, B1); PG8_BAR;
            }
        }
        if constexpr (ALIGN_EPI) { if (wr == 0) PG8_BAR; }
        if constexpr (!Epi::AFTER_DRAIN) { E(acc, cur, wr, wc, fr, fq); S.done(cur); }
        if (!has_next) break;
#pragma unroll
        for (int a = 0; a < 2; ++a)
#pragma unroll
            for (int b = 0; b < 2; ++b)
#pragma unroll
                for (int m = 0; m < 4; ++m)
#pragma unroll
                    for (int n = 0; n < 2; ++n) acc[a][b][m][n] = (f32x4){0.f, 0.f, 0.f, 0.f};
        cur = nxt; cA = nA; cB = nB; ++ui;
        if constexpr (ALIGN_EPI) { if (wr == 1) PG8_BAR; }
    }
    PG8_WAIT_V(0);
    if constexpr (!ALIGN_EPI) { if (wr == 0) PG8_BAR; }
    PG8_BAR;
    if constexpr (Epi::AFTER_DRAIN) { E.fused(acc, cur, wr, wc, fr, fq, lds, wid, lane); S.done(cur); }
#undef PG8_SA
#undef PG8_SB
#undef PG8_STAGE
#undef PG8_LDA
#undef PG8_LDB
#undef PG8_MMA
#undef PG8_WAIT_V
#undef PG8_WAIT_L
#undef PG8_BAR
#undef PG8_SCHED
}
}

constexpr int BATCH = 2, SEQ = 8192, DM = 1024, FF = 2816, NIN = 2560, RW = 512, M = BATCH * SEQ;
constexpr int NWAVES = 8, NTHR = 512;
constexpr int CH = 128, NCH = SEQ / CH;
constexpr size_t MiB = 1u << 20;
constexpr size_t WS_WGU1 = 0, WS_WD1 = 11 * MiB, WS_WIN = WS_WD1 + 11 * MiB / 2, WS_WOUT = WS_WIN + 5 * MiB, WS_WGU2 = WS_WOUT + 2 * MiB, WS_WD2 = WS_WGU2 + 11 * MiB, WS_WL = 40 * MiB;
constexpr size_t WS_GG = 0;
constexpr size_t WS_XB = 44 * MiB;
constexpr size_t WS_PST = 44 * MiB, WS_LST = 60 * MiB;
constexpr size_t WS_BIG = 76 * MiB;
constexpr size_t WS_LIN = WS_BIG + 80 * MiB;
constexpr size_t WS_DEC = 164 * MiB, WS_AA = 196 * MiB, WS_MIX = 212 * MiB, WS_SS = 244 * MiB, WS_CTL = 248 * MiB, WS_END = 249 * MiB;
static_assert(WS_WD2 + 11 * MiB / 2 <= WS_WL && WS_WL + MiB <= WS_XB, "weights map");

#define LAS __attribute__((address_space(3)))
typedef unsigned short bf16;
typedef unsigned v4u __attribute__((ext_vector_type(4)));
typedef unsigned v2u __attribute__((ext_vector_type(2)));
typedef float f32x4 __attribute__((ext_vector_type(4)));
typedef float f32x2 __attribute__((ext_vector_type(2)));
typedef short bf16x8 __attribute__((ext_vector_type(8)));
using pg8::cvt_pk_bf16;
__device__ __forceinline__ float bflo(unsigned u) { return __uint_as_float(u << 16); }
__device__ __forceinline__ float bfhi(unsigned u) { return __uint_as_float(u & 0xffff0000u); }
template <int CTRL> __device__ __forceinline__ float dpp_mov(float x) { return __builtin_bit_cast(float, __builtin_amdgcn_update_dpp(0, __builtin_bit_cast(int, x), CTRL, 0xF, 0xF, true)); }
__device__ __forceinline__ float sum16(float x) { x += dpp_mov<0xB1>(x); x += dpp_mov<0x4E>(x); x += dpp_mov<0x141>(x); x += dpp_mov<0x140>(x); return x; }
__device__ __forceinline__ float max16(float x) { x = fmaxf(x, dpp_mov<0xB1>(x)); x = fmaxf(x, dpp_mov<0x4E>(x)); x = fmaxf(x, dpp_mov<0x141>(x)); x = fmaxf(x, dpp_mov<0x140>(x)); return x; }
__device__ __forceinline__ float sum8(float x) { x += dpp_mov<0xB1>(x); x += dpp_mov<0x4E>(x); x += dpp_mov<0x141>(x); return x; }
__device__ __forceinline__ float wave_sum(float v) {
#pragma unroll
    for (int o = 1; o < 64; o <<= 1) v += __shfl_xor(v, o);
    return v;
}

__device__ __forceinline__ int lane_id() { return (int)__builtin_amdgcn_mbcnt_hi(~0u, __builtin_amdgcn_mbcnt_lo(~0u, 0u)); }
#define TIDX ((wave << 6) | lane_id())
struct Params {
    const float* in[26]; float* out; unsigned char* ws; int ph_lo, ph_hi;
};


#define GAS __attribute__((address_space(1)))
__device__ __forceinline__ const float* inp(int i) {
    const __attribute__((address_space(4))) char* ka = (const __attribute__((address_space(4))) char*)__builtin_amdgcn_kernarg_segment_ptr();
    int off = i * 8; asm volatile("" : "+s"(off));
    const float* q = *(const float* const __attribute__((address_space(4)))*)(ka + off);
    return (const float*)(const GAS float*)q;
}

__device__ __forceinline__ void conv_item(const float* W, int K, int N, const float* sc, bf16* WT, int k0, int n0, int drow0, float* scr, int lane) {
#pragma unroll 8
    for (int i = 0; i < 32; ++i) { const int kk = 2 * i + (lane >> 5); float v = W[(size_t)(k0 + kk) * N + n0 + (lane & 31)]; if (sc) v *= sc[k0 + kk]; scr[kk * 33 + (lane & 31)] = v; }
    __builtin_amdgcn_fence(__ATOMIC_RELEASE, "wavefront"); asm volatile("s_waitcnt lgkmcnt(0)" ::: "memory");
    const int c = lane & 7;
#pragma unroll
    for (int j = 0; j < 4; ++j) { const int n = (lane >> 3) + 8 * j; const float* s = scr + (8 * c) * 33 + n;
        v4u o; o.x = cvt_pk_bf16(s[0 * 33], s[1 * 33]); o.y = cvt_pk_bf16(s[2 * 33], s[3 * 33]); o.z = cvt_pk_bf16(s[4 * 33], s[5 * 33]); o.w = cvt_pk_bf16(s[6 * 33], s[7 * 33]);
        *(v4u*)(WT + (size_t)(drow0 + n) * K + k0 + 8 * c) = o; }
    asm volatile("s_waitcnt lgkmcnt(0)" ::: "memory");
}
__device__ __forceinline__ void conv_plain(const float* W, int K, int N, const float* sc, bf16* WT, int item, float* scr, int lane) {
    const int nblk = N / 32, kb = item / nblk, nb = item % nblk; conv_item(W, K, N, sc, WT, 64 * kb, 32 * nb, 32 * nb, scr, lane);
}
__device__ __forceinline__ void conv_gu(const float* W, const float* sc, bf16* WT, int item, int up, float* scr, int lane) {
    const int nblk = FF / 32, kb = item / nblk, nb = item % nblk, n0 = 32 * nb; conv_item(W, DM, FF, sc, WT, 64 * kb, n0, (n0 >> 7) * 256 + up * 128 + (n0 & 127), scr, lane);
}
__device__ __forceinline__ void p0_prologue(const Params& p, unsigned char* lds, int wave, int lane) {
    float* scr = (float*)(lds + wave * 16384);
    unsigned char* ws = p.ws;
    const int gw = blockIdx.x * NWAVES + wave, NGW = gridDim.x * NWAVES;
    constexpr int I_GU = (DM / 64) * (FF / 32), I_DN = (FF / 64) * (DM / 32), I_IN = (DM / 64) * (NIN / 32), I_OUT = (DM / 64) * (DM / 32);
    constexpr int NITEMS = 4 * I_GU + 2 * I_DN + I_IN + I_OUT;
    for (int it = gw; it < NITEMS; it += NGW) {
        int r = it;
        if (r < I_GU) { conv_gu(inp(2), inp(1), (bf16*)(ws + WS_WGU1), r, 0, scr, lane); continue; } r -= I_GU;
        if (r < I_GU) { conv_gu(inp(3), inp(1), (bf16*)(ws + WS_WGU1), r, 1, scr, lane); continue; } r -= I_GU;
        if (r < I_DN) { conv_plain(inp(4), FF, DM, nullptr, (bf16*)(ws + WS_WD1), r, scr, lane); continue; } r -= I_DN;
        if (r < I_IN) { conv_plain(inp(6), DM, NIN, inp(5), (bf16*)(ws + WS_WIN), r, scr, lane); continue; } r -= I_IN;
        if (r < I_OUT) { conv_plain(inp(20), DM, DM, nullptr, (bf16*)(ws + WS_WOUT), r, scr, lane); continue; } r -= I_OUT;
        if (r < I_GU) { conv_gu(inp(22), inp(21), (bf16*)(ws + WS_WGU2), r, 0, scr, lane); continue; } r -= I_GU;
        if (r < I_GU) { conv_gu(inp(23), inp(21), (bf16*)(ws + WS_WGU2), r, 1, scr, lane); continue; } r -= I_GU;
        conv_plain(inp(24), FF, DM, nullptr, (bf16*)(ws + WS_WD2), r, scr, lane);
    }
    { bf16* WL = (bf16*)(ws + WS_WL); const float* w2 = inp(10); const float* a2 = inp(12); const float* g2 = inp(13);
      for (int idx = (blockIdx.x * NTHR + TIDX); idx < 1536 * 128; idx += gridDim.x * NTHR) {
          const int n = idx >> 7, k = (idx & 127) * 2; float v0 = 0.f, v1 = 0.f;
          if (n < 512) { if (k < 64) { v0 = w2[k * 512 + n]; v1 = w2[(k + 1) * 512 + n]; } }
          else if (n < 1024) { if (k >= 64 && k < 128) { v0 = a2[(k - 64) * 512 + n - 512]; v1 = a2[(k - 63) * 512 + n - 512]; } }
          else { if (k >= 128) { v0 = g2[(k - 128) * 512 + n - 1024]; v1 = g2[(k - 127) * 512 + n - 1024]; } }
          *(unsigned*)(WL + (size_t)n * 256 + k) = cvt_pk_bf16(v0, v1); } }
    { const float* x = inp(0); bf16* XB = (bf16*)(ws + WS_XB); float* ss0 = (float*)(ws + WS_SS);
      for (int m = gw; m < M; m += NGW) { const f32x4* xr = (const f32x4*)(x + (size_t)m * DM) + lane; float s = 0.f; f32x4 v[4];
#pragma unroll
          for (int j = 0; j < 4; ++j) { v[j] = xr[64 * j]; s += (v[j][0] * v[j][0] + v[j][1] * v[j][1]) + (v[j][2] * v[j][2] + v[j][3] * v[j][3]); }
          s = wave_sum(s);
          v2u* o8 = (v2u*)(XB + (size_t)m * DM) + lane;
#pragma unroll
          for (int j = 0; j < 4; ++j) { v2u w; w.x = cvt_pk_bf16(v[j][0], v[j][1]); w.y = cvt_pk_bf16(v[j][2], v[j][3]); o8[64 * j] = w; }
          if (lane < 16) ss0[(size_t)m * 16 + lane] = (lane == 0) ? s : 0.f; } }
}

__device__ __forceinline__ void r1_phase(const Params& p, int wave) {
    const bf16* P = (const bf16*)(p.ws + WS_BIG); bf16* LIN = (bf16*)(p.ws + WS_LIN); const float* mix = inp(8);
    for (int idx = blockIdx.x * NTHR + TIDX; idx < M * 32; idx += gridDim.x * NTHR) {
        const int row = idx >> 5, g8 = idx & 31, col = 1536 + 8 * g8; const bool hp = (row & (SEQ - 1)) != 0;
        const v4u c = *(const v4u*)(P + (size_t)row * NIN + col); v4u q = (v4u){0u, 0u, 0u, 0u}; if (hp) q = *(const v4u*)(P + (size_t)(row - 1) * NIN + col);
        const f32x4 m0 = *(const f32x4*)(mix + col), m1 = *(const f32x4*)(mix + col + 4);
        float x[8];
#pragma unroll
        for (int e = 0; e < 4; ++e) { const float c0 = bflo(c[e]), c1 = bfhi(c[e]), q0 = bflo(q[e]), q1 = bfhi(q[e]); const float ma = (e < 2) ? m0[2 * e] : m1[2 * e - 4], mb = (e < 2) ? m0[2 * e + 1] : m1[2 * e - 3];
            x[2 * e] = c0 + (q0 - c0) * ma; x[2 * e + 1] = c1 + (q1 - c1) * mb; }
        if (g8 < 8) {
#pragma unroll
            for (int e = 0; e < 8; ++e) x[e] = tanhf(x[e]);
        } else if (g8 >= 16) {
#pragma unroll
            for (int e = 0; e < 8; ++e) x[e] = 1.0f / (1.0f + expf(-x[e]));
        }
        v4u o; o.x = cvt_pk_bf16(x[0], x[1]); o.y = cvt_pk_bf16(x[2], x[3]); o.z = cvt_pk_bf16(x[4], x[5]); o.w = cvt_pk_bf16(x[6], x[7]);
        *(v4u*)(LIN + (size_t)row * 256 + 8 * g8) = o;
    }
}

constexpr int SC_W = 0, SC_B = 1, SC_K = 2, SC_KK = 3, SC_V = 4, SC_R = 5, SC_O = 6, SC_BC = 7;
template <bool P3> __device__ __forceinline__ void scan_load(const Params& p, float* sm, int b, int h, int t0, int wave) {
    const int tid = TIDX, tt = tid >> 3, c8 = (tid & 7) * 8, hc = h * 64 + c8;
    const bf16* P = (const bf16*)(p.ws + WS_BIG); const float* DEC = (const float*)(p.ws + WS_DEC); const bf16* AA = (const bf16*)(p.ws + WS_AA);
    const float* mix = inp(8); const float* k_k = inp(14); const float* k_a = inp(15); const float* r_k = inp(16);
    const int gr = b * SEQ + t0 + tt; const bool hp = (t0 + tt) > 0;
    const bf16* prow = P + (size_t)gr * NIN + hc;
    float r[8], k[8], v[8];
#define SHIFT_LOAD(dst, off) do { const v4u c_ = *(const v4u*)(prow + (off)); v4u q_ = (v4u){0u, 0u, 0u, 0u}; if (hp) q_ = *(const v4u*)(prow + (off) - NIN); \
        const f32x4 m0_ = *(const f32x4*)(mix + hc + (off)), m1_ = *(const f32x4*)(mix + hc + (off) + 4); \
        _Pragma("unroll") for (int e = 0; e < 4; ++e) { const float c0 = bflo(c_[e]), c1 = bfhi(c_[e]), q0 = bflo(q_[e]), q1 = bfhi(q_[e]); const float ma = (e < 2) ? m0_[2 * e] : m1_[2 * e - 4], mb = (e < 2) ? m0_[2 * e + 1] : m1_[2 * e - 3]; \
            dst[2 * e] = c0 + (q0 - c0) * ma; dst[2 * e + 1] = c1 + (q1 - c1) * mb; } } while (0)
    SHIFT_LOAD(k, 512); SHIFT_LOAD(v, 1024);
    if (P3) SHIFT_LOAD(r, 0);
#undef SHIFT_LOAD
    const f32x4 d0 = *(const f32x4*)(DEC + (size_t)gr * RW + hc), d1 = *(const f32x4*)(DEC + (size_t)gr * RW + hc + 4);
    const v4u av = *(const v4u*)(AA + (size_t)gr * RW + hc);
    const f32x4 kk0 = *(const f32x4*)(k_k + hc), kk1 = *(const f32x4*)(k_k + hc + 4), ka0 = *(const f32x4*)(k_a + hc), ka1 = *(const f32x4*)(k_a + hc + 4);
    float a[8], kk[8], kp[8], bb[8]; float ssq = 0.f;
#pragma unroll
    for (int e = 0; e < 4; ++e) { a[2 * e] = bflo(av[e]); a[2 * e + 1] = bfhi(av[e]); }
#pragma unroll
    for (int e = 0; e < 8; ++e) { const float kkw = (e < 4) ? kk0[e] : kk1[e - 4], kaw = (e < 4) ? ka0[e] : ka1[e - 4];
        kk[e] = k[e] * kkw; ssq += kk[e] * kk[e]; kp[e] = k[e] * (1.0f + (a[e] - 1.0f) * kaw); }
    ssq = sum8(ssq);
    const float inv = 1.0f / fmaxf(sqrtf(ssq), 1e-12f);
#pragma unroll
    for (int e = 0; e < 8; ++e) { kk[e] *= inv; bb[e] = kk[e] * a[e]; }
    float* base = sm + tt * 64 + c8;
    *(f32x4*)(base + SC_W * 4096) = d0; *(f32x4*)(base + SC_W * 4096 + 4) = d1;
    *(f32x4*)(base + SC_B * 4096) = (f32x4){bb[0], bb[1], bb[2], bb[3]}; *(f32x4*)(base + SC_B * 4096 + 4) = (f32x4){bb[4], bb[5], bb[6], bb[7]};
    *(f32x4*)(base + SC_K * 4096) = (f32x4){kp[0], kp[1], kp[2], kp[3]}; *(f32x4*)(base + SC_K * 4096 + 4) = (f32x4){kp[4], kp[5], kp[6], kp[7]};
    *(f32x4*)(base + SC_KK * 4096) = (f32x4){kk[0], kk[1], kk[2], kk[3]}; *(f32x4*)(base + SC_KK * 4096 + 4) = (f32x4){kk[4], kk[5], kk[6], kk[7]};
    *(f32x4*)(base + SC_V * 4096) = (f32x4){v[0], v[1], v[2], v[3]}; *(f32x4*)(base + SC_V * 4096 + 4) = (f32x4){v[4], v[5], v[6], v[7]};
    if (P3) {
        *(f32x4*)(base + SC_R * 4096) = (f32x4){r[0], r[1], r[2], r[3]}; *(f32x4*)(base + SC_R * 4096 + 4) = (f32x4){r[4], r[5], r[6], r[7]};
        const f32x4 rk0 = *(const f32x4*)(r_k + hc), rk1 = *(const f32x4*)(r_k + hc + 4); float bc = 0.f;
#pragma unroll
        for (int e = 0; e < 8; ++e) bc += r[e] * kp[e] * ((e < 4) ? rk0[e] : rk1[e - 4]);
        bc = sum8(bc);
        if ((tid & 7) == 0) sm[SC_BC * 4096 + tt] = bc;
    }
}
#define LO2(v) __builtin_shufflevector(v, v, 0, 1)
#define HI2(v) __builtin_shufflevector(v, v, 2, 3)
template <int RPL, bool WITH_O, bool REAL> __device__ __forceinline__ void scan_run(const float* sm, f32x2 (&S)[RPL][2], int cs, int rowbase) {
    typedef float vrow_t __attribute__((ext_vector_type(RPL)));
    const float* st0 = sm + 4 * cs;
    f32x4 w4 = *(const f32x4*)(st0 + SC_W * 4096), b4 = *(const f32x4*)(st0 + SC_B * 4096), kk4 = *(const f32x4*)(st0 + SC_KK * 4096), k4 = w4, r4 = w4;
    if (REAL) k4 = *(const f32x4*)(st0 + SC_K * 4096);
    if (WITH_O) r4 = *(const f32x4*)(st0 + SC_R * 4096);
    vrow_t v4; if (REAL) v4 = *(const vrow_t*)(sm + SC_V * 4096 + rowbase);
#pragma unroll 2
    for (int t = 0; t < 64; ++t) {
        const int tn = (t + 1) & 63;
        const float* st = st0 + tn * 64;
        const f32x4 nw4 = *(const f32x4*)(st + SC_W * 4096), nb4 = *(const f32x4*)(st + SC_B * 4096), nkk4 = *(const f32x4*)(st + SC_KK * 4096);
        f32x4 nk4 = nw4, nr4 = nw4; vrow_t nv4;
        if (REAL) { nk4 = *(const f32x4*)(st + SC_K * 4096); nv4 = *(const vrow_t*)(sm + SC_V * 4096 + tn * 64 + rowbase); }
        if (WITH_O) nr4 = *(const f32x4*)(st + SC_R * 4096);
        const f32x2 w01 = LO2(w4), w23 = HI2(w4), b01 = LO2(b4), b23 = HI2(b4), kk01 = LO2(kk4), kk23 = HI2(kk4), k01 = LO2(k4), k23 = HI2(k4), r01 = LO2(r4), r23 = HI2(r4);
        float oo[RPL];
#pragma unroll
        for (int j = 0; j < RPL; ++j) {
            f32x2 pp = S[j][0] * kk01; pp = S[j][1] * kk23 + pp;
            const float nsa = -sum16(pp[0] + pp[1]);
            const f32x2 nsa2 = (f32x2){nsa, nsa};
            f32x2 t01 = nsa2 * b01, t23 = nsa2 * b23;
            if (REAL) { const f32x2 v2 = (f32x2){v4[j], v4[j]}; t01 = v2 * k01 + t01; t23 = v2 * k23 + t23; }
            S[j][0] = S[j][0] * w01 + t01; S[j][1] = S[j][1] * w23 + t23;
            if (WITH_O) { f32x2 qq = S[j][0] * r01; qq = S[j][1] * r23 + qq; oo[j] = sum16(qq[0] + qq[1]); }
        }
        if (WITH_O) { if (cs == 0) {
#pragma unroll
            for (int j = 0; j < RPL; ++j) ((float*)sm)[SC_O * 4096 + t * 64 + rowbase + j] = oo[j]; } }
        w4 = nw4; b4 = nb4; kk4 = nkk4; k4 = nk4; r4 = nr4; if (REAL) v4 = nv4;
    }
}
__device__ __forceinline__ void scan_pass1(const Params& p, float* sm, int wave, int lane) {
    float* PST = (float*)(p.ws + WS_PST); float* LST = (float*)(p.ws + WS_LST);
    const int cs = lane & 15, rg = lane >> 4; const bool real = wave < 4; const int rowbase = (wave & 3) * 16 + rg * 4;
    constexpr int NU = BATCH * (NCH - 1) * 8;
    for (int u = blockIdx.x; u < NU; u += gridDim.x) {
        const int h = u & 7, bc = u >> 3, c = bc % (NCH - 1), b = bc / (NCH - 1);
        f32x2 S[4][2];
#pragma unroll
        for (int j = 0; j < 4; ++j)
#pragma unroll
            for (int e = 0; e < 4; ++e) S[j][e >> 1][e & 1] = (!real && (rowbase + j == 4 * cs + e)) ? 1.0f : 0.0f;
        for (int sub = 0; sub < 2; ++sub) {
            __syncthreads();
            scan_load<false>(p, sm, b, h, c * CH + sub * 64, wave);
            __syncthreads();
            if (real) scan_run<4, false, true>(sm, S, cs, rowbase); else scan_run<4, false, false>(sm, S, cs, rowbase);
        }
        float* dst = (real ? LST : PST) + ((size_t)((b * NCH + c) * 8 + h)) * 4096 + rowbase * 64 + 4 * cs;
#pragma unroll
        for (int j = 0; j < 4; ++j) *(f32x4*)(dst + j * 64) = (f32x4){S[j][0][0], S[j][0][1], S[j][1][0], S[j][1][1]};
    }
}
__device__ __forceinline__ float rowsum4(float part) {
    const f32x4 z = (f32x4){0.f, 0.f, 0.f, 0.f};
    const f32x4 d = __builtin_amdgcn_mfma_f32_16x16x4f32(1.0f, part, z, 0, 0, 0);
    return d[0];
}
struct ScanRaw { v4u kc, kq, vc, vq, rc, rq, av, gv; f32x4 d0, d1; };
__device__ __forceinline__ void scanL_params(float* parl, int hc, int c8) {
    const float* mix = inp(8); const float* k_k = inp(14); const float* k_a = inp(15); const float* r_k = inp(16); const float* ln_w = inp(17); const float* ln_b = inp(18);
    float* d = parl + c8;
    *(f32x4*)(d) = *(const f32x4*)(mix + hc); *(f32x4*)(d + 4) = *(const f32x4*)(mix + hc + 4);
    *(f32x4*)(d + 64) = *(const f32x4*)(mix + 512 + hc); *(f32x4*)(d + 68) = *(const f32x4*)(mix + 512 + hc + 4);
    *(f32x4*)(d + 128) = *(const f32x4*)(mix + 1024 + hc); *(f32x4*)(d + 132) = *(const f32x4*)(mix + 1024 + hc + 4);
    *(f32x4*)(d + 192) = *(const f32x4*)(k_k + hc); *(f32x4*)(d + 196) = *(const f32x4*)(k_k + hc + 4);
    *(f32x4*)(d + 256) = *(const f32x4*)(k_a + hc); *(f32x4*)(d + 260) = *(const f32x4*)(k_a + hc + 4);
    *(f32x4*)(d + 320) = *(const f32x4*)(r_k + hc); *(f32x4*)(d + 324) = *(const f32x4*)(r_k + hc + 4);
    *(f32x4*)(d + 384) = *(const f32x4*)(ln_w + hc); *(f32x4*)(d + 388) = *(const f32x4*)(ln_w + hc + 4);
    *(f32x4*)(d + 448) = *(const f32x4*)(ln_b + hc); *(f32x4*)(d + 452) = *(const f32x4*)(ln_b + hc + 4);
}
template <bool P3> __device__ __forceinline__ void scanL_issue(const Params& p, ScanRaw& w, int b, int hc, int tok) {
    const bf16* P = (const bf16*)(p.ws + WS_BIG); const float* DEC = (const float*)(p.ws + WS_DEC); const bf16* AA = (const bf16*)(p.ws + WS_AA); const bf16* GG = (const bf16*)(p.ws + WS_GG);
    const int gr = b * SEQ + tok; const bool hp = tok > 0;
    const bf16* prow = P + (size_t)gr * NIN + hc; const v4u z = (v4u){0u, 0u, 0u, 0u};
    w.kc = *(const v4u*)(prow + 512); w.kq = hp ? *(const v4u*)(prow + 512 - NIN) : z;
    w.vc = *(const v4u*)(prow + 1024); w.vq = hp ? *(const v4u*)(prow + 1024 - NIN) : z;
    if (P3) { w.rc = *(const v4u*)(prow); w.rq = hp ? *(const v4u*)(prow - NIN) : z; w.gv = *(const v4u*)(GG + (size_t)gr * RW + hc); }
    w.d0 = *(const f32x4*)(DEC + (size_t)gr * RW + hc); w.d1 = *(const f32x4*)(DEC + (size_t)gr * RW + hc + 4);
    w.av = *(const v4u*)(AA + (size_t)gr * RW + hc);
}
__device__ __forceinline__ void shift8(float (&dst)[8], const v4u& c_, const v4u& q_, const f32x4& m0_, const f32x4& m1_) {
#pragma unroll
    for (int e = 0; e < 4; ++e) { const float c0 = bflo(c_[e]), c1 = bfhi(c_[e]), q0 = bflo(q_[e]), q1 = bfhi(q_[e]); const float ma = (e < 2) ? m0_[2 * e] : m1_[2 * e - 4], mb = (e < 2) ? m0_[2 * e + 1] : m1_[2 * e - 3];
        dst[2 * e] = c0 + (q0 - c0) * ma; dst[2 * e + 1] = c1 + (q1 - c1) * mb; }
}
template <bool P3, int TS> __device__ __forceinline__ void scanL_store(const ScanRaw& w, const float* parl, float* su, float* bcl, int tt, int c8, bool bcw) {
    float r[8], k[8], v[8]; const float* pq = parl + c8;
    shift8(k, w.kc, w.kq, *(const f32x4*)(pq + 64), *(const f32x4*)(pq + 68)); shift8(v, w.vc, w.vq, *(const f32x4*)(pq + 128), *(const f32x4*)(pq + 132));
    if (P3) shift8(r, w.rc, w.rq, *(const f32x4*)(pq), *(const f32x4*)(pq + 4));
    const f32x4 qkk0 = *(const f32x4*)(pq + 192), qkk1 = *(const f32x4*)(pq + 196), qka0 = *(const f32x4*)(pq + 256), qka1 = *(const f32x4*)(pq + 260);
    float a[8], kk[8], kp[8], bb[8]; float ssq = 0.f;
#pragma unroll
    for (int e = 0; e < 4; ++e) { a[2 * e] = bflo(w.av[e]); a[2 * e + 1] = bfhi(w.av[e]); }
#pragma unroll
    for (int e = 0; e < 8; ++e) { const float kkw = (e < 4) ? qkk0[e] : qkk1[e - 4], kaw = (e < 4) ? qka0[e] : qka1[e - 4];
        kk[e] = k[e] * kkw; ssq += kk[e] * kk[e]; kp[e] = k[e] * (1.0f + (a[e] - 1.0f) * kaw); }
    ssq = sum8(ssq);
    const float inv = 1.0f / fmaxf(sqrtf(ssq), 1e-12f);
#pragma unroll
    for (int e = 0; e < 8; ++e) { kk[e] *= inv; bb[e] = kk[e] * a[e]; }
    constexpr int AS = TS * 64;
    float* base = su + tt * 64 + c8;
    *(f32x4*)(base + SC_W * AS) = w.d0; *(f32x4*)(base + SC_W * AS + 4) = w.d1;
    *(f32x4*)(base + SC_B * AS) = (f32x4){bb[0], bb[1], bb[2], bb[3]}; *(f32x4*)(base + SC_B * AS + 4) = (f32x4){bb[4], bb[5], bb[6], bb[7]};
    *(f32x4*)(base + SC_K * AS) = (f32x4){kp[0], kp[1], kp[2], kp[3]}; *(f32x4*)(base + SC_K * AS + 4) = (f32x4){kp[4], kp[5], kp[6], kp[7]};
    *(f32x4*)(base + SC_KK * AS) = (f32x4){kk[0], kk[1], kk[2], kk[3]}; *(f32x4*)(base + SC_KK * AS + 4) = (f32x4){kk[4], kk[5], kk[6], kk[7]};
    *(f32x4*)(base + SC_V * AS) = (f32x4){v[0], v[1], v[2], v[3]}; *(f32x4*)(base + SC_V * AS + 4) = (f32x4){v[4], v[5], v[6], v[7]};
    if (P3) {
        *(f32x4*)(base + SC_R * AS) = (f32x4){r[0], r[1], r[2], r[3]}; *(f32x4*)(base + SC_R * AS + 4) = (f32x4){r[4], r[5], r[6], r[7]};
        const f32x4 qrk0 = *(const f32x4*)(pq + 320), qrk1 = *(const f32x4*)(pq + 324); float bc = 0.f;
#pragma unroll
        for (int e = 0; e < 8; ++e) bc += r[e] * kp[e] * ((e < 4) ? qrk0[e] : qrk1[e - 4]);
        bc = sum8(bc);
        if (bcw) bcl[tt] = bc;
    }
}
#define LD16(dst, ptr) do { const f32x4 x0_ = *(const f32x4*)(ptr), x1_ = *(const f32x4*)((ptr) + 4), x2_ = *(const f32x4*)((ptr) + 8), x3_ = *(const f32x4*)((ptr) + 12); \
        dst[0] = LO2(x0_); dst[1] = HI2(x0_); dst[2] = LO2(x1_); dst[3] = HI2(x1_); dst[4] = LO2(x2_); dst[5] = HI2(x2_); dst[6] = LO2(x3_); dst[7] = HI2(x3_); } while (0)
template <int RPL, bool WITH_O, bool REAL, int TS> __device__ __forceinline__ void scanL_run(float* su, f32x2 (&S)[RPL][8], int r, int g, int rowbase) {
    constexpr int AS = TS * 64;
#pragma unroll 1
    for (int t = 0; t < TS; ++t) {
        const float* st = su + t * 64 + 16 * g;
        f32x2 w2[8], b2[8], kk2[8], k2[8], r2[8];
        LD16(kk2, st + SC_KK * AS); LD16(w2, st + SC_W * AS); LD16(b2, st + SC_B * AS);
        if (REAL) LD16(k2, st + SC_K * AS);
        if (WITH_O) LD16(r2, st + SC_R * AS);
        float vv[RPL];
#pragma unroll
        for (int j = 0; j < RPL; ++j) vv[j] = REAL ? su[SC_V * AS + t * 64 + rowbase + 16 * j + r] : 0.f;
#pragma unroll
        for (int j = 0; j < RPL; ++j) {
            f32x2 p0 = S[j][0] * kk2[0], p1 = S[j][1] * kk2[1];
#pragma unroll
            for (int i = 2; i < 8; i += 2) { p0 = S[j][i] * kk2[i] + p0; p1 = S[j][i + 1] * kk2[i + 1] + p1; }
            p0 += p1;
            const float nsa = -rowsum4(p0[0] + p0[1]);
            const f32x2 nsa2 = (f32x2){nsa, nsa}, v2 = (f32x2){vv[j], vv[j]};
            f32x2 q0 = (f32x2){0.f, 0.f}, q1 = q0;
#pragma unroll
            for (int i = 0; i < 8; ++i) { f32x2 tt_ = nsa2 * b2[i]; if (REAL) tt_ = v2 * k2[i] + tt_; S[j][i] = S[j][i] * w2[i] + tt_;
                if (WITH_O) { if (i & 1) q1 = S[j][i] * r2[i] + q1; else q0 = S[j][i] * r2[i] + q0; } }
            if (WITH_O) { q0 += q1; const float o = rowsum4(q0[0] + q0[1]); if (g == 0) su[SC_O * AS + t * 64 + rowbase + 16 * j + r] = o; }
        }
    }
}
__device__ __forceinline__ void scanL_pass1(const Params& p, float* sm, int wave) {
    constexpr int TS = 32, SLOT = 5 * TS * 64, NPAIR = BATCH * (NCH - 1) * 8 / 2;
    float* PST = (float*)(p.ws + WS_PST); float* LST = (float*)(p.ws + WS_LST);
    const int lane = lane_id(), tid = (wave << 6) | lane, r = lane & 15, g = lane >> 4, u2 = wave >> 2, wq = wave & 3; const bool real = wq < 2; const int rowbase = (wq & 1) * 32;
    float* su = sm + u2 * SLOT;
    const int ltt = (tid >> 3) & 31, lc8 = (tid & 7) * 8;
    for (int up = blockIdx.x; up < NPAIR; up += gridDim.x) {
        const int u = 2 * up + u2, h = u & 7, bc = u >> 3, c = bc % (NCH - 1), b = bc / (NCH - 1);
        f32x2 S[2][8];
#pragma unroll
        for (int j = 0; j < 2; ++j)
#pragma unroll
            for (int i = 0; i < 8; ++i) { const int row = rowbase + 16 * j + r, col = 16 * g + 2 * i; S[j][i] = (f32x2){(!real && row == col) ? 1.f : 0.f, (!real && row == col + 1) ? 1.f : 0.f}; }
        float* parl = sm + 2 * SLOT + u2 * 512;
        __syncthreads();
        if (ltt == 0) scanL_params(parl, h * 64 + lc8, lc8);
        ScanRaw raw; scanL_issue<false>(p, raw, b, h * 64 + lc8, c * CH + ltt);
        for (int sub = 0; sub < CH / TS; ++sub) {
            __syncthreads();
            scanL_store<false, TS>(raw, parl, su, nullptr, ltt, lc8, false);
            if (sub + 1 < CH / TS) scanL_issue<false>(p, raw, b, h * 64 + lc8, c * CH + (sub + 1) * TS + ltt);
            __syncthreads();
            if (real) scanL_run<2, false, true, TS>(su, S, r, g, rowbase); else scanL_run<2, false, false, TS>(su, S, r, g, rowbase);
        }
        float* dst = (real ? LST : PST) + ((size_t)((b * NCH + c) * 8 + h)) * 4096 + 16 * g;
#pragma unroll
        for (int j = 0; j < 2; ++j) { float* d = dst + (rowbase + 16 * j + r) * 64;
#pragma unroll
            for (int i = 0; i < 4; ++i) *(f32x4*)(d + 4 * i) = (f32x4){S[j][2 * i][0], S[j][2 * i][1], S[j][2 * i + 1][0], S[j][2 * i + 1][1]}; }
    }
}
__device__ __forceinline__ void scanL_pass3(const Params& p, float* sm, int wave) {
    constexpr int TS = 16, AS = TS * 64, SLOT = 7 * AS, NQ = BATCH * NCH * 8 / 4;
    const float* LST = (const float*)(p.ws + WS_LST); const bf16* GG = (const bf16*)(p.ws + WS_GG); bf16* MIX = (bf16*)(p.ws + WS_MIX);
    const float* ln_w = inp(17); const float* ln_b = inp(18);
    const int lane = lane_id(), tid = (wave << 6) | lane, r = lane & 15, g = lane >> 4, u4 = wave >> 1, rowbase = (wave & 1) * 32;
    float* su = sm + u4 * SLOT; float* bcl = sm + 4 * SLOT + u4 * TS;
    const int tt = (tid >> 3) & 15, c8 = (tid & 7) * 8;
    for (int uq = blockIdx.x; uq < NQ; uq += gridDim.x) {
        const int u = 4 * uq + u4, h = u & 7, bc = u >> 3, c = bc % NCH, b = bc / NCH, hc = h * 64 + c8;
        f32x2 S[2][8];
#pragma unroll
        for (int j = 0; j < 2; ++j) {
            if (c > 0) { const float* src = LST + ((size_t)((b * NCH + c - 1) * 8 + h)) * 4096 + (rowbase + 16 * j + r) * 64 + 16 * g;
#pragma unroll
                for (int i = 0; i < 4; ++i) { const f32x4 s4 = *(const f32x4*)(src + 4 * i); S[j][2 * i] = LO2(s4); S[j][2 * i + 1] = HI2(s4); } }
            else {
#pragma unroll
                for (int i = 0; i < 8; ++i) S[j][i] = (f32x2){0.f, 0.f}; } }
        float* parl = sm + 4 * SLOT + 64 + u4 * 512;
        __syncthreads();
        if (tt == 0) scanL_params(parl, hc, c8);
        ScanRaw raw; scanL_issue<true>(p, raw, b, hc, c * CH + tt);
        for (int sub = 0; sub < CH / TS; ++sub) {
            __syncthreads();
            scanL_store<true, TS>(raw, parl, su, bcl, tt, c8, (tid & 7) == 0);
            const v4u gv = raw.gv;
            if (sub + 1 < CH / TS) scanL_issue<true>(p, raw, b, hc, c * CH + (sub + 1) * TS + tt);
            __syncthreads();
            scanL_run<2, true, true, TS>(su, S, r, g, rowbase);
            __syncthreads();
            const int gr = b * SEQ + c * CH + sub * TS + tt;
            const f32x4 o0 = *(const f32x4*)(su + SC_O * AS + tt * 64 + c8), o1 = *(const f32x4*)(su + SC_O * AS + tt * 64 + c8 + 4);
            const f32x4 v0 = *(const f32x4*)(su + SC_V * AS + tt * 64 + c8), v1 = *(const f32x4*)(su + SC_V * AS + tt * 64 + c8 + 4);
            const float bcv = bcl[tt];
            float mu = ((o0[0] + o0[1]) + (o0[2] + o0[3])) + ((o1[0] + o1[1]) + (o1[2] + o1[3])); mu = sum8(mu) * (1.0f / 64.0f);
            const f32x4 e0 = o0 - mu, e1 = o1 - mu;
            float var = ((e0[0] * e0[0] + e0[1] * e0[1]) + (e0[2] * e0[2] + e0[3] * e0[3])) + ((e1[0] * e1[0] + e1[1] * e1[1]) + (e1[2] * e1[2] + e1[3] * e1[3])); var = sum8(var) * (1.0f / 64.0f);
            const float rs = 1.0f / sqrtf(var + 64e-5f);
            const f32x4 lw0 = *(const f32x4*)(parl + 384 + c8), lw1 = *(const f32x4*)(parl + 388 + c8), lb0 = *(const f32x4*)(parl + 448 + c8), lb1 = *(const f32x4*)(parl + 452 + c8);
            f32x4 y0 = (e0 * rs) * lw0 + lb0 + v0 * bcv, y1 = (e1 * rs) * lw1 + lb1 + v1 * bcv;
            y0[0] *= bflo(gv[0]); y0[1] *= bfhi(gv[0]); y0[2] *= bflo(gv[1]); y0[3] *= bfhi(gv[1]); y1[0] *= bflo(gv[2]); y1[1] *= bfhi(gv[2]); y1[2] *= bflo(gv[3]); y1[3] *= bfhi(gv[3]);
            v4u w; w.x = cvt_pk_bf16(y0[0], y0[1]); w.y = cvt_pk_bf16(y0[2], y0[3]); w.z = cvt_pk_bf16(y1[0], y1[1]); w.w = cvt_pk_bf16(y1[2], y1[3]);
            *(v4u*)(MIX + (size_t)gr * DM + hc) = w;
        }
    }
}

__device__ __forceinline__ void scan_pass2(const Params& p, float* sm, int wave) {
    const float* PST = (const float*)(p.ws + WS_PST); float* LST = (float*)(p.ws + WS_LST);
    const int lane = lane_id(), tid = (wave << 6) | lane, vb = (blockIdx.x & 7) * (gridDim.x >> 3) + (blockIdx.x >> 3);
    if (vb >= 128) return;
    const int chain = vb >> 3, row = (vb & 7) * 8 + wave, b = chain >> 3, h = chain & 7;
    float* Pb = sm; float* Sw = sm + 8192 + wave * 64;
    constexpr int NS = NCH - 1;
#define UOFF(c) ((size_t)((b * NCH + (c)) * 8 + h) * 4096)
#define LDP(X0, X1, LX, c) do { X0 = *(const f32x4*)(PST + UOFF(c) + tid * 8); X1 = *(const f32x4*)(PST + UOFF(c) + tid * 8 + 4); LX = LST[UOFF(c) + row * 64 + lane]; } while (0)
    f32x4 A0, A1, B0, B1, C0, C1; float LA = 0.f, LB = 0.f, LC = 0.f, Lcur;
    __syncthreads();
    LDP(A0, A1, LA, 0);
    *(f32x4*)(Pb + tid * 8) = A0; *(f32x4*)(Pb + tid * 8 + 4) = A1; Lcur = LA;
    Sw[lane] = 0.f;
    LDP(B0, B1, LB, 1); LDP(C0, C1, LC, 2); LDP(A0, A1, LA, 3);
    __syncthreads();
#define P2STEP(c, X0, X1, LX) do { float Lnx = 0.f; \
        if ((c) + 1 < NS) { float* Pn = Pb + (((c) + 1) & 1) * 4096; *(f32x4*)(Pn + tid * 8) = X0; *(f32x4*)(Pn + tid * 8 + 4) = X1; Lnx = LX; } \
        if ((c) + 4 < NS) LDP(X0, X1, LX, (c) + 4); \
        const float* Pc = Pb + ((c) & 1) * 4096 + lane; float a0 = 0.f, a1 = 0.f, a2 = 0.f, a3 = 0.f; \
        _Pragma("unroll") for (int i = 0; i < 64; i += 4) { const f32x4 s4 = *(const f32x4*)(Sw + i); \
            a0 += s4[0] * Pc[(i + 0) * 64]; a1 += s4[1] * Pc[(i + 1) * 64]; a2 += s4[2] * Pc[(i + 2) * 64]; a3 += s4[3] * Pc[(i + 3) * 64]; } \
        const float sn = ((a0 + a1) + (a2 + a3)) + Lcur; LST[UOFF(c) + row * 64 + lane] = sn; Sw[lane] = sn; Lcur = Lnx; \
        __syncthreads(); } while (0)
    for (int c = 0; c < NS; c += 3) { P2STEP(c, B0, B1, LB); P2STEP(c + 1, C0, C1, LC); P2STEP(c + 2, A0, A1, LA); }
    static_assert(NS % 3 == 0, "pass 2 is unrolled by 3");
#undef P2STEP
#undef LDP
#undef UOFF
}
__device__ __forceinline__ void scan_pass3(const Params& p, float* sm, int wave, int lane) {
    const float* LST = (const float*)(p.ws + WS_LST); const bf16* GG = (const bf16*)(p.ws + WS_GG); bf16* MIX = (bf16*)(p.ws + WS_MIX);
    const float* ln_w = inp(17); const float* ln_b = inp(18);
    const int tid = TIDX, cs = lane & 15, rg = lane >> 4, rowbase = wave * 8 + rg * 2;
    constexpr int NU = BATCH * NCH * 8;
    for (int u = blockIdx.x; u < NU; u += gridDim.x) {
        const int h = u & 7, bc = u >> 3, c = bc % NCH, b = bc / NCH;
        f32x2 S[2][2];
        if (c > 0) { const float* src = LST + ((size_t)((b * NCH + c - 1) * 8 + h)) * 4096 + rowbase * 64 + 4 * cs;
#pragma unroll
            for (int j = 0; j < 2; ++j) { const f32x4 s4 = *(const f32x4*)(src + j * 64); S[j][0] = LO2(s4); S[j][1] = HI2(s4); } }
        else {
#pragma unroll
            for (int j = 0; j < 2; ++j) { S[j][0] = (f32x2){0.f, 0.f}; S[j][1] = (f32x2){0.f, 0.f}; } }
        for (int sub = 0; sub < 2; ++sub) {
            __syncthreads();
            scan_load<true>(p, sm, b, h, c * CH + sub * 64, wave);
            __syncthreads();
            scan_run<2, true, true>(sm, S, cs, rowbase);
            __syncthreads();
            const int tt = tid >> 3, c8 = (tid & 7) * 8, hc = h * 64 + c8; const int gr = b * SEQ + c * CH + sub * 64 + tt;
            const f32x4 o0 = *(const f32x4*)(sm + SC_O * 4096 + tt * 64 + c8), o1 = *(const f32x4*)(sm + SC_O * 4096 + tt * 64 + c8 + 4);
            const f32x4 v0 = *(const f32x4*)(sm + SC_V * 4096 + tt * 64 + c8), v1 = *(const f32x4*)(sm + SC_V * 4096 + tt * 64 + c8 + 4);
            const float bcv = sm[SC_BC * 4096 + tt];
            float mu = ((o0[0] + o0[1]) + (o0[2] + o0[3])) + ((o1[0] + o1[1]) + (o1[2] + o1[3])); mu = sum8(mu) * (1.0f / 64.0f);
            const f32x4 e0 = o0 - mu, e1 = o1 - mu;
            float var = ((e0[0] * e0[0] + e0[1] * e0[1]) + (e0[2] * e0[2] + e0[3] * e0[3])) + ((e1[0] * e1[0] + e1[1] * e1[1]) + (e1[2] * e1[2] + e1[3] * e1[3])); var = sum8(var) * (1.0f / 64.0f);
            const float rs = 1.0f / sqrtf(var + 64e-5f);
            const f32x4 lw0 = *(const f32x4*)(ln_w + hc), lw1 = *(const f32x4*)(ln_w + hc + 4), lb0 = *(const f32x4*)(ln_b + hc), lb1 = *(const f32x4*)(ln_b + hc + 4);
            const v4u gv = *(const v4u*)(GG + (size_t)gr * RW + hc);
            f32x4 y0 = (e0 * rs) * lw0 + lb0 + v0 * bcv, y1 = (e1 * rs) * lw1 + lb1 + v1 * bcv;
            y0[0] *= bflo(gv[0]); y0[1] *= bfhi(gv[0]); y0[2] *= bflo(gv[1]); y0[3] *= bfhi(gv[1]); y1[0] *= bflo(gv[2]); y1[1] *= bfhi(gv[2]); y1[2] *= bflo(gv[3]); y1[3] *= bfhi(gv[3]);
            v4u w; w.x = cvt_pk_bf16(y0[0], y0[1]); w.y = cvt_pk_bf16(y0[2], y0[3]); w.z = cvt_pk_bf16(y1[0], y1[1]); w.w = cvt_pk_bf16(y1[2], y1[3]);
            *(v4u*)(MIX + (size_t)gr * DM + hc) = w;
        }
    }
}

constexpr int AT_KS = 0, AT_VT = 256 * 72 * 2, AT_PS = AT_VT + 64 * 280 * 2, AT_PSW = 16 * 168 * 2;
__device__ __forceinline__ void attn_phase(const Params& p, unsigned char* lds, int wave, int lane) {
    const bf16* P = (const bf16*)(p.ws + WS_BIG); bf16* MIX = (bf16*)(p.ws + WS_MIX); const float* sinks = inp(19);
    const int tid = TIDX; bf16* Ks = (bf16*)(lds + AT_KS); bf16* Vt = (bf16*)(lds + AT_VT); bf16* Ps = (bf16*)(lds + AT_PS + wave * AT_PSW);
    const int fr = lane & 15, fq = lane >> 4;
    for (int u = blockIdx.x; u < BATCH * 64 * 2; u += gridDim.x) {
        const int g = u & 1, qb = (u >> 1) & 63, b = u >> 7, q0 = qb * 128;
        __syncthreads();
        { const int key = tid >> 1, half = tid & 1; const bool valid = (qb > 0) || (key >= 128);
          const bf16* src = P + (size_t)(b * SEQ + q0 - 128 + key) * NIN + 1792 + 512 + g * 64 + half * 32;
#pragma unroll
          for (int i = 0; i < 4; ++i) { v4u kx = (v4u){0u, 0u, 0u, 0u}, vx = kx; if (valid) { kx = *(const v4u*)(src + 8 * i); vx = *(const v4u*)(src + 128 + 8 * i); }
              *(v4u*)(Ks + key * 72 + half * 32 + 8 * i) = kx;
#pragma unroll
              for (int e = 0; e < 4; ++e) { const int d = half * 32 + 8 * i + 2 * e; Vt[d * 280 + key] = (bf16)(vx[e] & 0xffffu); Vt[(d + 1) * 280 + key] = (bf16)(vx[e] >> 16); } }
          if (tid < 64 * 3) { const int d = tid / 3, part = tid % 3; *(v4u*)(Vt + d * 280 + 256 + 8 * part) = (v4u){0u, 0u, 0u, 0u}; } }
        __syncthreads();
        for (int hq4 = 0; hq4 < 4; ++hq4) {
            const int hq = g * 4 + hq4; const float sink = sinks[hq];
            const bf16* qp = P + (size_t)(b * SEQ + q0 + 16 * wave + fr) * NIN + 1792 + hq * 64 + 8 * fq;
            const bf16x8 qa0 = *(const bf16x8*)qp, qa1 = *(const bf16x8*)(qp + 32);
            f32x4 sc[9]; float mx[4] = {-1e30f, -1e30f, -1e30f, -1e30f};
#pragma unroll
            for (int nt = 0; nt < 9; ++nt) { const int jt = 16 * (wave + nt); const bf16* kp = Ks + (jt + fr) * 72 + 8 * fq;
                const bf16x8 kb0 = *(const bf16x8*)kp, kb1 = *(const bf16x8*)(kp + 32);
                f32x4 a = (f32x4){0.f, 0.f, 0.f, 0.f}; a = __builtin_amdgcn_mfma_f32_16x16x32_bf16(qa0, kb0, a, 0, 0, 0); a = __builtin_amdgcn_mfma_f32_16x16x32_bf16(qa1, kb1, a, 0, 0, 0);
                const int j = jt + fr;
#pragma unroll
                for (int r = 0; r < 4; ++r) { const int i = 16 * wave + 4 * fq + r, dist = i + 128 - j; const bool ok = (dist >= 0) && (dist < 128) && ((qb > 0) || (j >= 128));
                    a[r] = ok ? a[r] * 0.125f : -1e30f; mx[r] = fmaxf(mx[r], a[r]); }
                sc[nt] = a; }
            float sm_[4];
#pragma unroll
            for (int r = 0; r < 4; ++r) { mx[r] = fmaxf(max16(mx[r]), sink); sm_[r] = 0.f; }
#pragma unroll
            for (int nt = 0; nt < 9; ++nt) {
#pragma unroll
                for (int r = 0; r < 4; ++r) { const float e = __expf(sc[nt][r] - mx[r]); sm_[r] += e; Ps[(4 * fq + r) * 168 + nt * 16 + fr] = (bf16)(cvt_pk_bf16(e, 0.f) & 0xffffu); } }
#pragma unroll
            for (int r = 0; r < 4; ++r) { Ps[(4 * fq + r) * 168 + 144 + fr] = 0; sm_[r] = 1.0f / (sum16(sm_[r]) + __expf(sink - mx[r])); }
            __builtin_amdgcn_fence(__ATOMIC_RELEASE, "wavefront"); asm volatile("s_waitcnt lgkmcnt(0)" ::: "memory");
            f32x4 o[4];
#pragma unroll
            for (int dt = 0; dt < 4; ++dt) o[dt] = (f32x4){0.f, 0.f, 0.f, 0.f};
#pragma unroll
            for (int ks = 0; ks < 5; ++ks) { const bf16x8 pa = *(const bf16x8*)(Ps + fr * 168 + ks * 32 + 8 * fq);
#pragma unroll
                for (int dt = 0; dt < 4; ++dt) { const bf16x8 vb = *(const bf16x8*)(Vt + (dt * 16 + fr) * 280 + 16 * wave + ks * 32 + 8 * fq);
                    o[dt] = __builtin_amdgcn_mfma_f32_16x16x32_bf16(pa, vb, o[dt], 0, 0, 0); } }
            bf16* op = MIX + (size_t)(b * SEQ + q0 + 16 * wave + 4 * fq) * DM + 512 + hq * 64 + fr;
#pragma unroll
            for (int r = 0; r < 4; ++r)
#pragma unroll
                for (int dt = 0; dt < 4; ++dt) op[(size_t)r * DM + dt * 16] = (bf16)(cvt_pk_bf16(o[dt][r] * sm_[r], 0.f) & 0xffffu);
            asm volatile("s_waitcnt lgkmcnt(0)" ::: "memory");
        }
    }
}

__device__ __forceinline__ void final_norm(const Params& p, int wave, int lane) {
    const float* ss3 = (const float*)(p.ws + WS_SS) + (size_t)3 * M * 16; const float* gf = inp(25);
    const int gw = blockIdx.x * NWAVES + wave, NGW = gridDim.x * NWAVES;
    f32x4 gfv[4];
#pragma unroll
    for (int j = 0; j < 4; ++j) gfv[j] = ((const f32x4*)gf)[lane + 64 * j];
    for (int m = gw; m < M; m += NGW) { const float rs = pg8::row_rstd(ss3, m); f32x4* xr = (f32x4*)(p.out + (size_t)m * DM) + lane;
#pragma unroll
        for (int j = 0; j < 4; ++j) { const f32x4 v = xr[64 * j]; xr[64 * j] = v * rs * gfv[j]; } }
}


#define XB_TMO      128
#define XB_XCNT(j)  (256  + 64 * (j))
#define XB_XSUB(j)  (1280 + 64 * (j))
#define XB_XGEN(j)  (2304 + 64 * (j))
#define XB_TOP      3328
#define XB_TOPGEN   3392
#define XCD_BAR_WORDS 3456
#define XB_SPIN_CAP (1u << 18)

__device__ __forceinline__ unsigned xb_ld(unsigned* p)              { return __hip_atomic_load(p, __ATOMIC_RELAXED, __HIP_MEMORY_SCOPE_AGENT); }
__device__ __forceinline__ unsigned xb_add(unsigned* p, unsigned v) { return __hip_atomic_fetch_add(p, v, __ATOMIC_RELAXED, __HIP_MEMORY_SCOPE_AGENT); }
__device__ __forceinline__ unsigned xb_xcc_id() { return (unsigned)__builtin_amdgcn_s_getreg((3 << 11) | 20) & 0xFu; }
#define XB_SPIN(cond, bar) do { unsigned _sp = 0; while (cond) { __builtin_amdgcn_s_sleep(1); \
    if ((++_sp & 255u) == 0u) { if (xb_ld(&(bar)[XB_TMO])) break; if (_sp > XB_SPIN_CAP) { atomicAdd(&(bar)[XB_TMO], 1u); break; } } } } while (0)

struct XcdBarrier {
    unsigned* bar; unsigned x;
    volatile LAS unsigned* st; int wave;
};

__device__ __forceinline__ XcdBarrier xcd_barrier_post(unsigned* bar, volatile LAS unsigned* st, int wave) {
    XcdBarrier b; b.bar = bar; b.x = xb_xcc_id(); b.st = st; b.wave = wave;
    if (wave == 0 && lane_id() == 0) (void)xb_add(&bar[XB_XCNT(b.x)], 1u);
    return b;
}
__device__ __forceinline__ void xcd_barrier_complete(unsigned* bar, unsigned x, unsigned& nloc, unsigned& nx) {
    const unsigned G = gridDim.x * gridDim.y * gridDim.z;
    unsigned sum, cnt, mine, sp = 0u;
    for (;;) {
        sum = 0u; cnt = 0u; mine = 0u;
#pragma unroll
        for (unsigned j = 0; j < 16; ++j) { const unsigned c = xb_ld(&bar[XB_XCNT(j)]); sum += c; cnt += (c > 0u) ? 1u : 0u; mine = (j == x) ? c : mine; }
        if (sum == G) break;
        __builtin_amdgcn_s_sleep(1);
        if ((++sp & 255u) == 0u) { if (xb_ld(&bar[XB_TMO])) break; if (sp > XB_SPIN_CAP) { atomicAdd(&bar[XB_TMO], 1u); break; } }
    }
    nloc = mine > 0u ? mine : 1u; nx = cnt > 0u ? cnt : 1u;
}

__device__ __forceinline__ void xcd_barrier(const XcdBarrier& b) {
    asm volatile("s_waitcnt vmcnt(0)" ::: "memory");
    __syncthreads();
    if (b.wave == 0 && lane_id() == 0) {
        unsigned* bar = b.bar;
        __builtin_amdgcn_s_waitcnt(0);
        unsigned nloc = b.st[0], nx = b.st[1];
        if (nloc == 0u) { xcd_barrier_complete(bar, b.x, nloc, nx); b.st[0] = nloc; b.st[1] = nx; }
        const unsigned old = xb_add(&bar[XB_XSUB(b.x)], 1u);
        const unsigned gen = old / nloc;
        if (old + 1u == (gen + 1u) * nloc) {
            __builtin_amdgcn_fence(__ATOMIC_RELEASE, "agent");
            asm volatile("s_waitcnt vmcnt(0)" ::: "memory");
            const unsigned og = xb_add(&bar[XB_TOP], 1u);
            const unsigned tg = og / nx;
            if (og + 1u == (tg + 1u) * nx) xb_add(&bar[XB_TOPGEN], 1u);
            else XB_SPIN(xb_ld(&bar[XB_TOPGEN]) == tg, bar);
            __builtin_amdgcn_fence(__ATOMIC_ACQUIRE, "agent");
            xb_add(&bar[XB_XGEN(b.x)], 1u);
            asm volatile("s_waitcnt vmcnt(0)" ::: "memory");
        } else {
            XB_SPIN(xb_ld(&bar[XB_XGEN(b.x)]) == gen, bar);
            __builtin_amdgcn_fence(__ATOMIC_ACQUIRE, "agent");
            asm volatile("s_waitcnt vmcnt(0)" ::: "memory");
        }
    }
    __syncthreads();
}

constexpr int LDS_BYTES = 147456;
constexpr int NPHASE = 12;
#ifndef DUPMASK
#define DUPMASK 0
#endif
__global__ void __launch_bounds__(NTHR, 2) hymba_fwd(Params p) {
    extern __shared__ __attribute__((aligned(16))) unsigned char lds[];
    cg::grid_group grid = cg::this_grid();
    const int wave = __builtin_amdgcn_readfirstlane((int)threadIdx.x >> 6); const int lane = lane_id(); const int tid = (wave << 6) | lane;
    unsigned char* ws = p.ws;
    PG8_LAS unsigned char* lds3 = (PG8_LAS unsigned char*)lds;
    float* ss = (float*)(ws + WS_SS);
    bf16* XB = (bf16*)(ws + WS_XB); bf16* ACT = (bf16*)(ws + WS_BIG); bf16* PB = (bf16*)(ws + WS_BIG);
    const int lo = p.ph_lo, hi = p.ph_hi;
#define IN(k) (lo <= (k) && (k) < hi)
#define REP(k) for (int rep_ = 0; rep_ < 1 + ((DUPMASK >> (k)) & 1); ++rep_)
#ifndef DUPBAR
#define DUPBAR 0
#endif
#define SEAM(k) do { if (IN(k) && IN((k) + 1)) { for (int rb_ = 0; rb_ <= DUPBAR; ++rb_) xcd_barrier(xbar); } } while (0)
    unsigned* bctr = (unsigned*)(ws + WS_CTL);
    volatile LAS unsigned* misc = (volatile LAS unsigned*)(lds3 + 131072 + 1024);
    if (wave == 0 && lane < 2) misc[lane] = 0u;
    if (blockIdx.x == 0) for (int i = tid; i < XCD_BAR_WORDS; i += NTHR) __hip_atomic_store(bctr + i, 0u, __ATOMIC_RELAXED, __HIP_MEMORY_SCOPE_AGENT);
    if (IN(0)) REP(0) { p0_prologue(p, lds, wave, lane_id()); }
    grid.sync();
    XcdBarrier xbar = xcd_barrier_post(bctr, misc, wave);
    if (IN(1)) REP(1) { pg8::Gemm g{XB, (const bf16*)(ws + WS_WGU1), M, 2 * FF, DM}; pg8::StaticOrder S; S.init(M, 2 * FF, gridDim.x, blockIdx.x);
        pg8::EpiSwiGLU E{ACT, ss, FF}; pg8::gemm_phase<pg8::EpiSwiGLU, pg8::StaticOrder, true, true>(lds3, g, S, E, wave); } SEAM(1);
    if (IN(2)) REP(2) { pg8::Gemm g{ACT, (const bf16*)(ws + WS_WD1), M, DM, FF}; pg8::StaticOrder S; S.init(M, DM, gridDim.x, blockIdx.x);
        pg8::EpiRes E{inp(0), p.out, XB, ss + (size_t)M * 16, 0.5f}; pg8::gemm_phase<pg8::EpiRes, pg8::StaticOrder, true, true>(lds3, g, S, E, wave); } SEAM(2);
    if (IN(3)) REP(3) { pg8::Gemm g{XB, (const bf16*)(ws + WS_WIN), M, NIN, DM}; pg8::StaticOrder S; S.init(M, NIN, gridDim.x, blockIdx.x);
        pg8::EpiWin E{PB, ss + (size_t)M * 16, inp(7), 1792, NIN}; pg8::gemm_phase<pg8::EpiWin, pg8::StaticOrder, true, true>(lds3, g, S, E, wave); } SEAM(3);
    if (IN(4)) REP(4) { r1_phase(p, wave); } SEAM(4);
    if (IN(5)) REP(5) { pg8::Gemm g{(const bf16*)(ws + WS_LIN), (const bf16*)(ws + WS_WL), M, 1536, 256}; pg8::StaticOrder S; S.init(M, 1536, gridDim.x, blockIdx.x);
        pg8::EpiLora E{(float*)(ws + WS_DEC), (bf16*)(ws + WS_AA), (bf16*)(ws + WS_GG), inp(9), inp(11)}; pg8::gemm_phase<pg8::EpiLora, pg8::StaticOrder, true, true>(lds3, g, S, E, wave); } SEAM(5);
    if (IN(6)) REP(6) { scanL_pass1(p, (float*)lds, wave); attn_phase(p, lds, wave, lane_id()); } SEAM(6);
    if (IN(7)) REP(7) { scan_pass2(p, (float*)lds, wave); } SEAM(7);
    if (IN(8)) REP(8) { scanL_pass3(p, (float*)lds, wave); __syncthreads(); } SEAM(8);
    if (IN(9)) REP(9) { pg8::Gemm g{(const bf16*)(ws + WS_MIX), (const bf16*)(ws + WS_WOUT), M, DM, DM}; pg8::StaticOrder S; S.init(M, DM, gridDim.x, blockIdx.x);
        pg8::EpiRes E{p.out, p.out, XB, ss + (size_t)2 * M * 16, 1.0f}; pg8::gemm_phase<pg8::EpiRes, pg8::StaticOrder, true, true>(lds3, g, S, E, wave); } SEAM(9);
    if (IN(10)) REP(10) { pg8::Gemm g{XB, (const bf16*)(ws + WS_WGU2), M, 2 * FF, DM}; pg8::StaticOrder S; S.init(M, 2 * FF, gridDim.x, blockIdx.x);
        pg8::EpiSwiGLU E{ACT, ss + (size_t)2 * M * 16, FF}; pg8::gemm_phase<pg8::EpiSwiGLU, pg8::StaticOrder, true, true>(lds3, g, S, E, wave); } SEAM(10);
    if (IN(11)) REP(11) { pg8::Gemm g{ACT, (const bf16*)(ws + WS_WD2), M, DM, FF}; pg8::StaticOrder S; S.init(M, DM, gridDim.x, blockIdx.x);
        pg8::EpiRes E{p.out, p.out, nullptr, ss + (size_t)3 * M * 16, 0.5f}; pg8::gemm_phase<pg8::EpiRes, pg8::StaticOrder, true, true>(lds3, g, S, E, wave); } SEAM(11);
    if (IN(12)) REP(12) { final_norm(p, wave, lane_id()); }
#undef IN
#undef SEAM
}

extern "C" void kernel_launch(void* const* d_in, const int* in_sizes, int n_in, void* d_out, int out_size, void* d_ws, size_t ws_size, hipStream_t stream) {
    static int grid = 0;
    if (grid == 0) {
        if (n_in != 26 || out_size != M * DM || ws_size < WS_END) { fprintf(stderr, "kernel_launch: unexpected sizes n_in %d out %d ws %zu\n", n_in, out_size, ws_size); grid = -1; return; }
        int dev = 0, cus = 0, per_cu = 0;
        hipGetDevice(&dev); hipDeviceGetAttribute(&cus, hipDeviceAttributeMultiprocessorCount, dev);
        hipFuncSetAttribute((const void*)hymba_fwd, hipFuncAttributeMaxDynamicSharedMemorySize, LDS_BYTES);
        hipOccupancyMaxActiveBlocksPerMultiprocessor(&per_cu, (const void*)hymba_fwd, NTHR, LDS_BYTES);
        (void)hipGetLastError();
        if (per_cu < 1) per_cu = 1;
        grid = cus * per_cu; if (grid > 256) grid = 256;
        if (grid != 256) fprintf(stderr, "kernel_launch: grid %d (cus %d per_cu %d), kernel assumes 256\n", grid, cus, per_cu);
    }
    if (grid < 0) return;
    Params p{};
    for (int i = 0; i < 26; ++i) p.in[i] = (const float*)d_in[i];
    p.out = (float*)d_out; p.ws = (unsigned char*)d_ws; p.ph_lo = 0; p.ph_hi = NPHASE + 1;
    void* args[] = {&p};
    hipError_t e = hipLaunchCooperativeKernel((const void*)hymba_fwd, dim3(grid), dim3(NTHR), args, LDS_BYTES, stream);
    if (e != hipSuccess) fprintf(stderr, "cooperative launch failed: %s (grid %d)\n", hipGetErrorString(e), grid);
}
```

```cpp
#include <hip/hip_runtime.h>
#include <hip/hip_cooperative_groups.h>
#include <cstdio>
#include <cstdint>
namespace cg = cooperative_groups;
namespace pg8 {
#define PG8_LAS __attribute__((address_space(3)))
typedef unsigned short bf16_t;
typedef short bf16x8 __attribute__((ext_vector_type(8)));
typedef float f32x4 __attribute__((ext_vector_type(4)));
typedef unsigned u32x4 __attribute__((ext_vector_type(4)));
constexpr int BM = 256, BK = 64, HALF = 128, HTB = HALF * BK * 2  , STAGE_BYTES = 8 * HTB, NXCD = 8, WGM = 8;

__host__ __device__ __forceinline__ int lds_byte(int r, int c) { const int st = (r >> 4) * 2 + (c >> 5), rr = r & 15, cc = c & 31, ob = rr * 64 + cc * 2; return st * 1024 + (ob ^ (((ob >> 9) & 1) << 5)); }
__host__ __device__ __forceinline__ void stage_rc(int b, int& R, int& C) { const int st = b / 1024, sb = b % 1024, swz = sb ^ (((sb >> 9) & 1) << 5); R = (st >> 1) * 16 + swz / 64; C = (st & 1) * 32 + (swz % 64) / 2; }
__host__ __device__ __forceinline__ int perm32(int rho) { const int n = rho >> 4, i = rho & 15; return 8 * (i >> 2) + 4 * n + (i & 3); }

struct Unit { int pm, pn; };
struct Gemm { const bf16_t* A; const bf16_t* Bt; int M, N, K; };

struct StaticOrder {
    int nM, nN, nwg, G, c;
    __host__ __device__ void init(int M, int N, int G_, int c_) { nM = M / BM; nN = N / BM; nwg = nM * nN; G = G_; c = c_; }
    __host__ __device__ bool next(int i, Unit& u) const {
        const long L = (long)i * G + c; if (L >= nwg) return false;
        int wgid = (int)L; { const int q = nwg / NXCD, r = nwg % NXCD, xcd = wgid % NXCD, off = wgid / NXCD; wgid = (xcd < r ? xcd * (q + 1) : r * (q + 1) + (xcd - r) * q) + off; }
        const int nig = WGM * nN, gid = wgid / nig, fm = gid * WGM, gsz = (nM - fm) < WGM ? (nM - fm) : WGM;
        u.pm = fm + ((wgid % nig) % gsz); u.pn = (wgid % nig) / gsz; return true;
    }
    __device__ __forceinline__ void a_ready(const Unit&) const {}
    __device__ __forceinline__ void done(const Unit&) const {}
};

typedef float f32x2 __attribute__((ext_vector_type(2)));
typedef __bf16 bf16x2_t __attribute__((ext_vector_type(2)));
typedef unsigned u32x2 __attribute__((ext_vector_type(2)));
__device__ __forceinline__ unsigned cvt_pk_bf16(float lo, float hi) { f32x2 v = {lo, hi}; bf16x2_t b = __builtin_convertvector(v, bf16x2_t); return __builtin_bit_cast(unsigned, b); }
__device__ __forceinline__ float row_rstd(const float* ss, int row) {
    const f32x4* p = (const f32x4*)(ss + (size_t)row * 16); const f32x4 a = p[0], b = p[1], c = p[2], d = p[3];
    const float s = (((a[0] + a[1]) + (a[2] + a[3])) + ((b[0] + b[1]) + (b[2] + b[3]))) + (((c[0] + c[1]) + (c[2] + c[3])) + ((d[0] + d[1]) + (d[2] + d[3])));
    return 1.0f / sqrtf(s * (1.0f / 1024.0f) + 1e-5f);
}
__device__ __forceinline__ float silu_mul(float g, float u) { return g * __builtin_amdgcn_rcpf(1.0f + __expf(-g)) * u; }

struct EpiSwiGLU {
    static constexpr bool PERM = true, AFTER_DRAIN = false;
    bf16_t* O; const float* ss; int ldo;
    __device__ __forceinline__ void operator()(const f32x4 (&acc)[2][2][4][2], const Unit& u, int wr, int wc, int fr, int fq) const {
        const int row0 = u.pm * BM + wr * 64 + fr; const int col0 = u.pn * HALF + wc * 32 + 8 * fq;
#pragma unroll
        for (int ai = 0; ai < 2; ++ai)
#pragma unroll
            for (int m = 0; m < 4; ++m) { const int row = row0 + ai * HALF + m * 16; const float rs = row_rstd(ss, row);
                const f32x4 g0 = acc[ai][0][m][0] * rs, g1 = acc[ai][0][m][1] * rs, u0 = acc[ai][1][m][0] * rs, u1 = acc[ai][1][m][1] * rs;
                u32x4 w; w.x = cvt_pk_bf16(silu_mul(g0[0], u0[0]), silu_mul(g0[1], u0[1])); w.y = cvt_pk_bf16(silu_mul(g0[2], u0[2]), silu_mul(g0[3], u0[3]));
                w.z = cvt_pk_bf16(silu_mul(g1[0], u1[0]), silu_mul(g1[1], u1[1])); w.w = cvt_pk_bf16(silu_mul(g1[2], u1[2]), silu_mul(g1[3], u1[3]));
                *(u32x4*)(O + (size_t)row * ldo + col0) = w; }
    }
};
struct EpiRes {
    static constexpr bool PERM = false, AFTER_DRAIN = false;
    const float* base; float* out; bf16_t* xb; float* ss; float alpha;
    __device__ __forceinline__ void operator()(const f32x4 (&acc)[2][2][4][2], const Unit& u, int wr, int wc, int fr, int fq) const {
        const int row0 = u.pm * BM + wr * 64 + fr; const int col0 = u.pn * BM + wc * 32 + 4 * fq;
#pragma unroll
        for (int ai = 0; ai < 2; ++ai)
#pragma unroll
            for (int m = 0; m < 4; ++m) { const int row = row0 + ai * HALF + m * 16; const size_t off = (size_t)row * 1024 + col0; float sq = 0.f;
#pragma unroll
                for (int bj = 0; bj < 2; ++bj)
#pragma unroll
                    for (int n = 0; n < 2; ++n) { const f32x4 bs = *(const f32x4*)(base + off + bj * HALF + n * 16); const f32x4 o = bs + acc[ai][bj][m][n] * alpha;
                        *(f32x4*)(out + off + bj * HALF + n * 16) = o; sq += (o[0] * o[0] + o[1] * o[1]) + (o[2] * o[2] + o[3] * o[3]);
                        if (xb) { u32x2 w; w.x = cvt_pk_bf16(o[0], o[1]); w.y = cvt_pk_bf16(o[2], o[3]); *(u32x2*)(xb + off + bj * HALF + n * 16) = w; } }
                sq += __shfl_xor(sq, 16); sq += __shfl_xor(sq, 32);
                if (fq == 0) ss[(size_t)row * 16 + u.pn * 4 + wc] = sq; }
    }
};
struct EpiWin {
    static constexpr bool PERM = true, AFTER_DRAIN = false;
    bf16_t* O; const float* ss; const float* bias; int bias_from; int ldo;
    __device__ __forceinline__ void operator()(const f32x4 (&acc)[2][2][4][2], const Unit& u, int wr, int wc, int fr, int fq) const {
        const int row0 = u.pm * BM + wr * 64 + fr; const int col0 = u.pn * BM + wc * 32 + 8 * fq;
        f32x4 bv[2][2];
#pragma unroll
        for (int bj = 0; bj < 2; ++bj)
#pragma unroll
            for (int n = 0; n < 2; ++n) { const int c = col0 + bj * HALF + 4 * n; bv[bj][n] = (c >= bias_from) ? *(const f32x4*)(bias + (c - bias_from)) : (f32x4){0.f, 0.f, 0.f, 0.f}; }
#pragma unroll
        for (int ai = 0; ai < 2; ++ai)
#pragma unroll
            for (int m = 0; m < 4; ++m) { const int row = row0 + ai * HALF + m * 16; const float rs = row_rstd(ss, row);
#pragma unroll
                for (int bj = 0; bj < 2; ++bj) { const f32x4 v0 = acc[ai][bj][m][0] * rs + bv[bj][0], v1 = acc[ai][bj][m][1] * rs + bv[bj][1];
                    u32x4 w; w.x = cvt_pk_bf16(v0[0], v0[1]); w.y = cvt_pk_bf16(v0[2], v0[3]); w.z = cvt_pk_bf16(v1[0], v1[1]); w.w = cvt_pk_bf16(v1[2], v1[3]);
                    *(u32x4*)(O + (size_t)row * ldo + col0 + bj * HALF) = w; } }
    }
};
struct EpiLora {
    static constexpr bool PERM = true, AFTER_DRAIN = false;
    float* DEC; bf16_t* AA; bf16_t* GG; const float* w0; const float* a0;
    __device__ __forceinline__ void operator()(const f32x4 (&acc)[2][2][4][2], const Unit& u, int wr, int wc, int fr, int fq) const {
        const int row0 = u.pm * BM + wr * 64 + fr; const int kind = u.pn >> 1; const int col0 = (u.pn & 1) * BM + wc * 32 + 8 * fq;
#pragma unroll
        for (int bj = 0; bj < 2; ++bj) { const int c = col0 + bj * HALF;
            f32x4 b0 = (f32x4){0.f, 0.f, 0.f, 0.f}, b1 = b0;
            if (kind == 0) { b0 = *(const f32x4*)(w0 + c); b1 = *(const f32x4*)(w0 + c + 4); } else if (kind == 1) { b0 = *(const f32x4*)(a0 + c); b1 = *(const f32x4*)(a0 + c + 4); }
#pragma unroll
            for (int ai = 0; ai < 2; ++ai)
#pragma unroll
                for (int m = 0; m < 4; ++m) { const int row = row0 + ai * HALF + m * 16; f32x4 v0 = acc[ai][bj][m][0] + b0, v1 = acc[ai][bj][m][1] + b1;
                    if (kind == 0) {
#pragma unroll
                        for (int e = 0; e < 4; ++e) { v0[e] = expf(-0.60653065971f / (1.0f + expf(-v0[e]))); v1[e] = expf(-0.60653065971f / (1.0f + expf(-v1[e]))); }
                        *(f32x4*)(DEC + (size_t)row * 512 + c) = v0; *(f32x4*)(DEC + (size_t)row * 512 + c + 4) = v1;
                    } else {
                        if (kind == 1) {
#pragma unroll
                            for (int e = 0; e < 4; ++e) { v0[e] = 1.0f / (1.0f + expf(-v0[e])); v1[e] = 1.0f / (1.0f + expf(-v1[e])); } }
                        u32x4 w; w.x = cvt_pk_bf16(v0[0], v0[1]); w.y = cvt_pk_bf16(v0[2], v0[3]); w.z = cvt_pk_bf16(v1[0], v1[1]); w.w = cvt_pk_bf16(v1[2], v1[3]);
                        *(u32x4*)((kind == 1 ? AA : GG) + (size_t)row * 512 + c) = w; } }
        }
    }
};

template <class Epi, class Sched, bool ALIGN_EPI = false, bool SP2 = false>
__device__ __forceinline__ void gemm_phase(PG8_LAS unsigned char* lds, const Gemm g, const Sched& S, const Epi& E, const int wid) {
    const int lane = (int)__builtin_amdgcn_mbcnt_hi(~0u, __builtin_amdgcn_mbcnt_lo(~0u, 0u)), tid = (wid << 6) | lane, wr = wid >> 2, wc = wid & 3, fr = lane & 15, fq = lane >> 4;
    int K = g.K; asm volatile("" : "+s"(K)); const int nt = K / BK;
    unsigned voffA[2], voffB[2];
#pragma unroll
    for (int i = 0; i < 2; ++i) { int R, C; stage_rc(tid * 16 + i * 8192, R, C); const int Rb = Epi::PERM ? ((R & ~31) + perm32(R & 31)) : R;
        voffA[i] = (unsigned)(R * K + C) * 2u; voffB[i] = (unsigned)(Rb * K + C) * 2u; }
    const size_t kstep = (size_t)(BK * 2);
    const size_t hstep = (size_t)HALF * K * 2;
    const size_t tstep = 2 * hstep;
    const unsigned ldsw = (unsigned)wid * 1024u;
    const int aoff = lds_byte(wr * 64 + fr, fq * 8), boff = lds_byte(wc * 32 + fr, fq * 8);
#define PG8_SA(b, h) (((b) * 2 + (h)) * HTB)
#define PG8_SB(b, h) ((4 + (b) * 2 + (h)) * HTB)
#define PG8_STAGE(bufoff, gbase, voff) do { _Pragma("unroll") for (int _i = 0; _i < 2; ++_i) \
        __builtin_amdgcn_global_load_lds((const unsigned*)((const char*)(gbase) + (voff)[_i]), (PG8_LAS unsigned*)(lds + (bufoff) + ldsw + _i * 8192), 16, 0, 0); } while (0)
#define PG8_LDA(dst, b, h) do { _Pragma("unroll") for (int m = 0; m < 4; ++m) _Pragma("unroll") for (int k = 0; k < 2; ++k) dst[m][k] = *(const PG8_LAS bf16x8*)(lds + PG8_SA(b, h) + aoff + m * 2048 + k * 1024); } while (0)
#define PG8_LDB(dst, b, h) do { _Pragma("unroll") for (int n = 0; n < 2; ++n) _Pragma("unroll") for (int k = 0; k < 2; ++k) dst[n][k] = *(const PG8_LAS bf16x8*)(lds + PG8_SB(b, h) + boff + n * 2048 + k * 1024); } while (0)
#define PG8_MMA(ai, bj, At, Bt) do { __builtin_amdgcn_s_setprio(1); _Pragma("unroll") for (int m = 0; m < 4; ++m) _Pragma("unroll") for (int n = 0; n < 2; ++n) _Pragma("unroll") for (int k = 0; k < 2; ++k) \
        acc[ai][bj][m][n] = __builtin_amdgcn_mfma_f32_16x16x32_bf16(Bt[n][k], At[m][k], acc[ai][bj][m][n], 0, 0, 0); __builtin_amdgcn_s_setprio(0); } while (0)
#define PG8_WAIT_V(n) asm volatile("s_waitcnt vmcnt(" #n ")" ::: "memory")
#define PG8_WAIT_L(n) asm volatile("s_waitcnt lgkmcnt(" #n ")" ::: "memory")
#define PG8_BAR __builtin_amdgcn_s_barrier()
#define PG8_SCHED __builtin_amdgcn_sched_barrier(0)
    Unit cur, nxt; int ui = 0;
    if (!S.next(0, cur)) return;
    f32x4 acc[2][2][4][2];
#pragma unroll
    for (int a = 0; a < 2; ++a)
#pragma unroll
        for (int b = 0; b < 2; ++b)
#pragma unroll
            for (int m = 0; m < 4; ++m)
#pragma unroll
                for (int n = 0; n < 2; ++n) acc[a][b][m][n] = (f32x4){0.f, 0.f, 0.f, 0.f};
    bf16x8 At[4][2], B0[2][2], B1[2][2];
    const char* cA = (const char*)g.A + (size_t)cur.pm * tstep; const char* cB = (const char*)g.Bt + (size_t)cur.pn * tstep;
    S.a_ready(cur);
    if constexpr (SP2) {
        PG8_STAGE(PG8_SB(0, 0), cB, voffB); PG8_STAGE(PG8_SB(0, 1), cB + hstep, voffB); PG8_STAGE(PG8_SA(0, 0), cA, voffA); PG8_STAGE(PG8_SA(0, 1), cA + hstep, voffA);
        if (wr == 1) PG8_BAR;
        PG8_WAIT_V(2); PG8_BAR;
        PG8_STAGE(PG8_SB(1, 0), cB + kstep, voffB); PG8_STAGE(PG8_SA(1, 0), cA + kstep, voffA); PG8_STAGE(PG8_SB(1, 1), cB + hstep + kstep, voffB);
        PG8_WAIT_V(6); PG8_BAR;
    } else {
        PG8_STAGE(PG8_SB(0, 0), cB, voffB); PG8_STAGE(PG8_SA(0, 0), cA, voffA); PG8_STAGE(PG8_SB(0, 1), cB + hstep, voffB); PG8_STAGE(PG8_SA(0, 1), cA + hstep, voffA);
        if (wr == 1) PG8_BAR;
        PG8_WAIT_V(4); PG8_BAR;
        PG8_STAGE(PG8_SB(1, 0), cB + kstep, voffB); PG8_STAGE(PG8_SA(1, 0), cA + kstep, voffA); PG8_STAGE(PG8_SB(1, 1), cB + hstep + kstep, voffB);
        PG8_WAIT_V(6); PG8_BAR;
    }
    for (;;) {
        const bool has_next = S.next(ui + 1, nxt);
        const char* nA = has_next ? (const char*)g.A + (size_t)nxt.pm * tstep : cA; const char* nB = has_next ? (const char*)g.Bt + (size_t)nxt.pn * tstep : cB;
        for (int t = 0; t < nt; t += 2) {
            const bool last = (t == nt - 2);
            const char* a1 = cA + (size_t)(t + 1) * kstep;
            const char* a2 = last ? nA : cA + (size_t)(t + 2) * kstep; const char* b2 = last ? nB : cB + (size_t)(t + 2) * kstep;
            const char* a3 = a2 + kstep; const char* b3 = b2 + kstep;
            if (last && has_next) S.a_ready(nxt);
            if constexpr (SP2) {
            PG8_LDB(B0, 0, 0); PG8_LDB(B1, 0, 1); PG8_SCHED; PG8_LDA(At, 0, 0); PG8_STAGE(PG8_SA(1, 1), a1 + hstep, voffA);
            PG8_WAIT_V(8); PG8_WAIT_L(0); PG8_BAR; PG8_MMA(0, 0, At, B0); PG8_MMA(0, 1, At, B1); PG8_BAR; PG8_SCHED;
            PG8_LDA(At, 0, 1); PG8_STAGE(PG8_SB(0, 0), b2, voffB); PG8_STAGE(PG8_SB(0, 1), b2 + hstep, voffB); PG8_STAGE(PG8_SA(0, 0), a2, voffA);
            PG8_WAIT_V(8); PG8_WAIT_L(0); PG8_BAR; PG8_MMA(1, 0, At, B0); PG8_MMA(1, 1, At, B1); PG8_BAR; PG8_SCHED;
            PG8_LDB(B0, 1, 0); PG8_LDB(B1, 1, 1); PG8_SCHED; PG8_LDA(At, 1, 0); PG8_STAGE(PG8_SA(0, 1), a2 + hstep, voffA);
            PG8_WAIT_V(8); PG8_WAIT_L(0); PG8_BAR; PG8_MMA(0, 0, At, B0); PG8_MMA(0, 1, At, B1); PG8_BAR; PG8_SCHED;
            PG8_LDA(At, 1, 1); PG8_STAGE(PG8_SB(1, 0), b3, voffB); PG8_STAGE(PG8_SB(1, 1), b3 + hstep, voffB); PG8_STAGE(PG8_SA(1, 0), a3, voffA);
            PG8_WAIT_V(8); PG8_WAIT_L(0); PG8_BAR; PG8_MMA(1, 0, At, B0); PG8_MMA(1, 1, At, B1); PG8_BAR; PG8_SCHED;
            } else {
            PG8_LDB(B0, 0, 0); PG8_SCHED; PG8_LDA(At, 0, 0); PG8_STAGE(PG8_SA(1, 1), a1 + hstep, voffA);
            PG8_WAIT_L(8); PG8_BAR; PG8_WAIT_L(0); PG8_MMA(0, 0, At, B0); PG8_BAR; PG8_SCHED;
            PG8_LDB(B1, 0, 1); PG8_STAGE(PG8_SB(0, 0), b2, voffB);
            PG8_BAR; PG8_WAIT_L(0); PG8_MMA(0, 1, At, B1); PG8_BAR;
            PG8_LDA(At, 0, 1); PG8_STAGE(PG8_SA(0, 0), a2, voffA);
            PG8_BAR; PG8_WAIT_L(0); PG8_MMA(1, 0, At, B0); PG8_BAR; PG8_SCHED;
            PG8_STAGE(PG8_SB(0, 1), b2 + hstep, voffB);
            PG8_WAIT_V(6); PG8_BAR; PG8_MMA(1, 1, At, B1); PG8_BAR;
            PG8_LDB(B0, 1, 0); PG8_SCHED; PG8_LDA(At, 1, 0); PG8_STAGE(PG8_SA(0, 1), a2 + hstep, voffA);
            PG8_WAIT_L(8); PG8_BAR; PG8_WAIT_L(0); PG8_MMA(0, 0, At, B0); PG8_BAR; PG8_SCHED;
            PG8_LDB(B1, 1, 1); PG8_STAGE(PG8_SB(1, 0), b3, voffB);
            PG8_BAR; PG8_WAIT_L(0); PG8_MMA(0, 1, At, B1); PG8_BAR;
            PG8_LDA(At, 1, 1); PG8_STAGE(PG8_SA(1, 0), a3, voffA);
            PG8_BAR; PG8_WAIT_L(0); PG8_MMA(1, 0, At, B0); PG8_BAR; PG8_SCHED;
            PG8_STAGE(PG8_SB(1, 1), b3 + hstep, voffB);
            PG8_WAIT_V(6); PG8_BAR; PG8_MMA(1, 1, At, B1); PG8_BAR;
            }
        }
        if constexpr (ALIGN_EPI) { if (wr == 0) PG8_BAR; }
        if constexpr (!Epi::AFTER_DRAIN) { E(acc, cur, wr, wc, fr, fq); S.done(cur); }
        if (!has_next) break;
#pragma unroll
        for (int a = 0; a < 2; ++a)
#pragma unroll
            for (int b = 0; b < 2; ++b)
#pragma unroll
                for (int m = 0; m < 4; ++m)
#pragma unroll
                    for (int n = 0; n < 2; ++n) acc[a][b][m][n] = (f32x4){0.f, 0.f, 0.f, 0.f};
        cur = nxt; cA = nA; cB = nB; ++ui;
        if constexpr (ALIGN_EPI) { if (wr == 1) PG8_BAR; }
    }
    PG8_WAIT_V(0);
    if constexpr (!ALIGN_EPI) { if (wr == 0) PG8_BAR; }
    PG8_BAR;
    if constexpr (Epi::AFTER_DRAIN) { E.fused(acc, cur, wr, wc, fr, fq, lds, wid, lane); S.done(cur); }
#undef PG8_SA
#undef PG8_SB
#undef PG8_STAGE
#undef PG8_LDA
#undef PG8_LDB
#undef PG8_MMA
#undef PG8_WAIT_V
#undef PG8_WAIT_L
#undef PG8_BAR
#undef PG8_SCHED
}
}

constexpr int BATCH = 2, SEQ = 8192, DM = 1024, FF = 2816, NIN = 2560, RW = 512, M = BATCH * SEQ;
constexpr int NWAVES = 8, NTHR = 512;
constexpr int CH = 128, NCH = SEQ / CH;
constexpr size_t MiB = 1u << 20;
constexpr size_t WS_WGU1 = 0, WS_WD1 = 11 * MiB, WS_WIN = WS_WD1 + 11 * MiB / 2, WS_WOUT = WS_WIN + 5 * MiB, WS_WGU2 = WS_WOUT + 2 * MiB, WS_WD2 = WS_WGU2 + 11 * MiB, WS_WL = 40 * MiB;
constexpr size_t WS_GG = 0;
constexpr size_t WS_XB = 44 * MiB;
constexpr size_t WS_PST = 44 * MiB, WS_LST = 60 * MiB;
constexpr size_t WS_BIG = 76 * MiB;
constexpr size_t WS_LIN = WS_BIG + 80 * MiB;
constexpr size_t WS_DEC = 164 * MiB, WS_AA = 196 * MiB, WS_MIX = 212 * MiB, WS_SS = 244 * MiB, WS_CTL = 248 * MiB, WS_END = 249 * MiB;
static_assert(WS_WD2 + 11 * MiB / 2 <= WS_WL && WS_WL + MiB <= WS_XB, "weights map");

#define LAS __attribute__((address_space(3)))
typedef unsigned short bf16;
typedef unsigned v4u __attribute__((ext_vector_type(4)));
typedef unsigned v2u __attribute__((ext_vector_type(2)));
typedef float f32x4 __attribute__((ext_vector_type(4)));
typedef float f32x2 __attribute__((ext_vector_type(2)));
typedef short bf16x8 __attribute__((ext_vector_type(8)));
using pg8::cvt_pk_bf16;
__device__ __forceinline__ float bflo(unsigned u) { return __uint_as_float(u << 16); }
__device__ __forceinline__ float bfhi(unsigned u) { return __uint_as_float(u & 0xffff0000u); }
template <int CTRL> __device__ __forceinline__ float dpp_mov(float x) { return __builtin_bit_cast(float, __builtin_amdgcn_update_dpp(0, __builtin_bit_cast(int, x), CTRL, 0xF, 0xF, true)); }
__device__ __forceinline__ float sum16(float x) { x += dpp_mov<0xB1>(x); x += dpp_mov<0x4E>(x); x += dpp_mov<0x141>(x); x += dpp_mov<0x140>(x); return x; }
__device__ __forceinline__ float max16(float x) { x = fmaxf(x, dpp_mov<0xB1>(x)); x = fmaxf(x, dpp_mov<0x4E>(x)); x = fmaxf(x, dpp_mov<0x141>(x)); x = fmaxf(x, dpp_mov<0x140>(x)); return x; }
__device__ __forceinline__ float sum8(float x) { x += dpp_mov<0xB1>(x); x += dpp_mov<0x4E>(x); x += dpp_mov<0x141>(x); return x; }
__device__ __forceinline__ float wave_sum(float v) {
#pragma unroll
    for (int o = 1; o < 64; o <<= 1) v += __shfl_xor(v, o);
    return v;
}

__device__ __forceinline__ int lane_id() { return (int)__builtin_amdgcn_mbcnt_hi(~0u, __builtin_amdgcn_mbcnt_lo(~0u, 0u)); }
#define TIDX ((wave << 6) | lane_id())
struct Params {
    const float* in[26]; float* out; unsigned char* ws; int ph_lo, ph_hi;
};


#define GAS __attribute__((address_space(1)))
__device__ __forceinline__ const float* inp(int i) {
    const __attribute__((address_space(4))) char* ka = (const __attribute__((address_space(4))) char*)__builtin_amdgcn_kernarg_segment_ptr();
    int off = i * 8; asm volatile("" : "+s"(off));
    const float* q = *(const float* const __attribute__((address_space(4)))*)(ka + off);
    return (const float*)(const GAS float*)q;
}

__device__ __forceinline__ void conv_item(const float* W, int K, int N, const float* sc, bf16* WT, int k0, int n0, int drow0, float* scr, int lane) {
#pragma unroll 8
    for (int i = 0; i < 32; ++i) { const int kk = 2 * i + (lane >> 5); float v = W[(size_t)(k0 + kk) * N + n0 + (lane & 31)]; if (sc) v *= sc[k0 + kk]; scr[kk * 33 + (lane & 31)] = v; }
    __builtin_amdgcn_fence(__ATOMIC_RELEASE, "wavefront"); asm volatile("s_waitcnt lgkmcnt(0)" ::: "memory");
    const int c = lane & 7;
#pragma unroll
    for (int j = 0; j < 4; ++j) { const int n = (lane >> 3) + 8 * j; const float* s = scr + (8 * c) * 33 + n;
        v4u o; o.x = cvt_pk_bf16(s[0 * 33], s[1 * 33]); o.y = cvt_pk_bf16(s[2 * 33], s[3 * 33]); o.z = cvt_pk_bf16(s[4 * 33], s[5 * 33]); o.w = cvt_pk_bf16(s[6 * 33], s[7 * 33]);
        *(v4u*)(WT + (size_t)(drow0 + n) * K + k0 + 8 * c) = o; }
    asm volatile("s_waitcnt lgkmcnt(0)" ::: "memory");
}
__device__ __forceinline__ void conv_plain(const float* W, int K, int N, const float* sc, bf16* WT, int item, float* scr, int lane) {
    const int nblk = N / 32, kb = item / nblk, nb = item % nblk; conv_item(W, K, N, sc, WT, 64 * kb, 32 * nb, 32 * nb, scr, lane);
}
__device__ __forceinline__ void conv_gu(const float* W, const float* sc, bf16* WT, int item, int up, float* scr, int lane) {
    const int nblk = FF / 32, kb = item / nblk, nb = item % nblk, n0 = 32 * nb; conv_item(W, DM, FF, sc, WT, 64 * kb, n0, (n0 >> 7) * 256 + up * 128 + (n0 & 127), scr, lane);
}
__device__ __forceinline__ void p0_prologue(const Params& p, unsigned char* lds, int wave, int lane) {
    float* scr = (float*)(lds + wave * 16384);
    unsigned char* ws = p.ws;
    const int gw = blockIdx.x * NWAVES + wave, NGW = gridDim.x * NWAVES;
    constexpr int I_GU = (DM / 64) * (FF / 32), I_DN = (FF / 64) * (DM / 32), I_IN = (DM / 64) * (NIN / 32), I_OUT = (DM / 64) * (DM / 32);
    constexpr int NITEMS = 4 * I_GU + 2 * I_DN + I_IN + I_OUT;
    for (int it = gw; it < NITEMS; it += NGW) {
        int r = it;
        if (r < I_GU) { conv_gu(inp(2), inp(1), (bf16*)(ws + WS_WGU1), r, 0, scr, lane); continue; } r -= I_GU;
        if (r < I_GU) { conv_gu(inp(3), inp(1), (bf16*)(ws + WS_WGU1), r, 1, scr, lane); continue; } r -= I_GU;
        if (r < I_DN) { conv_plain(inp(4), FF, DM, nullptr, (bf16*)(ws + WS_WD1), r, scr, lane); continue; } r -= I_DN;
        if (r < I_IN) { conv_plain(inp(6), DM, NIN, inp(5), (bf16*)(ws + WS_WIN), r, scr, lane); continue; } r -= I_IN;
        if (r < I_OUT) { conv_plain(inp(20), DM, DM, nullptr, (bf16*)(ws + WS_WOUT), r, scr, lane); continue; } r -= I_OUT;
        if (r < I_GU) { conv_gu(inp(22), inp(21), (bf16*)(ws + WS_WGU2), r, 0, scr, lane); continue; } r -= I_GU;
        if (r < I_GU) { conv_gu(inp(23), inp(21), (bf16*)(ws + WS_WGU2), r, 1, scr, lane); continue; } r -= I_GU;
        conv_plain(inp(24), FF, DM, nullptr, (bf16*)(ws + WS_WD2), r, scr, lane);
    }
    { bf16* WL = (bf16*)(ws + WS_WL); const float* w2 = inp(10); const float* a2 = inp(12); const float* g2 = inp(13);
      for (int idx = (blockIdx.x * NTHR + TIDX); idx < 1536 * 128; idx += gridDim.x * NTHR) {
          const int n = idx >> 7, k = (idx & 127) * 2; float v0 = 0.f, v1 = 0.f;
          if (n < 512) { if (k < 64) { v0 = w2[k * 512 + n]; v1 = w2[(k + 1) * 512 + n]; } }
          else if (n < 1024) { if (k >= 64 && k < 128) { v0 = a2[(k - 64) * 512 + n - 512]; v1 = a2[(k - 63) * 512 + n - 512]; } }
          else { if (k >= 128) { v0 = g2[(k - 128) * 512 + n - 1024]; v1 = g2[(k - 127) * 512 + n - 1024]; } }
          *(unsigned*)(WL + (size_t)n * 256 + k) = cvt_pk_bf16(v0, v1); } }
    { const float* x = inp(0); bf16* XB = (bf16*)(ws + WS_XB); float* ss0 = (float*)(ws + WS_SS);
      for (int m = gw; m < M; m += NGW) { const f32x4* xr = (const f32x4*)(x + (size_t)m * DM) + lane; float s = 0.f; f32x4 v[4];
#pragma unroll
          for (int j = 0; j < 4; ++j) { v[j] = xr[64 * j]; s += (v[j][0] * v[j][0] + v[j][1] * v[j][1]) + (v[j][2] * v[j][2] + v[j][3] * v[j][3]); }
          s = wave_sum(s);
          v2u* o8 = (v2u*)(XB + (size_t)m * DM) + lane;
#pragma unroll
          for (int j = 0; j < 4; ++j) { v2u w; w.x = cvt_pk_bf16(v[j][0], v[j][1]); w.y = cvt_pk_bf16(v[j][2], v[j][3]); o8[64 * j] = w; }
          if (lane < 16) ss0[(size_t)m * 16 + lane] = (lane == 0) ? s : 0.f; } }
}

__device__ __forceinline__ void r1_phase(const Params& p, int wave) {
    const bf16* P = (const bf16*)(p.ws + WS_BIG); bf16* LIN = (bf16*)(p.ws + WS_LIN); const float* mix = inp(8);
    for (int idx = blockIdx.x * NTHR + TIDX; idx < M * 32; idx += gridDim.x * NTHR) {
        const int row = idx >> 5, g8 = idx & 31, col = 1536 + 8 * g8; const bool hp = (row & (SEQ - 1)) != 0;
        const v4u c = *(const v4u*)(P + (size_t)row * NIN + col); v4u q = (v4u){0u, 0u, 0u, 0u}; if (hp) q = *(const v4u*)(P + (size_t)(row - 1) * NIN + col);
        const f32x4 m0 = *(const f32x4*)(mix + col), m1 = *(const f32x4*)(mix + col + 4);
        float x[8];
#pragma unroll
        for (int e = 0; e < 4; ++e) { const float c0 = bflo(c[e]), c1 = bfhi(c[e]), q0 = bflo(q[e]), q1 = bfhi(q[e]); const float ma = (e < 2) ? m0[2 * e] : m1[2 * e - 4], mb = (e < 2) ? m0[2 * e + 1] : m1[2 * e - 3];
            x[2 * e] = c0 + (q0 - c0) * ma; x[2 * e + 1] = c1 + (q1 - c1) * mb; }
        if (g8 < 8) {
#pragma unroll
            for (int e = 0; e < 8; ++e) x[e] = tanhf(x[e]);
        } else if (g8 >= 16) {
#pragma unroll
            for (int e = 0; e < 8; ++e) x[e] = 1.0f / (1.0f + expf(-x[e]));
        }
        v4u o; o.x = cvt_pk_bf16(x[0], x[1]); o.y = cvt_pk_bf16(x[2], x[3]); o.z = cvt_pk_bf16(x[4], x[5]); o.w = cvt_pk_bf16(x[6], x[7]);
        *(v4u*)(LIN + (size_t)row * 256 + 8 * g8) = o;
    }
}

constexpr int SC_W = 0, SC_B = 1, SC_K = 2, SC_KK = 3, SC_V = 4, SC_R = 5, SC_O = 6, SC_BC = 7;
template <bool P3> __device__ __forceinline__ void scan_load(const Params& p, float* sm, int b, int h, int t0, int wave) {
    const int tid = TIDX, tt = tid >> 3, c8 = (tid & 7) * 8, hc = h * 64 + c8;
    const bf16* P = (const bf16*)(p.ws + WS_BIG); const float* DEC = (const float*)(p.ws + WS_DEC); const bf16* AA = (const bf16*)(p.ws + WS_AA);
    const float* mix = inp(8); const float* k_k = inp(14); const float* k_a = inp(15); const float* r_k = inp(16);
    const int gr = b * SEQ + t0 + tt; const bool hp = (t0 + tt) > 0;
    const bf16* prow = P + (size_t)gr * NIN + hc;
    float r[8], k[8], v[8];
#define SHIFT_LOAD(dst, off) do { const v4u c_ = *(const v4u*)(prow + (off)); v4u q_ = (v4u){0u, 0u, 0u, 0u}; if (hp) q_ = *(const v4u*)(prow + (off) - NIN); \
        const f32x4 m0_ = *(const f32x4*)(mix + hc + (off)), m1_ = *(const f32x4*)(mix + hc + (off) + 4); \
        _Pragma("unroll") for (int e = 0; e < 4; ++e) { const float c0 = bflo(c_[e]), c1 = bfhi(c_[e]), q0 = bflo(q_[e]), q1 = bfhi(q_[e]); const float ma = (e < 2) ? m0_[2 * e] : m1_[2 * e - 4], mb = (e < 2) ? m0_[2 * e + 1] : m1_[2 * e - 3]; \
            dst[2 * e] = c0 + (q0 - c0) * ma; dst[2 * e + 1] = c1 + (q1 - c1) * mb; } } while (0)
    SHIFT_LOAD(k, 512); SHIFT_LOAD(v, 1024);
    if (P3) SHIFT_LOAD(r, 0);
#undef SHIFT_LOAD
    const f32x4 d0 = *(const f32x4*)(DEC + (size_t)gr * RW + hc), d1 = *(const f32x4*)(DEC + (size_t)gr * RW + hc + 4);
    const v4u av = *(const v4u*)(AA + (size_t)gr * RW + hc);
    const f32x4 kk0 = *(const f32x4*)(k_k + hc), kk1 = *(const f32x4*)(k_k + hc + 4), ka0 = *(const f32x4*)(k_a + hc), ka1 = *(const f32x4*)(k_a + hc + 4);
    float a[8], kk[8], kp[8], bb[8]; float ssq = 0.f;
#pragma unroll
    for (int e = 0; e < 4; ++e) { a[2 * e] = bflo(av[e]); a[2 * e + 1] = bfhi(av[e]); }
#pragma unroll
    for (int e = 0; e < 8; ++e) { const float kkw = (e < 4) ? kk0[e] : kk1[e - 4], kaw = (e < 4) ? ka0[e] : ka1[e - 4];
        kk[e] = k[e] * kkw; ssq += kk[e] * kk[e]; kp[e] = k[e] * (1.0f + (a[e] - 1.0f) * kaw); }
    ssq = sum8(ssq);
    const float inv = 1.0f / fmaxf(sqrtf(ssq), 1e-12f);
#pragma unroll
    for (int e = 0; e < 8; ++e) { kk[e] *= inv; bb[e] = kk[e] * a[e]; }
    float* base = sm + tt * 64 + c8;
    *(f32x4*)(base + SC_W * 4096) = d0; *(f32x4*)(base + SC_W * 4096 + 4) = d1;
    *(f32x4*)(base + SC_B * 4096) = (f32x4){bb[0], bb[1], bb[2], bb[3]}; *(f32x4*)(base + SC_B * 4096 + 4) = (f32x4){bb[4], bb[5], bb[6], bb[7]};
    *(f32x4*)(base + SC_K * 4096) = (f32x4){kp[0], kp[1], kp[2], kp[3]}; *(f32x4*)(base + SC_K * 4096 + 4) = (f32x4){kp[4], kp[5], kp[6], kp[7]};
    *(f32x4*)(base + SC_KK * 4096) = (f32x4){kk[0], kk[1], kk[2], kk[3]}; *(f32x4*)(base + SC_KK * 4096 + 4) = (f32x4){kk[4], kk[5], kk[6], kk[7]};
    *(f32x4*)(base + SC_V * 4096) = (f32x4){v[0], v[1], v[2], v[3]}; *(f32x4*)(base + SC_V * 4096 + 4) = (f32x4){v[4], v[5], v[6], v[7]};
    if (P3) {
        *(f32x4*)(base + SC_R * 4096) = (f32x4){r[0], r[1], r[2], r[3]}; *(f32x4*)(base + SC_R * 4096 + 4) = (f32x4){r[4], r[5], r[6], r[7]};
        const f32x4 rk0 = *(const f32x4*)(r_k + hc), rk1 = *(const f32x4*)(r_k + hc + 4); float bc = 0.f;
#pragma unroll
        for (int e = 0; e < 8; ++e) bc += r[e] * kp[e] * ((e < 4) ? rk0[e] : rk1[e - 4]);
        bc = sum8(bc);
        if ((tid & 7) == 0) sm[SC_BC * 4096 + tt] = bc;
    }
}
#define LO2(v) __builtin_shufflevector(v, v, 0, 1)
#define HI2(v) __builtin_shufflevector(v, v, 2, 3)
template <int RPL, bool WITH_O, bool REAL> __device__ __forceinline__ void scan_run(const float* sm, f32x2 (&S)[RPL][2], int cs, int rowbase) {
    typedef float vrow_t __attribute__((ext_vector_type(RPL)));
    const float* st0 = sm + 4 * cs;
    f32x4 w4 = *(const f32x4*)(st0 + SC_W * 4096), b4 = *(const f32x4*)(st0 + SC_B * 4096), kk4 = *(const f32x4*)(st0 + SC_KK * 4096), k4 = w4, r4 = w4;
    if (REAL) k4 = *(const f32x4*)(st0 + SC_K * 4096);
    if (WITH_O) r4 = *(const f32x4*)(st0 + SC_R * 4096);
    vrow_t v4; if (REAL) v4 = *(const vrow_t*)(sm + SC_V * 4096 + rowbase);
#pragma unroll 2
    for (int t = 0; t < 64; ++t) {
        const int tn = (t + 1) & 63;
        const float* st = st0 + tn * 64;
        const f32x4 nw4 = *(const f32x4*)(st + SC_W * 4096), nb4 = *(const f32x4*)(st + SC_B * 4096), nkk4 = *(const f32x4*)(st + SC_KK * 4096);
        f32x4 nk4 = nw4, nr4 = nw4; vrow_t nv4;
        if (REAL) { nk4 = *(const f32x4*)(st + SC_K * 4096); nv4 = *(const vrow_t*)(sm + SC_V * 4096 + tn * 64 + rowbase); }
        if (WITH_O) nr4 = *(const f32x4*)(st + SC_R * 4096);
        const f32x2 w01 = LO2(w4), w23 = HI2(w4), b01 = LO2(b4), b23 = HI2(b4), kk01 = LO2(kk4), kk23 = HI2(kk4), k01 = LO2(k4), k23 = HI2(k4), r01 = LO2(r4), r23 = HI2(r4);
        float oo[RPL];
#pragma unroll
        for (int j = 0; j < RPL; ++j) {
            f32x2 pp = S[j][0] * kk01; pp = S[j][1] * kk23 + pp;
            const float nsa = -sum16(pp[0] + pp[1]);
            const f32x2 nsa2 = (f32x2){nsa, nsa};
            f32x2 t01 = nsa2 * b01, t23 = nsa2 * b23;
            if (REAL) { const f32x2 v2 = (f32x2){v4[j], v4[j]}; t01 = v2 * k01 + t01; t23 = v2 * k23 + t23; }
            S[j][0] = S[j][0] * w01 + t01; S[j][1] = S[j][1] * w23 + t23;
            if (WITH_O) { f32x2 qq = S[j][0] * r01; qq = S[j][1] * r23 + qq; oo[j] = sum16(qq[0] + qq[1]); }
        }
        if (WITH_O) { if (cs == 0) {
#pragma unroll
            for (int j = 0; j < RPL; ++j) ((float*)sm)[SC_O * 4096 + t * 64 + rowbase + j] = oo[j]; } }
        w4 = nw4; b4 = nb4; kk4 = nkk4; k4 = nk4; r4 = nr4; if (REAL) v4 = nv4;
    }
}
__device__ __forceinline__ void scan_pass1(const Params& p, float* sm, int wave, int lane) {
    float* PST = (float*)(p.ws + WS_PST); float* LST = (float*)(p.ws + WS_LST);
    const int cs = lane & 15, rg = lane >> 4; const bool real = wave < 4; const int rowbase = (wave & 3) * 16 + rg * 4;
    constexpr int NU = BATCH * (NCH - 1) * 8;
    for (int u = blockIdx.x; u < NU; u += gridDim.x) {
        const int h = u & 7, bc = u >> 3, c = bc % (NCH - 1), b = bc / (NCH - 1);
        f32x2 S[4][2];
#pragma unroll
        for (int j = 0; j < 4; ++j)
#pragma unroll
            for (int e = 0; e < 4; ++e) S[j][e >> 1][e & 1] = (!real && (rowbase + j == 4 * cs + e)) ? 1.0f : 0.0f;
        for (int sub = 0; sub < 2; ++sub) {
            __syncthreads();
            scan_load<false>(p, sm, b, h, c * CH + sub * 64, wave);
            __syncthreads();
            if (real) scan_run<4, false, true>(sm, S, cs, rowbase); else scan_run<4, false, false>(sm, S, cs, rowbase);
        }
        float* dst = (real ? LST : PST) + ((size_t)((b * NCH + c) * 8 + h)) * 4096 + rowbase * 64 + 4 * cs;
#pragma unroll
        for (int j = 0; j < 4; ++j) *(f32x4*)(dst + j * 64) = (f32x4){S[j][0][0], S[j][0][1], S[j][1][0], S[j][1][1]};
    }
}
__device__ __forceinline__ float rowsum4(float part) {
    const f32x4 z = (f32x4){0.f, 0.f, 0.f, 0.f};
    const f32x4 d = __builtin_amdgcn_mfma_f32_16x16x4f32(1.0f, part, z, 0, 0, 0);
    return d[0];
}
struct ScanRaw { v4u kc, kq, vc, vq, rc, rq, av, gv; f32x4 d0, d1; };
__device__ __forceinline__ void scanL_params(float* parl, int hc, int c8) {
    const float* mix = inp(8); const float* k_k = inp(14); const float* k_a = inp(15); const float* r_k = inp(16); const float* ln_w = inp(17); const float* ln_b = inp(18);
    float* d = parl + c8;
    *(f32x4*)(d) = *(const f32x4*)(mix + hc); *(f32x4*)(d + 4) = *(const f32x4*)(mix + hc + 4);
    *(f32x4*)(d + 64) = *(const f32x4*)(mix + 512 + hc); *(f32x4*)(d + 68) = *(const f32x4*)(mix + 512 + hc + 4);
    *(f32x4*)(d + 128) = *(const f32x4*)(mix + 1024 + hc); *(f32x4*)(d + 132) = *(const f32x4*)(mix + 1024 + hc + 4);
    *(f32x4*)(d + 192) = *(const f32x4*)(k_k + hc); *(f32x4*)(d + 196) = *(const f32x4*)(k_k + hc + 4);
    *(f32x4*)(d + 256) = *(const f32x4*)(k_a + hc); *(f32x4*)(d + 260) = *(const f32x4*)(k_a + hc + 4);
    *(f32x4*)(d + 320) = *(const f32x4*)(r_k + hc); *(f32x4*)(d + 324) = *(const f32x4*)(r_k + hc + 4);
    *(f32x4*)(d + 384) = *(const f32x4*)(ln_w + hc); *(f32x4*)(d + 388) = *(const f32x4*)(ln_w + hc + 4);
    *(f32x4*)(d + 448) = *(const f32x4*)(ln_b + hc); *(f32x4*)(d + 452) = *(const f32x4*)(ln_b + hc + 4);
}
template <bool P3> __device__ __forceinline__ void scanL_issue(const Params& p, ScanRaw& w, int b, int hc, int tok) {
    const bf16* P = (const bf16*)(p.ws + WS_BIG); const float* DEC = (const float*)(p.ws + WS_DEC); const bf16* AA = (const bf16*)(p.ws + WS_AA); const bf16* GG = (const bf16*)(p.ws + WS_GG);
    const int gr = b * SEQ + tok; const bool hp = tok > 0;
    const bf16* prow = P + (size_t)gr * NIN + hc; const v4u z = (v4u){0u, 0u, 0u, 0u};
    w.kc = *(const v4u*)(prow + 512); w.kq = hp ? *(const v4u*)(prow + 512 - NIN) : z;
    w.vc = *(const v4u*)(prow + 1024); w.vq = hp ? *(const v4u*)(prow + 1024 - NIN) : z;
    if (P3) { w.rc = *(const v4u*)(prow); w.rq = hp ? *(const v4u*)(prow - NIN) : z; w.gv = *(const v4u*)(GG + (size_t)gr * RW + hc); }
    w.d0 = *(const f32x4*)(DEC + (size_t)gr * RW + hc); w.d1 = *(const f32x4*)(DEC + (size_t)gr * RW + hc + 4);
    w.av = *(const v4u*)(AA + (size_t)gr * RW + hc);
}
__device__ __forceinline__ void shift8(float (&dst)[8], const v4u& c_, const v4u& q_, const f32x4& m0_, const f32x4& m1_) {
#pragma unroll
    for (int e = 0; e < 4; ++e) { const float c0 = bflo(c_[e]), c1 = bfhi(c_[e]), q0 = bflo(q_[e]), q1 = bfhi(q_[e]); const float ma = (e < 2) ? m0_[2 * e] : m1_[2 * e - 4], mb = (e < 2) ? m0_[2 * e + 1] : m1_[2 * e - 3];
        dst[2 * e] = c0 + (q0 - c0) * ma; dst[2 * e + 1] = c1 + (q1 - c1) * mb; }
}
template <bool P3, int TS> __device__ __forceinline__ void scanL_store(const ScanRaw& w, const float* parl, float* su, float* bcl, int tt, int c8, bool bcw) {
    float r[8], k[8], v[8]; const float* pq = parl + c8;
    shift8(k, w.kc, w.kq, *(const f32x4*)(pq + 64), *(const f32x4*)(pq + 68)); shift8(v, w.vc, w.vq, *(const f32x4*)(pq + 128), *(const f32x4*)(pq + 132));
    if (P3) shift8(r, w.rc, w.rq, *(const f32x4*)(pq), *(const f32x4*)(pq + 4));
    const f32x4 qkk0 = *(const f32x4*)(pq + 192), qkk1 = *(const f32x4*)(pq + 196), qka0 = *(const f32x4*)(pq + 256), qka1 = *(const f32x4*)(pq + 260);
    float a[8], kk[8], kp[8], bb[8]; float ssq = 0.f;
#pragma unroll
    for (int e = 0; e < 4; ++e) { a[2 * e] = bflo(w.av[e]); a[2 * e + 1] = bfhi(w.av[e]); }
#pragma unroll
    for (int e = 0; e < 8; ++e) { const float kkw = (e < 4) ? qkk0[e] : qkk1[e - 4], kaw = (e < 4) ? qka0[e] : qka1[e - 4];
        kk[e] = k[e] * kkw; ssq += kk[e] * kk[e]; kp[e] = k[e] * (1.0f + (a[e] - 1.0f) * kaw); }
    ssq = sum8(ssq);
    const float inv = 1.0f / fmaxf(sqrtf(ssq), 1e-12f);
#pragma unroll
    for (int e = 0; e < 8; ++e) { kk[e] *= inv; bb[e] = kk[e] * a[e]; }
    constexpr int AS = TS * 64;
    float* base = su + tt * 64 + c8;
    *(f32x4*)(base + SC_W * AS) = w.d0; *(f32x4*)(base + SC_W * AS + 4) = w.d1;
    *(f32x4*)(base + SC_B * AS) = (f32x4){bb[0], bb[1], bb[2], bb[3]}; *(f32x4*)(base + SC_B * AS + 4) = (f32x4){bb[4], bb[5], bb[6], bb[7]};
    *(f32x4*)(base + SC_K * AS) = (f32x4){kp[0], kp[1], kp[2], kp[3]}; *(f32x4*)(base + SC_K * AS + 4) = (f32x4){kp[4], kp[5], kp[6], kp[7]};
    *(f32x4*)(base + SC_KK * AS) = (f32x4){kk[0], kk[1], kk[2], kk[3]}; *(f32x4*)(base + SC_KK * AS + 4) = (f32x4){kk[4], kk[5], kk[6], kk[7]};
    *(f32x4*)(base + SC_V * AS) = (f32x4){v[0], v[1], v[2], v[3]}; *(f32x4*)(base + SC_V * AS + 4) = (f32x4){v[4], v[5], v[6], v[7]};
    if (P3) {
        *(f32x4*)(base + SC_R * AS) = (f32x4){r[0], r[1], r[2], r[3]}; *(f32x4*)(base + SC_R * AS + 4) = (f32x4){r[4], r[5], r[6], r[7]};
        const f32x4 qrk0 = *(const f32x4*)(pq + 320), qrk1 = *(const f32x4*)(pq + 324); float bc = 0.f;
#pragma unroll
        for (int e = 0; e < 8; ++e) bc += r[e] * kp[e] * ((e < 4) ? qrk0[e] : qrk1[e - 4]);
        bc = sum8(bc);
        if (bcw) bcl[tt] = bc;
    }
}
#define LD16(dst, ptr) do { const f32x4 x0_ = *(const f32x4*)(ptr), x1_ = *(const f32x4*)((ptr) + 4), x2_ = *(const f32x4*)((ptr) + 8), x3_ = *(const f32x4*)((ptr) + 12); \
        dst[0] = LO2(x0_); dst[1] = HI2(x0_); dst[2] = LO2(x1_); dst[3] = HI2(x1_); dst[4] = LO2(x2_); dst[5] = HI2(x2_); dst[6] = LO2(x3_); dst[7] = HI2(x3_); } while (0)
template <int RPL, bool WITH_O, bool REAL, int TS> __device__ __forceinline__ void scanL_run(float* su, f32x2 (&S)[RPL][8], int r, int g, int rowbase) {
    constexpr int AS = TS * 64;
#pragma unroll 1
    for (int t = 0; t < TS; ++t) {
        const float* st = su + t * 64 + 16 * g;
        f32x2 w2[8], b2[8], kk2[8], k2[8], r2[8];
        LD16(kk2, st + SC_KK * AS); LD16(w2, st + SC_W * AS); LD16(b2, st + SC_B * AS);
        if (REAL) LD16(k2, st + SC_K * AS);
        if (WITH_O) LD16(r2, st + SC_R * AS);
        float vv[RPL];
#pragma unroll
        for (int j = 0; j < RPL; ++j) vv[j] = REAL ? su[SC_V * AS + t * 64 + rowbase + 16 * j + r] : 0.f;
#pragma unroll
        for (int j = 0; j < RPL; ++j) {
            f32x2 p0 = S[j][0] * kk2[0], p1 = S[j][1] * kk2[1];
#pragma unroll
            for (int i = 2; i < 8; i += 2) { p0 = S[j][i] * kk2[i] + p0; p1 = S[j][i + 1] * kk2[i + 1] + p1; }
            p0 += p1;
            const float nsa = -rowsum4(p0[0] + p0[1]);
            const f32x2 nsa2 = (f32x2){nsa, nsa}, v2 = (f32x2){vv[j], vv[j]};
            f32x2 q0 = (f32x2){0.f, 0.f}, q1 = q0;
#pragma unroll
            for (int i = 0; i < 8; ++i) { f32x2 tt_ = nsa2 * b2[i]; if (REAL) tt_ = v2 * k2[i] + tt_; S[j][i] = S[j][i] * w2[i] + tt_;
                if (WITH_O) { if (i & 1) q1 = S[j][i] * r2[i] + q1; else q0 = S[j][i] * r2[i] + q0; } }
            if (WITH_O) { q0 += q1; const float o = rowsum4(q0[0] + q0[1]); if (g == 0) su[SC_O * AS + t * 64 + rowbase + 16 * j + r] = o; }
        }
    }
}
__device__ __forceinline__ void scanL_pass1(const Params& p, float* sm, int wave) {
    constexpr int TS = 32, SLOT = 5 * TS * 64, NPAIR = BATCH * (NCH - 1) * 8 / 2;
    float* PST = (float*)(p.ws + WS_PST); float* LST = (float*)(p.ws + WS_LST);
    const int lane = lane_id(), tid = (wave << 6) | lane, r = lane & 15, g = lane >> 4, u2 = wave >> 2, wq = wave & 3; const bool real = wq < 2; const int rowbase = (wq & 1) * 32;
    float* su = sm + u2 * SLOT;
    const int ltt = (tid >> 3) & 31, lc8 = (tid & 7) * 8;
    for (int up = blockIdx.x; up < NPAIR; up += gridDim.x) {
        const int u = 2 * up + u2, h = u & 7, bc = u >> 3, c = bc % (NCH - 1), b = bc / (NCH - 1);
        f32x2 S[2][8];
#pragma unroll
        for (int j = 0; j < 2; ++j)
#pragma unroll
            for (int i = 0; i < 8; ++i) { const int row = rowbase + 16 * j + r, col = 16 * g + 2 * i; S[j][i] = (f32x2){(!real && row == col) ? 1.f : 0.f, (!real && row == col + 1) ? 1.f : 0.f}; }
        float* parl = sm + 2 * SLOT + u2 * 512;
        __syncthreads();
        if (ltt == 0) scanL_params(parl, h * 64 + lc8, lc8);
        ScanRaw raw; scanL_issue<false>(p, raw, b, h * 64 + lc8, c * CH + ltt);
        for (int sub = 0; sub < CH / TS; ++sub) {
            __syncthreads();
            scanL_store<false, TS>(raw, parl, su, nullptr, ltt, lc8, false);
            __syncthreads();
            if (sub + 1 < CH / TS) scanL_issue<false>(p, raw, b, h * 64 + lc8, c * CH + (sub + 1) * TS + ltt);
            if (real) scanL_run<2, false, true, TS>(su, S, r, g, rowbase); else scanL_run<2, false, false, TS>(su, S, r, g, rowbase);
        }
        float* dst = (real ? LST : PST) + ((size_t)((b * NCH + c) * 8 + h)) * 4096 + 16 * g;
#pragma unroll
        for (int j = 0; j < 2; ++j) { float* d = dst + (rowbase + 16 * j + r) * 64;
#pragma unroll
            for (int i = 0; i < 4; ++i) *(f32x4*)(d + 4 * i) = (f32x4){S[j][2 * i][0], S[j][2 * i][1], S[j][2 * i + 1][0], S[j][2 * i + 1][1]}; }
    }
}
__device__ __forceinline__ void scanL_pass3(const Params& p, float* sm, int wave) {
    constexpr int TS = 16, AS = TS * 64, SLOT = 7 * AS, NQ = BATCH * NCH * 8 / 4;
    const float* LST = (const float*)(p.ws + WS_LST); const bf16* GG = (const bf16*)(p.ws + WS_GG); bf16* MIX = (bf16*)(p.ws + WS_MIX);
    const float* ln_w = inp(17); const float* ln_b = inp(18);
    const int lane = lane_id(), tid = (wave << 6) | lane, r = lane & 15, g = lane >> 4, u4 = wave >> 1, rowbase = (wave & 1) * 32;
    float* su = sm + u4 * SLOT; float* bcl = sm + 4 * SLOT + u4 * TS;
    const int tt = (tid >> 3) & 15, c8 = (tid & 7) * 8;
    for (int uq = blockIdx.x; uq < NQ; uq += gridDim.x) {
        const int u = 4 * uq + u4, h = u & 7, bc = u >> 3, c = bc % NCH, b = bc / NCH, hc = h * 64 + c8;
        f32x2 S[2][8];
#pragma unroll
        for (int j = 0; j < 2; ++j) {
            if (c > 0) { const float* src = LST + ((size_t)((b * NCH + c - 1) * 8 + h)) * 4096 + (rowbase + 16 * j + r) * 64 + 16 * g;
#pragma unroll
                for (int i = 0; i < 4; ++i) { const f32x4 s4 = *(const f32x4*)(src + 4 * i); S[j][2 * i] = LO2(s4); S[j][2 * i + 1] = HI2(s4); } }
            else {
#pragma unroll
                for (int i = 0; i < 8; ++i) S[j][i] = (f32x2){0.f, 0.f}; } }
        float* parl = sm + 4 * SLOT + 64 + u4 * 512;
        __syncthreads();
        if (tt == 0) scanL_params(parl, hc, c8);
        ScanRaw raw; scanL_issue<true>(p, raw, b, hc, c * CH + tt);
        for (int sub = 0; sub < CH / TS; ++sub) {
            __syncthreads();
            scanL_store<true, TS>(raw, parl, su, bcl, tt, c8, (tid & 7) == 0);
            const v4u gv = raw.gv;
            __syncthreads();
            if (sub + 1 < CH / TS) scanL_issue<true>(p, raw, b, hc, c * CH + (sub + 1) * TS + tt);
            scanL_run<2, true, true, TS>(su, S, r, g, rowbase);
            __syncthreads();
            const int gr = b * SEQ + c * CH + sub * TS + tt;
            const f32x4 o0 = *(const f32x4*)(su + SC_O * AS + tt * 64 + c8), o1 = *(const f32x4*)(su + SC_O * AS + tt * 64 + c8 + 4);
            const f32x4 v0 = *(const f32x4*)(su + SC_V * AS + tt * 64 + c8), v1 = *(const f32x4*)(su + SC_V * AS + tt * 64 + c8 + 4);
            const float bcv = bcl[tt];
            float mu = ((o0[0] + o0[1]) + (o0[2] + o0[3])) + ((o1[0] + o1[1]) + (o1[2] + o1[3])); mu = sum8(mu) * (1.0f / 64.0f);
            const f32x4 e0 = o0 - mu, e1 = o1 - mu;
            float var = ((e0[0] * e0[0] + e0[1] * e0[1]) + (e0[2] * e0[2] + e0[3] * e0[3])) + ((e1[0] * e1[0] + e1[1] * e1[1]) + (e1[2] * e1[2] + e1[3] * e1[3])); var = sum8(var) * (1.0f / 64.0f);
            const float rs = 1.0f / sqrtf(var + 64e-5f);
            const f32x4 lw0 = *(const f32x4*)(parl + 384 + c8), lw1 = *(const f32x4*)(parl + 388 + c8), lb0 = *(const f32x4*)(parl + 448 + c8), lb1 = *(const f32x4*)(parl + 452 + c8);
            f32x4 y0 = (e0 * rs) * lw0 + lb0 + v0 * bcv, y1 = (e1 * rs) * lw1 + lb1 + v1 * bcv;
            y0[0] *= bflo(gv[0]); y0[1] *= bfhi(gv[0]); y0[2] *= bflo(gv[1]); y0[3] *= bfhi(gv[1]); y1[0] *= bflo(gv[2]); y1[1] *= bfhi(gv[2]); y1[2] *= bflo(gv[3]); y1[3] *= bfhi(gv[3]);
            v4u w; w.x = cvt_pk_bf16(y0[0], y0[1]); w.y = cvt_pk_bf16(y0[2], y0[3]); w.z = cvt_pk_bf16(y1[0], y1[1]); w.w = cvt_pk_bf16(y1[2], y1[3]);
            *(v4u*)(MIX + (size_t)gr * DM + hc) = w;
        }
    }
}

__device__ __forceinline__ void scan_pass2(const Params& p, float* sm, int wave) {
    const float* PST = (const float*)(p.ws + WS_PST); float* LST = (float*)(p.ws + WS_LST);
    const int lane = lane_id(), tid = (wave << 6) | lane, vb = (blockIdx.x & 7) * (gridDim.x >> 3) + (blockIdx.x >> 3);
    if (vb >= 128) return;
    const int chain = vb >> 3, row = (vb & 7) * 8 + wave, b = chain >> 3, h = chain & 7;
    float* Pb = sm; float* Sw = sm + 8192 + wave * 64;
    constexpr int NS = NCH - 1;
#define UOFF(c) ((size_t)((b * NCH + (c)) * 8 + h) * 4096)
#define LDP(X0, X1, LX, c) do { X0 = *(const f32x4*)(PST + UOFF(c) + tid * 8); X1 = *(const f32x4*)(PST + UOFF(c) + tid * 8 + 4); LX = LST[UOFF(c) + row * 64 + lane]; } while (0)
    f32x4 A0, A1, B0, B1, C0, C1; float LA = 0.f, LB = 0.f, LC = 0.f, Lcur;
    __syncthreads();
    LDP(A0, A1, LA, 0);
    *(f32x4*)(Pb + tid * 8) = A0; *(f32x4*)(Pb + tid * 8 + 4) = A1; Lcur = LA;
    Sw[lane] = 0.f;
    LDP(B0, B1, LB, 1); LDP(C0, C1, LC, 2); LDP(A0, A1, LA, 3);
    __syncthreads();
#define P2STEP(c, X0, X1, LX) do { float Lnx = 0.f; \
        if ((c) + 1 < NS) { float* Pn = Pb + (((c) + 1) & 1) * 4096; *(f32x4*)(Pn + tid * 8) = X0; *(f32x4*)(Pn + tid * 8 + 4) = X1; Lnx = LX; } \
        if ((c) + 4 < NS) LDP(X0, X1, LX, (c) + 4); \
        const float* Pc = Pb + ((c) & 1) * 4096 + lane; float a0 = 0.f, a1 = 0.f, a2 = 0.f, a3 = 0.f; \
        _Pragma("unroll") for (int i = 0; i < 64; i += 4) { const f32x4 s4 = *(const f32x4*)(Sw + i); \
            a0 += s4[0] * Pc[(i + 0) * 64]; a1 += s4[1] * Pc[(i + 1) * 64]; a2 += s4[2] * Pc[(i + 2) * 64]; a3 += s4[3] * Pc[(i + 3) * 64]; } \
        const float sn = ((a0 + a1) + (a2 + a3)) + Lcur; LST[UOFF(c) + row * 64 + lane] = sn; Sw[lane] = sn; Lcur = Lnx; \
        __syncthreads(); } while (0)
    for (int c = 0; c < NS; c += 3) { P2STEP(c, B0, B1, LB); P2STEP(c + 1, C0, C1, LC); P2STEP(c + 2, A0, A1, LA); }
    static_assert(NS % 3 == 0, "pass 2 is unrolled by 3");
#undef P2STEP
#undef LDP
#undef UOFF
}
__device__ __forceinline__ void scan_pass3(const Params& p, float* sm, int wave, int lane) {
    const float* LST = (const float*)(p.ws + WS_LST); const bf16* GG = (const bf16*)(p.ws + WS_GG); bf16* MIX = (bf16*)(p.ws + WS_MIX);
    const float* ln_w = inp(17); const float* ln_b = inp(18);
    const int tid = TIDX, cs = lane & 15, rg = lane >> 4, rowbase = wave * 8 + rg * 2;
    constexpr int NU = BATCH * NCH * 8;
    for (int u = blockIdx.x; u < NU; u += gridDim.x) {
        const int h = u & 7, bc = u >> 3, c = bc % NCH, b = bc / NCH;
        f32x2 S[2][2];
        if (c > 0) { const float* src = LST + ((size_t)((b * NCH + c - 1) * 8 + h)) * 4096 + rowbase * 64 + 4 * cs;
#pragma unroll
            for (int j = 0; j < 2; ++j) { const f32x4 s4 = *(const f32x4*)(src + j * 64); S[j][0] = LO2(s4); S[j][1] = HI2(s4); } }
        else {
#pragma unroll
            for (int j = 0; j < 2; ++j) { S[j][0] = (f32x2){0.f, 0.f}; S[j][1] = (f32x2){0.f, 0.f}; } }
        for (int sub = 0; sub < 2; ++sub) {
            __syncthreads();
            scan_load<true>(p, sm, b, h, c * CH + sub * 64, wave);
            __syncthreads();
            scan_run<2, true, true>(sm, S, cs, rowbase);
            __syncthreads();
            const int tt = tid >> 3, c8 = (tid & 7) * 8, hc = h * 64 + c8; const int gr = b * SEQ + c * CH + sub * 64 + tt;
            const f32x4 o0 = *(const f32x4*)(sm + SC_O * 4096 + tt * 64 + c8), o1 = *(const f32x4*)(sm + SC_O * 4096 + tt * 64 + c8 + 4);
            const f32x4 v0 = *(const f32x4*)(sm + SC_V * 4096 + tt * 64 + c8), v1 = *(const f32x4*)(sm + SC_V * 4096 + tt * 64 + c8 + 4);
            const float bcv = sm[SC_BC * 4096 + tt];
            float mu = ((o0[0] + o0[1]) + (o0[2] + o0[3])) + ((o1[0] + o1[1]) + (o1[2] + o1[3])); mu = sum8(mu) * (1.0f / 64.0f);
            const f32x4 e0 = o0 - mu, e1 = o1 - mu;
            float var = ((e0[0] * e0[0] + e0[1] * e0[1]) + (e0[2] * e0[2] + e0[3] * e0[3])) + ((e1[0] * e1[0] + e1[1] * e1[1]) + (e1[2] * e1[2] + e1[3] * e1[3])); var = sum8(var) * (1.0f / 64.0f);
            const float rs = 1.0f / sqrtf(var + 64e-5f);
            const f32x4 lw0 = *(const f32x4*)(ln_w + hc), lw1 = *(const f32x4*)(ln_w + hc + 4), lb0 = *(const f32x4*)(ln_b + hc), lb1 = *(const f32x4*)(ln_b + hc + 4);
            const v4u gv = *(const v4u*)(GG + (size_t)gr * RW + hc);
            f32x4 y0 = (e0 * rs) * lw0 + lb0 + v0 * bcv, y1 = (e1 * rs) * lw1 + lb1 + v1 * bcv;
            y0[0] *= bflo(gv[0]); y0[1] *= bfhi(gv[0]); y0[2] *= bflo(gv[1]); y0[3] *= bfhi(gv[1]); y1[0] *= bflo(gv[2]); y1[1] *= bfhi(gv[2]); y1[2] *= bflo(gv[3]); y1[3] *= bfhi(gv[3]);
            v4u w; w.x = cvt_pk_bf16(y0[0], y0[1]); w.y = cvt_pk_bf16(y0[2], y0[3]); w.z = cvt_pk_bf16(y1[0], y1[1]); w.w = cvt_pk_bf16(y1[2], y1[3]);
            *(v4u*)(MIX + (size_t)gr * DM + hc) = w;
        }
    }
}

constexpr int AT_KS = 0, AT_VT = 256 * 72 * 2, AT_PS = AT_VT + 64 * 280 * 2, AT_PSW = 16 * 168 * 2;
__device__ __forceinline__ void attn_phase(const Params& p, unsigned char* lds, int wave, int lane) {
    const bf16* P = (const bf16*)(p.ws + WS_BIG); bf16* MIX = (bf16*)(p.ws + WS_MIX); const float* sinks = inp(19);
    const int tid = TIDX; bf16* Ks = (bf16*)(lds + AT_KS); bf16* Vt = (bf16*)(lds + AT_VT); bf16* Ps = (bf16*)(lds + AT_PS + wave * AT_PSW);
    const int fr = lane & 15, fq = lane >> 4;
    const int vb_ = (blockIdx.x & 7) * (gridDim.x >> 3) + (blockIdx.x >> 3);
    for (int u = vb_ - 128; u >= 0 && u < BATCH * 64 * 2; u += 128) {
        const int g = u & 1, qb = (u >> 1) & 63, b = u >> 7, q0 = qb * 128;
        __syncthreads();
        { const int key = tid >> 1, half = tid & 1; const bool valid = (qb > 0) || (key >= 128);
          const bf16* src = P + (size_t)(b * SEQ + q0 - 128 + key) * NIN + 1792 + 512 + g * 64 + half * 32;
#pragma unroll
          for (int i = 0; i < 4; ++i) { v4u kx = (v4u){0u, 0u, 0u, 0u}, vx = kx; if (valid) { kx = *(const v4u*)(src + 8 * i); vx = *(const v4u*)(src + 128 + 8 * i); }
              *(v4u*)(Ks + key * 72 + half * 32 + 8 * i) = kx;
#pragma unroll
              for (int e = 0; e < 4; ++e) { const int d = half * 32 + 8 * i + 2 * e; Vt[d * 280 + key] = (bf16)(vx[e] & 0xffffu); Vt[(d + 1) * 280 + key] = (bf16)(vx[e] >> 16); } }
          if (tid < 64 * 3) { const int d = tid / 3, part = tid % 3; *(v4u*)(Vt + d * 280 + 256 + 8 * part) = (v4u){0u, 0u, 0u, 0u}; } }
        __syncthreads();
        for (int hq4 = 0; hq4 < 4; ++hq4) {
            const int hq = g * 4 + hq4; const float sink = sinks[hq];
            const bf16* qp = P + (size_t)(b * SEQ + q0 + 16 * wave + fr) * NIN + 1792 + hq * 64 + 8 * fq;
            const bf16x8 qa0 = *(const bf16x8*)qp, qa1 = *(const bf16x8*)(qp + 32);
            f32x4 sc[9]; float mx[4] = {-1e30f, -1e30f, -1e30f, -1e30f};
#pragma unroll
            for (int nt = 0; nt < 9; ++nt) { const int jt = 16 * (wave + nt); const bf16* kp = Ks + (jt + fr) * 72 + 8 * fq;
                const bf16x8 kb0 = *(const bf16x8*)kp, kb1 = *(const bf16x8*)(kp + 32);
                f32x4 a = (f32x4){0.f, 0.f, 0.f, 0.f}; a = __builtin_amdgcn_mfma_f32_16x16x32_bf16(qa0, kb0, a, 0, 0, 0); a = __builtin_amdgcn_mfma_f32_16x16x32_bf16(qa1, kb1, a, 0, 0, 0);
                const int j = jt + fr;
#pragma unroll
                for (int r = 0; r < 4; ++r) { const int i = 16 * wave + 4 * fq + r, dist = i + 128 - j; const bool ok = (dist >= 0) && (dist < 128) && ((qb > 0) || (j >= 128));
                    a[r] = ok ? a[r] * 0.125f : -1e30f; mx[r] = fmaxf(mx[r], a[r]); }
                sc[nt] = a; }
            float sm_[4];
#pragma unroll
            for (int r = 0; r < 4; ++r) { mx[r] = fmaxf(max16(mx[r]), sink); sm_[r] = 0.f; }
#pragma unroll
            for (int nt = 0; nt < 9; ++nt) {
#pragma unroll
                for (int r = 0; r < 4; ++r) { const float e = __expf(sc[nt][r] - mx[r]); sm_[r] += e; Ps[(4 * fq + r) * 168 + nt * 16 + fr] = (bf16)(cvt_pk_bf16(e, 0.f) & 0xffffu); } }
#pragma unroll
            for (int r = 0; r < 4; ++r) { Ps[(4 * fq + r) * 168 + 144 + fr] = 0; sm_[r] = 1.0f / (sum16(sm_[r]) + __expf(sink - mx[r])); }
            __builtin_amdgcn_fence(__ATOMIC_RELEASE, "wavefront"); asm volatile("s_waitcnt lgkmcnt(0)" ::: "memory");
            f32x4 o[4];
#pragma unroll
            for (int dt = 0; dt < 4; ++dt) o[dt] = (f32x4){0.f, 0.f, 0.f, 0.f};
#pragma unroll
            for (int ks = 0; ks < 5; ++ks) { const bf16x8 pa = *(const bf16x8*)(Ps + fr * 168 + ks * 32 + 8 * fq);
#pragma unroll
                for (int dt = 0; dt < 4; ++dt) { const bf16x8 vb = *(const bf16x8*)(Vt + (dt * 16 + fr) * 280 + 16 * wave + ks * 32 + 8 * fq);
                    o[dt] = __builtin_amdgcn_mfma_f32_16x16x32_bf16(pa, vb, o[dt], 0, 0, 0); } }
            bf16* op = MIX + (size_t)(b * SEQ + q0 + 16 * wave + 4 * fq) * DM + 512 + hq * 64 + fr;
#pragma unroll
            for (int r = 0; r < 4; ++r)
#pragma unroll
                for (int dt = 0; dt < 4; ++dt) op[(size_t)r * DM + dt * 16] = (bf16)(cvt_pk_bf16(o[dt][r] * sm_[r], 0.f) & 0xffffu);
            asm volatile("s_waitcnt lgkmcnt(0)" ::: "memory");
        }
    }
}

__device__ __forceinline__ void final_norm(const Params& p, int wave, int lane) {
    const float* ss3 = (const float*)(p.ws + WS_SS) + (size_t)3 * M * 16; const float* gf = inp(25);
    const int gw = blockIdx.x * NWAVES + wave, NGW = gridDim.x * NWAVES;
    f32x4 gfv[4];
#pragma unroll
    for (int j = 0; j < 4; ++j) gfv[j] = ((const f32x4*)gf)[lane + 64 * j];
    for (int m = gw; m < M; m += NGW) { const float rs = pg8::row_rstd(ss3, m); f32x4* xr = (f32x4*)(p.out + (size_t)m * DM) + lane;
#pragma unroll
        for (int j = 0; j < 4; ++j) { const f32x4 v = xr[64 * j]; xr[64 * j] = v * rs * gfv[j]; } }
}


#define XB_TMO      128
#define XB_XCNT(j)  (256  + 64 * (j))
#define XB_XSUB(j)  (1280 + 64 * (j))
#define XB_XGEN(j)  (2304 + 64 * (j))
#define XB_TOP      3328
#define XB_TOPGEN   3392
#define XCD_BAR_WORDS 3456
#define XB_SPIN_CAP (1u << 18)

__device__ __forceinline__ unsigned xb_ld(unsigned* p)              { return __hip_atomic_load(p, __ATOMIC_RELAXED, __HIP_MEMORY_SCOPE_AGENT); }
__device__ __forceinline__ unsigned xb_add(unsigned* p, unsigned v) { return __hip_atomic_fetch_add(p, v, __ATOMIC_RELAXED, __HIP_MEMORY_SCOPE_AGENT); }
__device__ __forceinline__ unsigned xb_xcc_id() { return (unsigned)__builtin_amdgcn_s_getreg((3 << 11) | 20) & 0xFu; }
#define XB_SPIN(cond, bar) do { unsigned _sp = 0; while (cond) { __builtin_amdgcn_s_sleep(1); \
    if ((++_sp & 255u) == 0u) { if (xb_ld(&(bar)[XB_TMO])) break; if (_sp > XB_SPIN_CAP) { atomicAdd(&(bar)[XB_TMO], 1u); break; } } } } while (0)

struct XcdBarrier {
    unsigned* bar; unsigned x;
    volatile LAS unsigned* st; int wave;
};

__device__ __forceinline__ XcdBarrier xcd_barrier_post(unsigned* bar, volatile LAS unsigned* st, int wave) {
    XcdBarrier b; b.bar = bar; b.x = xb_xcc_id(); b.st = st; b.wave = wave;
    if (wave == 0 && lane_id() == 0) (void)xb_add(&bar[XB_XCNT(b.x)], 1u);
    return b;
}
__device__ __forceinline__ void xcd_barrier_complete(unsigned* bar, unsigned x, unsigned& nloc, unsigned& nx) {
    const unsigned G = gridDim.x * gridDim.y * gridDim.z;
    unsigned sum, cnt, mine, sp = 0u;
    for (;;) {
        sum = 0u; cnt = 0u; mine = 0u;
#pragma unroll
        for (unsigned j = 0; j < 16; ++j) { const unsigned c = xb_ld(&bar[XB_XCNT(j)]); sum += c; cnt += (c > 0u) ? 1u : 0u; mine = (j == x) ? c : mine; }
        if (sum == G) break;
        __builtin_amdgcn_s_sleep(1);
        if ((++sp & 255u) == 0u) { if (xb_ld(&bar[XB_TMO])) break; if (sp > XB_SPIN_CAP) { atomicAdd(&bar[XB_TMO], 1u); break; } }
    }
    nloc = mine > 0u ? mine : 1u; nx = cnt > 0u ? cnt : 1u;
}

__device__ __forceinline__ void xcd_barrier(const XcdBarrier& b) {
    asm volatile("s_waitcnt vmcnt(0)" ::: "memory");
    __syncthreads();
    if (b.wave == 0 && lane_id() == 0) {
        unsigned* bar = b.bar;
        __builtin_amdgcn_s_waitcnt(0);
        unsigned nloc = b.st[0], nx = b.st[1];
        if (nloc == 0u) { xcd_barrier_complete(bar, b.x, nloc, nx); b.st[0] = nloc; b.st[1] = nx; }
        const unsigned old = xb_add(&bar[XB_XSUB(b.x)], 1u);
        const unsigned gen = old / nloc;
        if (old + 1u == (gen + 1u) * nloc) {
            __builtin_amdgcn_fence(__ATOMIC_RELEASE, "agent");
            asm volatile("s_waitcnt vmcnt(0)" ::: "memory");
            const unsigned og = xb_add(&bar[XB_TOP], 1u);
            const unsigned tg = og / nx;
            if (og + 1u == (tg + 1u) * nx) xb_add(&bar[XB_TOPGEN], 1u);
            else XB_SPIN(xb_ld(&bar[XB_TOPGEN]) == tg, bar);
            __builtin_amdgcn_fence(__ATOMIC_ACQUIRE, "agent");
            xb_add(&bar[XB_XGEN(b.x)], 1u);
            asm volatile("s_waitcnt vmcnt(0)" ::: "memory");
        } else {
            XB_SPIN(xb_ld(&bar[XB_XGEN(b.x)]) == gen, bar);
            __builtin_amdgcn_fence(__ATOMIC_ACQUIRE, "agent");
            asm volatile("s_waitcnt vmcnt(0)" ::: "memory");
        }
    }
    __syncthreads();
}

constexpr int LDS_BYTES = 147456;
constexpr int NPHASE = 12;
#ifndef DUPMASK
#define DUPMASK 0
#endif
__global__ void __launch_bounds__(NTHR, 2) hymba_fwd(Params p) {
    extern __shared__ __attribute__((aligned(16))) unsigned char lds[];
    cg::grid_group grid = cg::this_grid();
    const int wave = __builtin_amdgcn_readfirstlane((int)threadIdx.x >> 6); const int lane = lane_id(); const int tid = (wave << 6) | lane;
    unsigned char* ws = p.ws;
    PG8_LAS unsigned char* lds3 = (PG8_LAS unsigned char*)lds;
    float* ss = (float*)(ws + WS_SS);
    bf16* XB = (bf16*)(ws + WS_XB); bf16* ACT = (bf16*)(ws + WS_BIG); bf16* PB = (bf16*)(ws + WS_BIG);
    const int lo = p.ph_lo, hi = p.ph_hi;
#define IN(k) (lo <= (k) && (k) < hi)
#define REP(k) for (int rep_ = 0; rep_ < 1 + ((DUPMASK >> (k)) & 1); ++rep_)
#ifndef DUPBAR
#define DUPBAR 0
#endif
#define SEAM(k) do { if (IN(k) && IN((k) + 1)) { for (int rb_ = 0; rb_ <= DUPBAR; ++rb_) xcd_barrier(xbar); } } while (0)
    unsigned* bctr = (unsigned*)(ws + WS_CTL);
    volatile LAS unsigned* misc = (volatile LAS unsigned*)(lds3 + 131072 + 1024);
    if (wave == 0 && lane < 2) misc[lane] = 0u;
    if (blockIdx.x == 0) for (int i = tid; i < XCD_BAR_WORDS; i += NTHR) __hip_atomic_store(bctr + i, 0u, __ATOMIC_RELAXED, __HIP_MEMORY_SCOPE_AGENT);
    if (IN(0)) REP(0) { p0_prologue(p, lds, wave, lane_id()); }
    grid.sync();
    XcdBarrier xbar = xcd_barrier_post(bctr, misc, wave);
    if (IN(1)) REP(1) { pg8::Gemm g{XB, (const bf16*)(ws + WS_WGU1), M, 2 * FF, DM}; pg8::StaticOrder S; S.init(M, 2 * FF, gridDim.x, blockIdx.x);
        pg8::EpiSwiGLU E{ACT, ss, FF}; pg8::gemm_phase<pg8::EpiSwiGLU, pg8::StaticOrder, true, true>(lds3, g, S, E, wave); } SEAM(1);
    if (IN(2)) REP(2) { pg8::Gemm g{ACT, (const bf16*)(ws + WS_WD1), M, DM, FF}; pg8::StaticOrder S; S.init(M, DM, gridDim.x, blockIdx.x);
        pg8::EpiRes E{inp(0), p.out, XB, ss + (size_t)M * 16, 0.5f}; pg8::gemm_phase<pg8::EpiRes, pg8::StaticOrder, true, true>(lds3, g, S, E, wave); } SEAM(2);
    if (IN(3)) REP(3) { pg8::Gemm g{XB, (const bf16*)(ws + WS_WIN), M, NIN, DM}; pg8::StaticOrder S; S.init(M, NIN, gridDim.x, blockIdx.x);
        pg8::EpiWin E{PB, ss + (size_t)M * 16, inp(7), 1792, NIN}; pg8::gemm_phase<pg8::EpiWin, pg8::StaticOrder, true, true>(lds3, g, S, E, wave); } SEAM(3);
    if (IN(4)) REP(4) { r1_phase(p, wave); } SEAM(4);
    if (IN(5)) REP(5) { pg8::Gemm g{(const bf16*)(ws + WS_LIN), (const bf16*)(ws + WS_WL), M, 1536, 256}; pg8::StaticOrder S; S.init(M, 1536, gridDim.x, blockIdx.x);
        pg8::EpiLora E{(float*)(ws + WS_DEC), (bf16*)(ws + WS_AA), (bf16*)(ws + WS_GG), inp(9), inp(11)}; pg8::gemm_phase<pg8::EpiLora, pg8::StaticOrder, true, true>(lds3, g, S, E, wave); } SEAM(5);
    if (IN(6)) REP(6) { scanL_pass1(p, (float*)lds, wave); } SEAM(6);
    if (IN(7)) REP(7) { scan_pass2(p, (float*)lds, wave); attn_phase(p, lds, wave, lane_id()); } SEAM(7);
    if (IN(8)) REP(8) { scanL_pass3(p, (float*)lds, wave); __syncthreads(); } SEAM(8);
    if (IN(9)) REP(9) { pg8::Gemm g{(const bf16*)(ws + WS_MIX), (const bf16*)(ws + WS_WOUT), M, DM, DM}; pg8::StaticOrder S; S.init(M, DM, gridDim.x, blockIdx.x);
        pg8::EpiRes E{p.out, p.out, XB, ss + (size_t)2 * M * 16, 1.0f}; pg8::gemm_phase<pg8::EpiRes, pg8::StaticOrder, true, true>(lds3, g, S, E, wave); } SEAM(9);
    if (IN(10)) REP(10) { pg8::Gemm g{XB, (const bf16*)(ws + WS_WGU2), M, 2 * FF, DM}; pg8::StaticOrder S; S.init(M, 2 * FF, gridDim.x, blockIdx.x);
        pg8::EpiSwiGLU E{ACT, ss + (size_t)2 * M * 16, FF}; pg8::gemm_phase<pg8::EpiSwiGLU, pg8::StaticOrder, true, true>(lds3, g, S, E, wave); } SEAM(10);
    if (IN(11)) REP(11) { pg8::Gemm g{ACT, (const bf16*)(ws + WS_WD2), M, DM, FF}; pg8::StaticOrder S; S.init(M, DM, gridDim.x, blockIdx.x);
        pg8::EpiRes E{p.out, p.out, nullptr, ss + (size_t)3 * M * 16, 0.5f}; pg8::gemm_phase<pg8::EpiRes, pg8::StaticOrder, true, true>(lds3, g, S, E, wave); } SEAM(11);
    if (IN(12)) REP(12) { final_norm(p, wave, lane_id()); }
#undef IN
#undef SEAM
}

extern "C" void kernel_launch(void* const* d_in, const int* in_sizes, int n_in, void* d_out, int out_size, void* d_ws, size_t ws_size, hipStream_t stream) {
    static int grid = 0;
    if (grid == 0) {
        if (n_in != 26 || out_size != M * DM || ws_size < WS_END) { fprintf(stderr, "kernel_launch: unexpected sizes n_in %d out %d ws %zu\n", n_in, out_size, ws_size); grid = -1; return; }
        int dev = 0, cus = 0, per_cu = 0;
        hipGetDevice(&dev); hipDeviceGetAttribute(&cus, hipDeviceAttributeMultiprocessorCount, dev);
        hipFuncSetAttribute((const void*)hymba_fwd, hipFuncAttributeMaxDynamicSharedMemorySize, LDS_BYTES);
        hipOccupancyMaxActiveBlocksPerMultiprocessor(&per_cu, (const void*)hymba_fwd, NTHR, LDS_BYTES);
        (void)hipGetLastError();
        if (per_cu < 1) per_cu = 1;
        grid = cus * per_cu; if (grid > 256) grid = 256;
        if (grid != 256) fprintf(stderr, "kernel_launch: grid %d (cus %d per_cu %d), kernel assumes 256\n", grid, cus, per_cu);
    }
    if (grid < 0) return;
    Params p{};
    for (int i = 0; i < 26; ++i) p.in[i] = (const float*)d_in[i];
    p.out = (float*)d_out; p.ws = (unsigned char*)d_ws; p.ph_lo = 0; p.ph_hi = NPHASE + 1;
    void* args[] = {&p};
    hipError_t e = hipLaunchCooperativeKernel((const void*)hymba_fwd, dim3(grid), dim3(NTHR), args, LDS_BYTES, stream);
    if (e != hipSuccess) fprintf(stderr, "cooperative launch failed: %s (grid %d)\n", hipGetErrorString(e), grid);
}
```

```cpp
#include <hip/hip_runtime.h>
#include <hip/hip_cooperative_groups.h>
#include <cstdio>
#include <cstdint>
namespace cg = cooperative_groups;
namespace pg8 {
#define PG8_LAS __attribute__((address_space(3)))
typedef unsigned short bf16_t;
typedef short bf16x8 __attribute__((ext_vector_type(8)));
typedef float f32x4 __attribute__((ext_vector_type(4)));
typedef unsigned u32x4 __attribute__((ext_vector_type(4)));
constexpr int BM = 256, BK = 64, HALF = 128, HTB = HALF * BK * 2  , STAGE_BYTES = 8 * HTB, NXCD = 8, WGM = 8;

__host__ __device__ __forceinline__ int lds_byte(int r, int c) { const int st = (r >> 4) * 2 + (c >> 5), rr = r & 15, cc = c & 31, ob = rr * 64 + cc * 2; return st * 1024 + (ob ^ (((ob >> 9) & 1) << 5)); }
__host__ __device__ __forceinline__ void stage_rc(int b, int& R, int& C) { const int st = b / 1024, sb = b % 1024, swz = sb ^ (((sb >> 9) & 1) << 5); R = (st >> 1) * 16 + swz / 64; C = (st & 1) * 32 + (swz % 64) / 2; }
__host__ __device__ __forceinline__ int perm32(int rho) { const int n = rho >> 4, i = rho & 15; return 8 * (i >> 2) + 4 * n + (i & 3); }

struct Unit { int pm, pn; };
struct Gemm { const bf16_t* A; const bf16_t* Bt; int M, N, K; };

struct StaticOrder {
    int nM, nN, nwg, G, c;
    __host__ __device__ void init(int M, int N, int G_, int c_) { nM = M / BM; nN = N / BM; nwg = nM * nN; G = G_; c = c_; }
    __host__ __device__ bool next(int i, Unit& u) const {
        const long L = (long)i * G + c; if (L >= nwg) return false;
        int wgid = (int)L; { const int q = nwg / NXCD, r = nwg % NXCD, xcd = wgid % NXCD, off = wgid / NXCD; wgid = (xcd < r ? xcd * (q + 1) : r * (q + 1) + (xcd - r) * q) + off; }
        const int nig = WGM * nN, gid = wgid / nig, fm = gid * WGM, gsz = (nM - fm) < WGM ? (nM - fm) : WGM;
        u.pm = fm + ((wgid % nig) % gsz); u.pn = (wgid % nig) / gsz; return true;
    }
    __device__ __forceinline__ void a_ready(const Unit&) const {}
    __device__ __forceinline__ void done(const Unit&) const {}
};

typedef float f32x2 __attribute__((ext_vector_type(2)));
typedef __bf16 bf16x2_t __attribute__((ext_vector_type(2)));
typedef unsigned u32x2 __attribute__((ext_vector_type(2)));
__device__ __forceinline__ unsigned cvt_pk_bf16(float lo, float hi) { f32x2 v = {lo, hi}; bf16x2_t b = __builtin_convertvector(v, bf16x2_t); return __builtin_bit_cast(unsigned, b); }
__device__ __forceinline__ float row_rstd(const float* ss, int row) {
    const f32x4* p = (const f32x4*)(ss + (size_t)row * 16); const f32x4 a = p[0], b = p[1], c = p[2], d = p[3];
    const float s = (((a[0] + a[1]) + (a[2] + a[3])) + ((b[0] + b[1]) + (b[2] + b[3]))) + (((c[0] + c[1]) + (c[2] + c[3])) + ((d[0] + d[1]) + (d[2] + d[3])));
    return 1.0f / sqrtf(s * (1.0f / 1024.0f) + 1e-5f);
}
__device__ __forceinline__ float silu_mul(float g, float u) { return g * __builtin_amdgcn_rcpf(1.0f + __expf(-g)) * u; }

struct EpiSwiGLU {
    static constexpr bool PERM = true, AFTER_DRAIN = false;
    bf16_t* O; const float* ss; int ldo;
    __device__ __forceinline__ void operator()(const f32x4 (&acc)[2][2][4][2], const Unit& u, int wr, int wc, int fr, int fq) const {
        const int row0 = u.pm * BM + wr * 64 + fr; const int col0 = u.pn * HALF + wc * 32 + 8 * fq;
#pragma unroll
        for (int ai = 0; ai < 2; ++ai)
#pragma unroll
            for (int m = 0; m < 4; ++m) { const int row = row0 + ai * HALF + m * 16; const float rs = row_rstd(ss, row);
                const f32x4 g0 = acc[ai][0][m][0] * rs, g1 = acc[ai][0][m][1] * rs, u0 = acc[ai][1][m][0] * rs, u1 = acc[ai][1][m][1] * rs;
                u32x4 w; w.x = cvt_pk_bf16(silu_mul(g0[0], u0[0]), silu_mul(g0[1], u0[1])); w.y = cvt_pk_bf16(silu_mul(g0[2], u0[2]), silu_mul(g0[3], u0[3]));
                w.z = cvt_pk_bf16(silu_mul(g1[0], u1[0]), silu_mul(g1[1], u1[1])); w.w = cvt_pk_bf16(silu_mul(g1[2], u1[2]), silu_mul(g1[3], u1[3]));
                *(u32x4*)(O + (size_t)row * ldo + col0) = w; }
    }
};
struct EpiRes {
    static constexpr bool PERM = false, AFTER_DRAIN = false;
    const float* base; float* out; bf16_t* xb; float* ss; float alpha;
    __device__ __forceinline__ void operator()(const f32x4 (&acc)[2][2][4][2], const Unit& u, int wr, int wc, int fr, int fq) const {
        const int row0 = u.pm * BM + wr * 64 + fr; const int col0 = u.pn * BM + wc * 32 + 4 * fq;
#pragma unroll
        for (int ai = 0; ai < 2; ++ai)
#pragma unroll
            for (int m = 0; m < 4; ++m) { const int row = row0 + ai * HALF + m * 16; const size_t off = (size_t)row * 1024 + col0; float sq = 0.f;
#pragma unroll
                for (int bj = 0; bj < 2; ++bj)
#pragma unroll
                    for (int n = 0; n < 2; ++n) { const f32x4 bs = *(const f32x4*)(base + off + bj * HALF + n * 16); const f32x4 o = bs + acc[ai][bj][m][n] * alpha;
                        *(f32x4*)(out + off + bj * HALF + n * 16) = o; sq += (o[0] * o[0] + o[1] * o[1]) + (o[2] * o[2] + o[3] * o[3]);
                        if (xb) { u32x2 w; w.x = cvt_pk_bf16(o[0], o[1]); w.y = cvt_pk_bf16(o[2], o[3]); *(u32x2*)(xb + off + bj * HALF + n * 16) = w; } }
                sq += __shfl_xor(sq, 16); sq += __shfl_xor(sq, 32);
                if (fq == 0) ss[(size_t)row * 16 + u.pn * 4 + wc] = sq; }
    }
};
struct EpiWin {
    static constexpr bool PERM = true, AFTER_DRAIN = false;
    bf16_t* O; const float* ss; const float* bias; int bias_from; int ldo;
    __device__ __forceinline__ void operator()(const f32x4 (&acc)[2][2][4][2], const Unit& u, int wr, int wc, int fr, int fq) const {
        const int row0 = u.pm * BM + wr * 64 + fr; const int col0 = u.pn * BM + wc * 32 + 8 * fq;
        f32x4 bv[2][2];
#pragma unroll
        for (int bj = 0; bj < 2; ++bj)
#pragma unroll
            for (int n = 0; n < 2; ++n) { const int c = col0 + bj * HALF + 4 * n; bv[bj][n] = (c >= bias_from) ? *(const f32x4*)(bias + (c - bias_from)) : (f32x4){0.f, 0.f, 0.f, 0.f}; }
#pragma unroll
        for (int ai = 0; ai < 2; ++ai)
#pragma unroll
            for (int m = 0; m < 4; ++m) { const int row = row0 + ai * HALF + m * 16; const float rs = row_rstd(ss, row);
#pragma unroll
                for (int bj = 0; bj < 2; ++bj) { const f32x4 v0 = acc[ai][bj][m][0] * rs + bv[bj][0], v1 = acc[ai][bj][m][1] * rs + bv[bj][1];
                    u32x4 w; w.x = cvt_pk_bf16(v0[0], v0[1]); w.y = cvt_pk_bf16(v0[2], v0[3]); w.z = cvt_pk_bf16(v1[0], v1[1]); w.w = cvt_pk_bf16(v1[2], v1[3]);
                    *(u32x4*)(O + (size_t)row * ldo + col0 + bj * HALF) = w; } }
    }
};
struct EpiLora {
    static constexpr bool PERM = true, AFTER_DRAIN = false;
    float* DEC; bf16_t* AA; bf16_t* GG; const float* w0; const float* a0;
    __device__ __forceinline__ void operator()(const f32x4 (&acc)[2][2][4][2], const Unit& u, int wr, int wc, int fr, int fq) const {
        const int row0 = u.pm * BM + wr * 64 + fr; const int kind = u.pn >> 1; const int col0 = (u.pn & 1) * BM + wc * 32 + 8 * fq;
#pragma unroll
        for (int bj = 0; bj < 2; ++bj) { const int c = col0 + bj * HALF;
            f32x4 b0 = (f32x4){0.f, 0.f, 0.f, 0.f}, b1 = b0;
            if (kind == 0) { b0 = *(const f32x4*)(w0 + c); b1 = *(const f32x4*)(w0 + c + 4); } else if (kind == 1) { b0 = *(const f32x4*)(a0 + c); b1 = *(const f32x4*)(a0 + c + 4); }
#pragma unroll
            for (int ai = 0; ai < 2; ++ai)
#pragma unroll
                for (int m = 0; m < 4; ++m) { const int row = row0 + ai * HALF + m * 16; f32x4 v0 = acc[ai][bj][m][0] + b0, v1 = acc[ai][bj][m][1] + b1;
                    if (kind == 0) {
#pragma unroll
                        for (int e = 0; e < 4; ++e) { v0[e] = expf(-0.60653065971f / (1.0f + expf(-v0[e]))); v1[e] = expf(-0.60653065971f / (1.0f + expf(-v1[e]))); }
                        *(f32x4*)(DEC + (size_t)row * 512 + c) = v0; *(f32x4*)(DEC + (size_t)row * 512 + c + 4) = v1;
                    } else {
                        if (kind == 1) {
#pragma unroll
                            for (int e = 0; e < 4; ++e) { v0[e] = 1.0f / (1.0f + expf(-v0[e])); v1[e] = 1.0f / (1.0f + expf(-v1[e])); } }
                        u32x4 w; w.x = cvt_pk_bf16(v0[0], v0[1]); w.y = cvt_pk_bf16(v0[2], v0[3]); w.z = cvt_pk_bf16(v1[0], v1[1]); w.w = cvt_pk_bf16(v1[2], v1[3]);
                        *(u32x4*)((kind == 1 ? AA : GG) + (size_t)row * 512 + c) = w; } }
        }
    }
};

template <class Epi, class Sched, bool ALIGN_EPI = false, bool SP2 = false>
__device__ __forceinline__ void gemm_phase(PG8_LAS unsigned char* lds, const Gemm g, const Sched& S, const Epi& E, const int wid) {
    const int lane = (int)__builtin_amdgcn_mbcnt_hi(~0u, __builtin_amdgcn_mbcnt_lo(~0u, 0u)), tid = (wid << 6) | lane, wr = wid >> 2, wc = wid & 3, fr = lane & 15, fq = lane >> 4;
    int K = g.K; asm volatile("" : "+s"(K)); const int nt = K / BK;
    unsigned voffA[2], voffB[2];
#pragma unroll
    for (int i = 0; i < 2; ++i) { int R, C; stage_rc(tid * 16 + i * 8192, R, C); const int Rb = Epi::PERM ? ((R & ~31) + perm32(R & 31)) : R;
        voffA[i] = (unsigned)(R * K + C) * 2u; voffB[i] = (unsigned)(Rb * K + C) * 2u; }
    const size_t kstep = (size_t)(BK * 2);
    const size_t hstep = (size_t)HALF * K * 2;
    const size_t tstep = 2 * hstep;
    const unsigned ldsw = (unsigned)wid * 1024u;
    const int aoff = lds_byte(wr * 64 + fr, fq * 8), boff = lds_byte(wc * 32 + fr, fq * 8);
#define PG8_SA(b, h) (((b) * 2 + (h)) * HTB)
#define PG8_SB(b, h) ((4 + (b) * 2 + (h)) * HTB)
#define PG8_STAGE(bufoff, gbase, voff) do { _Pragma("unroll") for (int _i = 0; _i < 2; ++_i) \
        __builtin_amdgcn_global_load_lds((const unsigned*)((const char*)(gbase) + (voff)[_i]), (PG8_LAS unsigned*)(lds + (bufoff) + ldsw + _i * 8192), 16, 0, 0); } while (0)
#define PG8_LDA(dst, b, h) do { _Pragma("unroll") for (int m = 0; m < 4; ++m) _Pragma("unroll") for (int k = 0; k < 2; ++k) dst[m][k] = *(const PG8_LAS bf16x8*)(lds + PG8_SA(b, h) + aoff + m * 2048 + k * 1024); } while (0)
#define PG8_LDB(dst, b, h) do { _Pragma("unroll") for (int n = 0; n < 2; ++n) _Pragma("unroll") for (int k = 0; k < 2; ++k) dst[n][k] = *(const PG8_LAS bf16x8*)(lds + PG8_SB(b, h) + boff + n * 2048 + k * 1024); } while (0)
#define PG8_MMA(ai, bj, At, Bt) do { __builtin_amdgcn_s_setprio(1); _Pragma("unroll") for (int m = 0; m < 4; ++m) _Pragma("unroll") for (int n = 0; n < 2; ++n) _Pragma("unroll") for (int k = 0; k < 2; ++k) \
        acc[ai][bj][m][n] = __builtin_amdgcn_mfma_f32_16x16x32_bf16(Bt[n][k], At[m][k], acc[ai][bj][m][n], 0, 0, 0); __builtin_amdgcn_s_setprio(0); } while (0)
#define PG8_WAIT_V(n) asm volatile("s_waitcnt vmcnt(" #n ")" ::: "memory")
#define PG8_WAIT_L(n) asm volatile("s_waitcnt lgkmcnt(" #n ")" ::: "memory")
#define PG8_BAR __builtin_amdgcn_s_barrier()
#define PG8_SCHED __builtin_amdgcn_sched_barrier(0)
    Unit cur, nxt; int ui = 0;
    if (!S.next(0, cur)) return;
    f32x4 acc[2][2][4][2];
#pragma unroll
    for (int a = 0; a < 2; ++a)
#pragma unroll
        for (int b = 0; b < 2; ++b)
#pragma unroll
            for (int m = 0; m < 4; ++m)
#pragma unroll
                for (int n = 0; n < 2; ++n) acc[a][b][m][n] = (f32x4){0.f, 0.f, 0.f, 0.f};
    bf16x8 At[4][2], B0[2][2], B1[2][2];
    const char* cA = (const char*)g.A + (size_t)cur.pm * tstep; const char* cB = (const char*)g.Bt + (size_t)cur.pn * tstep;
    S.a_ready(cur);
    if constexpr (SP2) {
        PG8_STAGE(PG8_SB(0, 0), cB, voffB); PG8_STAGE(PG8_SB(0, 1), cB + hstep, voffB); PG8_STAGE(PG8_SA(0, 0), cA, voffA); PG8_STAGE(PG8_SA(0, 1), cA + hstep, voffA);
        if (wr == 1) PG8_BAR;
        PG8_WAIT_V(2); PG8_BAR;
        PG8_STAGE(PG8_SB(1, 0), cB + kstep, voffB); PG8_STAGE(PG8_SA(1, 0), cA + kstep, voffA); PG8_STAGE(PG8_SB(1, 1), cB + hstep + kstep, voffB);
        PG8_WAIT_V(6); PG8_BAR;
    } else {
        PG8_STAGE(PG8_SB(0, 0), cB, voffB); PG8_STAGE(PG8_SA(0, 0), cA, voffA); PG8_STAGE(PG8_SB(0, 1), cB + hstep, voffB); PG8_STAGE(PG8_SA(0, 1), cA + hstep, voffA);
        if (wr == 1) PG8_BAR;
        PG8_WAIT_V(4); PG8_BAR;
        PG8_STAGE(PG8_SB(1, 0), cB + kstep, voffB); PG8_STAGE(PG8_SA(1, 0), cA + kstep, voffA); PG8_STAGE(PG8_SB(1, 1), cB + hstep + kstep, voffB);
        PG8_WAIT_V(6); PG8_BAR;
    }
    for (;;) {
        const bool has_next = S.next(ui + 1, nxt);
        const char* nA = has_next ? (const char*)g.A + (size_t)nxt.pm * tstep : cA; const char* nB = has_next ? (const char*)g.Bt + (size_t)nxt.pn * tstep : cB;
        for (int t = 0; t < nt; t += 2) {
            const bool last = (t == nt - 2);
            const char* a1 = cA + (size_t)(t + 1) * kstep;
            const char* a2 = last ? nA : cA + (size_t)(t + 2) * kstep; const char* b2 = last ? nB : cB + (size_t)(t + 2) * kstep;
            const char* a3 = a2 + kstep; const char* b3 = b2 + kstep;
            if (last && has_next) S.a_ready(nxt);
            if constexpr (SP2) {
            PG8_LDB(B0, 0, 0); PG8_LDB(B1, 0, 1); PG8_SCHED; PG8_LDA(At, 0, 0); PG8_STAGE(PG8_SA(1, 1), a1 + hstep, voffA);
            PG8_WAIT_V(8); PG8_WAIT_L(0); PG8_BAR; PG8_MMA(0, 0, At, B0); PG8_MMA(0, 1, At, B1); PG8_BAR; PG8_SCHED;
            PG8_LDA(At, 0, 1); PG8_STAGE(PG8_SB(0, 0), b2, voffB); PG8_STAGE(PG8_SB(0, 1), b2 + hstep, voffB); PG8_STAGE(PG8_SA(0, 0), a2, voffA);
            PG8_WAIT_V(8); PG8_WAIT_L(0); PG8_BAR; PG8_MMA(1, 0, At, B0); PG8_MMA(1, 1, At, B1); PG8_BAR; PG8_SCHED;
            PG8_LDB(B0, 1, 0); PG8_LDB(B1, 1, 1); PG8_SCHED; PG8_LDA(At, 1, 0); PG8_STAGE(PG8_SA(0, 1), a2 + hstep, voffA);
            PG8_WAIT_V(8); PG8_WAIT_L(0); PG8_BAR; PG8_MMA(0, 0, At, B0); PG8_MMA(0, 1, At, B1); PG8_BAR; PG8_SCHED;
            PG8_LDA(At, 1, 1); PG8_STAGE(PG8_SB(1, 0), b3, voffB); PG8_STAGE(PG8_SB(1, 1), b3 + hstep, voffB); PG8_STAGE(PG8_SA(1, 0), a3, voffA);
            PG8_WAIT_V(8); PG8_WAIT_L(0); PG8_BAR; PG8_MMA(1, 0, At, B0); PG8_MMA(1, 1, At, B1); PG8_BAR; PG8_SCHED;
            } else {
            PG8_LDB(B0, 0, 0); PG8_SCHED; PG8_LDA(At, 0, 0); PG8_STAGE(PG8_SA(1, 1), a1 + hstep, voffA);
            PG8_WAIT_L(8); PG8_BAR; PG8_WAIT_L(0); PG8_MMA(0, 0, At, B0); PG8_BAR; PG8_SCHED;
            PG8_LDB(B1, 0, 1); PG8_STAGE(PG8_SB(0, 0), b2, voffB);
            PG8_BAR; PG8_WAIT_L(0); PG8_MMA(0, 1, At, B1); PG8_BAR;
            PG8_LDA(At, 0, 1); PG8_STAGE(PG8_SA(0, 0), a2, voffA);
            PG8_BAR; PG8_WAIT_L(0); PG8_MMA(1, 0, At, B0); PG8_BAR; PG8_SCHED;
            PG8_STAGE(PG8_SB(0, 1), b2 + hstep, voffB);
            PG8_WAIT_V(6); PG8_BAR; PG8_MMA(1, 1, At, B1); PG8_BAR;
            PG8_LDB(B0, 1, 0); PG8_SCHED; PG8_LDA(At, 1, 0); PG8_STAGE(PG8_SA(0, 1), a2 + hstep, voffA);
            PG8_WAIT_L(8); PG8_BAR; PG8_WAIT_L(0); PG8_MMA(0, 0, At, B0); PG8_BAR; PG8_SCHED;
            PG8_LDB(B1, 1, 1); PG8_STAGE(PG8_SB(1, 0), b3, voffB);
            PG8_BAR; PG8_WAIT_L(0); PG8_MMA(0, 1, At, B1); PG8_BAR;
            PG8_LDA(At, 1, 1); PG8_STAGE(PG8_SA(1, 0), a3, voffA);
            PG8_BAR; PG8_WAIT_L(0); PG8_MMA(1, 0, At, B0); PG8_BAR; PG8_SCHED;
            PG8_STAGE(PG8_SB(1, 1), b3 + hstep, voffB);
            PG8_WAIT_V(6); PG8_BAR; PG8_MMA(1, 1, At, B1); PG8_BAR;
            }
        }
        if constexpr (ALIGN_EPI) { if (wr == 0) PG8_BAR; }
        if constexpr (!Epi::AFTER_DRAIN) { E(acc, cur, wr, wc, fr, fq); S.done(cur); }
        if (!has_next) break;
#pragma unroll
        for (int a = 0; a < 2; ++a)
#pragma unroll
            for (int b = 0; b < 2; ++b)
#pragma unroll
                for (int m = 0; m < 4; ++m)
#pragma unroll
                    for (int n = 0; n < 2; ++n) acc[a][b][m][n] = (f32x4){0.f, 0.f, 0.f, 0.f};
        cur = nxt; cA = nA; cB = nB; ++ui;
        if constexpr (ALIGN_EPI) { if (wr == 1) PG8_BAR; }
    }
    PG8_WAIT_V(0);
    if constexpr (!ALIGN_EPI) { if (wr == 0) PG8_BAR; }
    PG8_BAR;
    if constexpr (Epi::AFTER_DRAIN) { E.fused(acc, cur, wr, wc, fr, fq, lds, wid, lane); S.done(cur); }
#undef PG8_SA
#undef PG8_SB
#undef PG8_STAGE
#undef PG8_LDA
#undef PG8_LDB
#undef PG8_MMA
#undef PG8_WAIT_V
#undef PG8_WAIT_L
#undef PG8_BAR
#undef PG8_SCHED
}
}

constexpr int BATCH = 2, SEQ = 8192, DM = 1024, FF = 2816, NIN = 2560, RW = 512, M = BATCH * SEQ;
constexpr int NWAVES = 8, NTHR = 512;
constexpr int CH = 128, NCH = SEQ / CH;
constexpr size_t MiB = 1u << 20;
constexpr size_t WS_WGU1 = 0, WS_WD1 = 11 * MiB, WS_WIN = WS_WD1 + 11 * MiB / 2, WS_WOUT = WS_WIN + 5 * MiB, WS_WGU2 = WS_WOUT + 2 * MiB, WS_WD2 = WS_WGU2 + 11 * MiB, WS_WL = 40 * MiB;
constexpr size_t WS_GG = 0;
constexpr size_t WS_XB = 44 * MiB;
constexpr size_t WS_PST = 44 * MiB, WS_LST = 60 * MiB;
constexpr size_t WS_BIG = 76 * MiB;
constexpr size_t WS_LIN = WS_BIG + 80 * MiB;
constexpr size_t WS_DEC = 164 * MiB, WS_AA = 196 * MiB, WS_MIX = 212 * MiB, WS_SS = 244 * MiB, WS_CTL = 248 * MiB, WS_END = 249 * MiB;
static_assert(WS_WD2 + 11 * MiB / 2 <= WS_WL && WS_WL + MiB <= WS_XB, "weights map");

#define LAS __attribute__((address_space(3)))
typedef unsigned short bf16;
typedef unsigned v4u __attribute__((ext_vector_type(4)));
typedef unsigned v2u __attribute__((ext_vector_type(2)));
typedef float f32x4 __attribute__((ext_vector_type(4)));
typedef float f32x2 __attribute__((ext_vector_type(2)));
typedef short bf16x8 __attribute__((ext_vector_type(8)));
using pg8::cvt_pk_bf16;
__device__ __forceinline__ float bflo(unsigned u) { return __uint_as_float(u << 16); }
__device__ __forceinline__ float bfhi(unsigned u) { return __uint_as_float(u & 0xffff0000u); }
template <int CTRL> __device__ __forceinline__ float dpp_mov(float x) { return __builtin_bit_cast(float, __builtin_amdgcn_update_dpp(0, __builtin_bit_cast(int, x), CTRL, 0xF, 0xF, true)); }
__device__ __forceinline__ float sum16(float x) { x += dpp_mov<0xB1>(x); x += dpp_mov<0x4E>(x); x += dpp_mov<0x141>(x); x += dpp_mov<0x140>(x); return x; }
__device__ __forceinline__ float max16(float x) { x = fmaxf(x, dpp_mov<0xB1>(x)); x = fmaxf(x, dpp_mov<0x4E>(x)); x = fmaxf(x, dpp_mov<0x141>(x)); x = fmaxf(x, dpp_mov<0x140>(x)); return x; }
__device__ __forceinline__ float sum8(float x) { x += dpp_mov<0xB1>(x); x += dpp_mov<0x4E>(x); x += dpp_mov<0x141>(x); return x; }
__device__ __forceinline__ float wave_sum(float v) {
#pragma unroll
    for (int o = 1; o < 64; o <<= 1) v += __shfl_xor(v, o);
    return v;
}

__device__ __forceinline__ int lane_id() { return (int)__builtin_amdgcn_mbcnt_hi(~0u, __builtin_amdgcn_mbcnt_lo(~0u, 0u)); }
#define TIDX ((wave << 6) | lane_id())
struct Params {
    const float* in[26]; float* out; unsigned char* ws; int ph_lo, ph_hi;
};


#define GAS __attribute__((address_space(1)))
__device__ __forceinline__ const float* inp(int i) {
    const __attribute__((address_space(4))) char* ka = (const __attribute__((address_space(4))) char*)__builtin_amdgcn_kernarg_segment_ptr();
    int off = i * 8; asm volatile("" : "+s"(off));
    const float* q = *(const float* const __attribute__((address_space(4)))*)(ka + off);
    return (const float*)(const GAS float*)q;
}

__device__ __forceinline__ void conv_item(const float* W, int K, int N, const float* sc, bf16* WT, int k0, int n0, int drow0, float* scr, int lane) {
    float wv[32];
#pragma unroll
    for (int i = 0; i < 32; ++i) wv[i] = W[(size_t)(k0 + 2 * i + (lane >> 5)) * N + n0 + (lane & 31)];
    if (sc) { const float s0 = sc[k0 + lane];
#pragma unroll
        for (int i = 0; i < 32; ++i) wv[i] *= __shfl(s0, 2 * i + (lane >> 5)); }
#pragma unroll
    for (int i = 0; i < 32; ++i) scr[(2 * i + (lane >> 5)) * 33 + (lane & 31)] = wv[i];
    __builtin_amdgcn_fence(__ATOMIC_RELEASE, "wavefront"); asm volatile("s_waitcnt lgkmcnt(0)" ::: "memory");
    const int c = lane & 7;
#pragma unroll
    for (int j = 0; j < 4; ++j) { const int n = (lane >> 3) + 8 * j; const float* s = scr + (8 * c) * 33 + n;
        v4u o; o.x = cvt_pk_bf16(s[0 * 33], s[1 * 33]); o.y = cvt_pk_bf16(s[2 * 33], s[3 * 33]); o.z = cvt_pk_bf16(s[4 * 33], s[5 * 33]); o.w = cvt_pk_bf16(s[6 * 33], s[7 * 33]);
        *(v4u*)(WT + (size_t)(drow0 + n) * K + k0 + 8 * c) = o; }
    asm volatile("s_waitcnt lgkmcnt(0)" ::: "memory");
}
__device__ __forceinline__ void conv_plain(const float* W, int K, int N, const float* sc, bf16* WT, int item, float* scr, int lane) {
    const int nblk = N / 32, kb = item / nblk, nb = item % nblk; conv_item(W, K, N, sc, WT, 64 * kb, 32 * nb, 32 * nb, scr, lane);
}
__device__ __forceinline__ void conv_gu(const float* W, const float* sc, bf16* WT, int item, int up, float* scr, int lane) {
    const int nblk = FF / 32, kb = item / nblk, nb = item % nblk, n0 = 32 * nb; conv_item(W, DM, FF, sc, WT, 64 * kb, n0, (n0 >> 7) * 256 + up * 128 + (n0 & 127), scr, lane);
}
__device__ __forceinline__ void p0_late_weights(const Params& p, unsigned char* lds, int wave, int lane, int bidx, int NB) {
    float* scr = (float*)(lds + wave * 16384);
    unsigned char* ws = p.ws;
    const int gw = bidx * NWAVES + wave, NGW = NB * NWAVES;
    constexpr int I_GU = (DM / 64) * (FF / 32), I_DN = (FF / 64) * (DM / 32), I_IN = (DM / 64) * (NIN / 32), I_OUT = (DM / 64) * (DM / 32);
    constexpr int NITEMS = 2 * I_GU + I_DN + I_IN + I_OUT;
    for (int it = gw; it < NITEMS; it += NGW) {
        int r = it;
        if (r < I_IN) { conv_plain(inp(6), DM, NIN, inp(5), (bf16*)(ws + WS_WIN), r, scr, lane); continue; } r -= I_IN;
        if (r < I_OUT) { conv_plain(inp(20), DM, DM, nullptr, (bf16*)(ws + WS_WOUT), r, scr, lane); continue; } r -= I_OUT;
        if (r < I_GU) { conv_gu(inp(22), inp(21), (bf16*)(ws + WS_WGU2), r, 0, scr, lane); continue; } r -= I_GU;
        if (r < I_GU) { conv_gu(inp(23), inp(21), (bf16*)(ws + WS_WGU2), r, 1, scr, lane); continue; } r -= I_GU;
        conv_plain(inp(24), FF, DM, nullptr, (bf16*)(ws + WS_WD2), r, scr, lane);
    }
}
__device__ __forceinline__ void p0_prologue(const Params& p, unsigned char* lds, int wave, int lane) {
    float* scr = (float*)(lds + wave * 16384);
    unsigned char* ws = p.ws;
    const int gw = blockIdx.x * NWAVES + wave, NGW = gridDim.x * NWAVES;
    constexpr int I_GU = (DM / 64) * (FF / 32), I_DN = (FF / 64) * (DM / 32);
    constexpr int NITEMS = 2 * I_GU + I_DN;
    for (int it = gw; it < NITEMS; it += NGW) {
        int r = it;
        if (r < I_GU) { conv_gu(inp(2), inp(1), (bf16*)(ws + WS_WGU1), r, 0, scr, lane); continue; } r -= I_GU;
        if (r < I_GU) { conv_gu(inp(3), inp(1), (bf16*)(ws + WS_WGU1), r, 1, scr, lane); continue; } r -= I_GU;
        conv_plain(inp(4), FF, DM, nullptr, (bf16*)(ws + WS_WD1), r, scr, lane);
    }
    { bf16* WL = (bf16*)(ws + WS_WL); const float* w2 = inp(10); const float* a2 = inp(12); const float* g2 = inp(13);
      for (int idx = (blockIdx.x * NTHR + TIDX); idx < 1536 * 128; idx += gridDim.x * NTHR) {
          const int n = idx >> 7, k = (idx & 127) * 2; float v0 = 0.f, v1 = 0.f;
          if (n < 512) { if (k < 64) { v0 = w2[k * 512 + n]; v1 = w2[(k + 1) * 512 + n]; } }
          else if (n < 1024) { if (k >= 64 && k < 128) { v0 = a2[(k - 64) * 512 + n - 512]; v1 = a2[(k - 63) * 512 + n - 512]; } }
          else { if (k >= 128) { v0 = g2[(k - 128) * 512 + n - 1024]; v1 = g2[(k - 127) * 512 + n - 1024]; } }
          *(unsigned*)(WL + (size_t)n * 256 + k) = cvt_pk_bf16(v0, v1); } }
    { const float* x = inp(0); bf16* XB = (bf16*)(ws + WS_XB); float* ss0 = (float*)(ws + WS_SS);
      for (int m = gw; m < M; m += NGW) { const f32x4* xr = (const f32x4*)(x + (size_t)m * DM) + lane; float s = 0.f; f32x4 v[4];
#pragma unroll
          for (int j = 0; j < 4; ++j) { v[j] = xr[64 * j]; s += (v[j][0] * v[j][0] + v[j][1] * v[j][1]) + (v[j][2] * v[j][2] + v[j][3] * v[j][3]); }
          s = wave_sum(s);
          v2u* o8 = (v2u*)(XB + (size_t)m * DM) + lane;
#pragma unroll
          for (int j = 0; j < 4; ++j) { v2u w; w.x = cvt_pk_bf16(v[j][0], v[j][1]); w.y = cvt_pk_bf16(v[j][2], v[j][3]); o8[64 * j] = w; }
          if (lane < 16) ss0[(size_t)m * 16 + lane] = (lane == 0) ? s : 0.f; } }
}

__device__ __forceinline__ void r1_phase(const Params& p, int wave) {
    const bf16* P = (const bf16*)(p.ws + WS_BIG); bf16* LIN = (bf16*)(p.ws + WS_LIN); const float* mix = inp(8);
    for (int idx = blockIdx.x * NTHR + TIDX; idx < M * 32; idx += gridDim.x * NTHR) {
        const int row = idx >> 5, g8 = idx & 31, col = 1536 + 8 * g8; const bool hp = (row & (SEQ - 1)) != 0;
        const v4u c = *(const v4u*)(P + (size_t)row * NIN + col); v4u q = (v4u){0u, 0u, 0u, 0u}; if (hp) q = *(const v4u*)(P + (size_t)(row - 1) * NIN + col);
        const f32x4 m0 = *(const f32x4*)(mix + col), m1 = *(const f32x4*)(mix + col + 4);
        float x[8];
#pragma unroll
        for (int e = 0; e < 4; ++e) { const float c0 = bflo(c[e]), c1 = bfhi(c[e]), q0 = bflo(q[e]), q1 = bfhi(q[e]); const float ma = (e < 2) ? m0[2 * e] : m1[2 * e - 4], mb = (e < 2) ? m0[2 * e + 1] : m1[2 * e - 3];
            x[2 * e] = c0 + (q0 - c0) * ma; x[2 * e + 1] = c1 + (q1 - c1) * mb; }
        if (g8 < 8) {
#pragma unroll
            for (int e = 0; e < 8; ++e) x[e] = tanhf(x[e]);
        } else if (g8 >= 16) {
#pragma unroll
            for (int e = 0; e < 8; ++e) x[e] = 1.0f / (1.0f + expf(-x[e]));
        }
        v4u o; o.x = cvt_pk_bf16(x[0], x[1]); o.y = cvt_pk_bf16(x[2], x[3]); o.z = cvt_pk_bf16(x[4], x[5]); o.w = cvt_pk_bf16(x[6], x[7]);
        *(v4u*)(LIN + (size_t)row * 256 + 8 * g8) = o;
    }
}

constexpr int SC_W = 0, SC_B = 1, SC_K = 2, SC_KK = 3, SC_V = 4, SC_R = 5, SC_O = 6, SC_BC = 7;
template <bool P3> __device__ __forceinline__ void scan_load(const Params& p, float* sm, int b, int h, int t0, int wave) {
    const int tid = TIDX, tt = tid >> 3, c8 = (tid & 7) * 8, hc = h * 64 + c8;
    const bf16* P = (const bf16*)(p.ws + WS_BIG); const float* DEC = (const float*)(p.ws + WS_DEC); const bf16* AA = (const bf16*)(p.ws + WS_AA);
    const float* mix = inp(8); const float* k_k = inp(14); const float* k_a = inp(15); const float* r_k = inp(16);
    const int gr = b * SEQ + t0 + tt; const bool hp = (t0 + tt) > 0;
    const bf16* prow = P + (size_t)gr * NIN + hc;
    float r[8], k[8], v[8];
#define SHIFT_LOAD(dst, off) do { const v4u c_ = *(const v4u*)(prow + (off)); v4u q_ = (v4u){0u, 0u, 0u, 0u}; if (hp) q_ = *(const v4u*)(prow + (off) - NIN); \
        const f32x4 m0_ = *(const f32x4*)(mix + hc + (off)), m1_ = *(const f32x4*)(mix + hc + (off) + 4); \
        _Pragma("unroll") for (int e = 0; e < 4; ++e) { const float c0 = bflo(c_[e]), c1 = bfhi(c_[e]), q0 = bflo(q_[e]), q1 = bfhi(q_[e]); const float ma = (e < 2) ? m0_[2 * e] : m1_[2 * e - 4], mb = (e < 2) ? m0_[2 * e + 1] : m1_[2 * e - 3]; \
            dst[2 * e] = c0 + (q0 - c0) * ma; dst[2 * e + 1] = c1 + (q1 - c1) * mb; } } while (0)
    SHIFT_LOAD(k, 512); SHIFT_LOAD(v, 1024);
    if (P3) SHIFT_LOAD(r, 0);
#undef SHIFT_LOAD
    const f32x4 d0 = *(const f32x4*)(DEC + (size_t)gr * RW + hc), d1 = *(const f32x4*)(DEC + (size_t)gr * RW + hc + 4);
    const v4u av = *(const v4u*)(AA + (size_t)gr * RW + hc);
    const f32x4 kk0 = *(const f32x4*)(k_k + hc), kk1 = *(const f32x4*)(k_k + hc + 4), ka0 = *(const f32x4*)(k_a + hc), ka1 = *(const f32x4*)(k_a + hc + 4);
    float a[8], kk[8], kp[8], bb[8]; float ssq = 0.f;
#pragma unroll
    for (int e = 0; e < 4; ++e) { a[2 * e] = bflo(av[e]); a[2 * e + 1] = bfhi(av[e]); }
#pragma unroll
    for (int e = 0; e < 8; ++e) { const float kkw = (e < 4) ? kk0[e] : kk1[e - 4], kaw = (e < 4) ? ka0[e] : ka1[e - 4];
        kk[e] = k[e] * kkw; ssq += kk[e] * kk[e]; kp[e] = k[e] * (1.0f + (a[e] - 1.0f) * kaw); }
    ssq = sum8(ssq);
    const float inv = 1.0f / fmaxf(sqrtf(ssq), 1e-12f);
#pragma unroll
    for (int e = 0; e < 8; ++e) { kk[e] *= inv; bb[e] = kk[e] * a[e]; }
    float* base = sm + tt * 64 + c8;
    *(f32x4*)(base + SC_W * 4096) = d0; *(f32x4*)(base + SC_W * 4096 + 4) = d1;
    *(f32x4*)(base + SC_B * 4096) = (f32x4){bb[0], bb[1], bb[2], bb[3]}; *(f32x4*)(base + SC_B * 4096 + 4) = (f32x4){bb[4], bb[5], bb[6], bb[7]};
    *(f32x4*)(base + SC_K * 4096) = (f32x4){kp[0], kp[1], kp[2], kp[3]}; *(f32x4*)(base + SC_K * 4096 + 4) = (f32x4){kp[4], kp[5], kp[6], kp[7]};
    *(f32x4*)(base + SC_KK * 4096) = (f32x4){kk[0], kk[1], kk[2], kk[3]}; *(f32x4*)(base + SC_KK * 4096 + 4) = (f32x4){kk[4], kk[5], kk[6], kk[7]};
    *(f32x4*)(base + SC_V * 4096) = (f32x4){v[0], v[1], v[2], v[3]}; *(f32x4*)(base + SC_V * 4096 + 4) = (f32x4){v[4], v[5], v[6], v[7]};
    if (P3) {
        *(f32x4*)(base + SC_R * 4096) = (f32x4){r[0], r[1], r[2], r[3]}; *(f32x4*)(base + SC_R * 4096 + 4) = (f32x4){r[4], r[5], r[6], r[7]};
        const f32x4 rk0 = *(const f32x4*)(r_k + hc), rk1 = *(const f32x4*)(r_k + hc + 4); float bc = 0.f;
#pragma unroll
        for (int e = 0; e < 8; ++e) bc += r[e] * kp[e] * ((e < 4) ? rk0[e] : rk1[e - 4]);
        bc = sum8(bc);
        if ((tid & 7) == 0) sm[SC_BC * 4096 + tt] = bc;
    }
}
#define LO2(v) __builtin_shufflevector(v, v, 0, 1)
#define HI2(v) __builtin_shufflevector(v, v, 2, 3)
template <int RPL, bool WITH_O, bool REAL> __device__ __forceinline__ void scan_run(const float* sm, f32x2 (&S)[RPL][2], int cs, int rowbase) {
    typedef float vrow_t __attribute__((ext_vector_type(RPL)));
    const float* st0 = sm + 4 * cs;
    f32x4 w4 = *(const f32x4*)(st0 + SC_W * 4096), b4 = *(const f32x4*)(st0 + SC_B * 4096), kk4 = *(const f32x4*)(st0 + SC_KK * 4096), k4 = w4, r4 = w4;
    if (REAL) k4 = *(const f32x4*)(st0 + SC_K * 4096);
    if (WITH_O) r4 = *(const f32x4*)(st0 + SC_R * 4096);
    vrow_t v4; if (REAL) v4 = *(const vrow_t*)(sm + SC_V * 4096 + rowbase);
#pragma unroll 2
    for (int t = 0; t < 64; ++t) {
        const int tn = (t + 1) & 63;
        const float* st = st0 + tn * 64;
        const f32x4 nw4 = *(const f32x4*)(st + SC_W * 4096), nb4 = *(const f32x4*)(st + SC_B * 4096), nkk4 = *(const f32x4*)(st + SC_KK * 4096);
        f32x4 nk4 = nw4, nr4 = nw4; vrow_t nv4;
        if (REAL) { nk4 = *(const f32x4*)(st + SC_K * 4096); nv4 = *(const vrow_t*)(sm + SC_V * 4096 + tn * 64 + rowbase); }
        if (WITH_O) nr4 = *(const f32x4*)(st + SC_R * 4096);
        const f32x2 w01 = LO2(w4), w23 = HI2(w4), b01 = LO2(b4), b23 = HI2(b4), kk01 = LO2(kk4), kk23 = HI2(kk4), k01 = LO2(k4), k23 = HI2(k4), r01 = LO2(r4), r23 = HI2(r4);
        float oo[RPL];
#pragma unroll
        for (int j = 0; j < RPL; ++j) {
            f32x2 pp = S[j][0] * kk01; pp = S[j][1] * kk23 + pp;
            const float nsa = -sum16(pp[0] + pp[1]);
            const f32x2 nsa2 = (f32x2){nsa, nsa};
            f32x2 t01 = nsa2 * b01, t23 = nsa2 * b23;
            if (REAL) { const f32x2 v2 = (f32x2){v4[j], v4[j]}; t01 = v2 * k01 + t01; t23 = v2 * k23 + t23; }
            S[j][0] = S[j][0] * w01 + t01; S[j][1] = S[j][1] * w23 + t23;
            if (WITH_O) { f32x2 qq = S[j][0] * r01; qq = S[j][1] * r23 + qq; oo[j] = sum16(qq[0] + qq[1]); }
        }
        if (WITH_O) { if (cs == 0) {
#pragma unroll
            for (int j = 0; j < RPL; ++j) ((float*)sm)[SC_O * 4096 + t * 64 + rowbase + j] = oo[j]; } }
        w4 = nw4; b4 = nb4; kk4 = nkk4; k4 = nk4; r4 = nr4; if (REAL) v4 = nv4;
    }
}
__device__ __forceinline__ void scan_pass1(const Params& p, float* sm, int wave, int lane) {
    float* PST = (float*)(p.ws + WS_PST); float* LST = (float*)(p.ws + WS_LST);
    const int cs = lane & 15, rg = lane >> 4; const bool real = wave < 4; const int rowbase = (wave & 3) * 16 + rg * 4;
    constexpr int NU = BATCH * (NCH - 1) * 8;
    for (int u = blockIdx.x; u < NU; u += gridDim.x) {
        const int h = u & 7, bc = u >> 3, c = bc % (NCH - 1), b = bc / (NCH - 1);
        f32x2 S[4][2];
#pragma unroll
        for (int j = 0; j < 4; ++j)
#pragma unroll
            for (int e = 0; e < 4; ++e) S[j][e >> 1][e & 1] = (!real && (rowbase + j == 4 * cs + e)) ? 1.0f : 0.0f;
        for (int sub = 0; sub < 2; ++sub) {
            __syncthreads();
            scan_load<false>(p, sm, b, h, c * CH + sub * 64, wave);
            __syncthreads();
            if (real) scan_run<4, false, true>(sm, S, cs, rowbase); else scan_run<4, false, false>(sm, S, cs, rowbase);
        }
        float* dst = (real ? LST : PST) + ((size_t)((b * NCH + c) * 8 + h)) * 4096 + rowbase * 64 + 4 * cs;
#pragma unroll
        for (int j = 0; j < 4; ++j) *(f32x4*)(dst + j * 64) = (f32x4){S[j][0][0], S[j][0][1], S[j][1][0], S[j][1][1]};
    }
}
__device__ __forceinline__ float rowsum4(float part) {
    const f32x4 z = (f32x4){0.f, 0.f, 0.f, 0.f};
    const f32x4 d = __builtin_amdgcn_mfma_f32_16x16x4f32(1.0f, part, z, 0, 0, 0);
    return d[0];
}
struct ScanRaw { v4u kc, kq, vc, vq, rc, rq, av, gv; f32x4 d0, d1; };
__device__ __forceinline__ void scanL_params(float* parl, int hc, int c8) {
    const float* mix = inp(8); const float* k_k = inp(14); const float* k_a = inp(15); const float* r_k = inp(16); const float* ln_w = inp(17); const float* ln_b = inp(18);
    float* d = parl + c8;
    *(f32x4*)(d) = *(const f32x4*)(mix + hc); *(f32x4*)(d + 4) = *(const f32x4*)(mix + hc + 4);
    *(f32x4*)(d + 64) = *(const f32x4*)(mix + 512 + hc); *(f32x4*)(d + 68) = *(const f32x4*)(mix + 512 + hc + 4);
    *(f32x4*)(d + 128) = *(const f32x4*)(mix + 1024 + hc); *(f32x4*)(d + 132) = *(const f32x4*)(mix + 1024 + hc + 4);
    *(f32x4*)(d + 192) = *(const f32x4*)(k_k + hc); *(f32x4*)(d + 196) = *(const f32x4*)(k_k + hc + 4);
    *(f32x4*)(d + 256) = *(const f32x4*)(k_a + hc); *(f32x4*)(d + 260) = *(const f32x4*)(k_a + hc + 4);
    *(f32x4*)(d + 320) = *(const f32x4*)(r_k + hc); *(f32x4*)(d + 324) = *(const f32x4*)(r_k + hc + 4);
    *(f32x4*)(d + 384) = *(const f32x4*)(ln_w + hc); *(f32x4*)(d + 388) = *(const f32x4*)(ln_w + hc + 4);
    *(f32x4*)(d + 448) = *(const f32x4*)(ln_b + hc); *(f32x4*)(d + 452) = *(const f32x4*)(ln_b + hc + 4);
}
template <bool P3> __device__ __forceinline__ void scanL_issue(const Params& p, ScanRaw& w, int b, int hc, int tok) {
    const bf16* P = (const bf16*)(p.ws + WS_BIG); const float* DEC = (const float*)(p.ws + WS_DEC); const bf16* AA = (const bf16*)(p.ws + WS_AA); const bf16* GG = (const bf16*)(p.ws + WS_GG);
    const int gr = b * SEQ + tok; const bool hp = tok > 0;
    const bf16* prow = P + (size_t)gr * NIN + hc; const v4u z = (v4u){0u, 0u, 0u, 0u};
    w.kc = *(const v4u*)(prow + 512); w.kq = hp ? *(const v4u*)(prow + 512 - NIN) : z;
    w.vc = *(const v4u*)(prow + 1024); w.vq = hp ? *(const v4u*)(prow + 1024 - NIN) : z;
    if (P3) { w.rc = *(const v4u*)(prow); w.rq = hp ? *(const v4u*)(prow - NIN) : z; w.gv = *(const v4u*)(GG + (size_t)gr * RW + hc); }
    w.d0 = *(const f32x4*)(DEC + (size_t)gr * RW + hc); w.d1 = *(const f32x4*)(DEC + (size_t)gr * RW + hc + 4);
    w.av = *(const v4u*)(AA + (size_t)gr * RW + hc);
}
__device__ __forceinline__ void shift8(float (&dst)[8], const v4u& c_, const v4u& q_, const f32x4& m0_, const f32x4& m1_) {
#pragma unroll
    for (int e = 0; e < 4; ++e) { const float c0 = bflo(c_[e]), c1 = bfhi(c_[e]), q0 = bflo(q_[e]), q1 = bfhi(q_[e]); const float ma = (e < 2) ? m0_[2 * e] : m1_[2 * e - 4], mb = (e < 2) ? m0_[2 * e + 1] : m1_[2 * e - 3];
        dst[2 * e] = c0 + (q0 - c0) * ma; dst[2 * e + 1] = c1 + (q1 - c1) * mb; }
}
template <bool P3, int TS> __device__ __forceinline__ void scanL_store(const ScanRaw& w, const float* parl, float* su, float* bcl, int tt, int c8, bool bcw) {
    float r[8], k[8], v[8]; const float* pq = parl + c8;
    shift8(k, w.kc, w.kq, *(const f32x4*)(pq + 64), *(const f32x4*)(pq + 68)); shift8(v, w.vc, w.vq, *(const f32x4*)(pq + 128), *(const f32x4*)(pq + 132));
    if (P3) shift8(r, w.rc, w.rq, *(const f32x4*)(pq), *(const f32x4*)(pq + 4));
    const f32x4 qkk0 = *(const f32x4*)(pq + 192), qkk1 = *(const f32x4*)(pq + 196), qka0 = *(const f32x4*)(pq + 256), qka1 = *(const f32x4*)(pq + 260);
    float a[8], kk[8], kp[8], bb[8]; float ssq = 0.f;
#pragma unroll
    for (int e = 0; e < 4; ++e) { a[2 * e] = bflo(w.av[e]); a[2 * e + 1] = bfhi(w.av[e]); }
#pragma unroll
    for (int e = 0; e < 8; ++e) { const float kkw = (e < 4) ? qkk0[e] : qkk1[e - 4], kaw = (e < 4) ? qka0[e] : qka1[e - 4];
        kk[e] = k[e] * kkw; ssq += kk[e] * kk[e]; kp[e] = k[e] * (1.0f + (a[e] - 1.0f) * kaw); }
    ssq = sum8(ssq);
    const float inv = 1.0f / fmaxf(sqrtf(ssq), 1e-12f);
#pragma unroll
    for (int e = 0; e < 8; ++e) { kk[e] *= inv; bb[e] = kk[e] * a[e]; }
    constexpr int AS = TS * 64;
    float* base = su + tt * 64 + c8;
    *(f32x4*)(base + SC_W * AS) = w.d0; *(f32x4*)(base + SC_W * AS + 4) = w.d1;
    *(f32x4*)(base + SC_B * AS) = (f32x4){bb[0], bb[1], bb[2], bb[3]}; *(f32x4*)(base + SC_B * AS + 4) = (f32x4){bb[4], bb[5], bb[6], bb[7]};
    *(f32x4*)(base + SC_K * AS) = (f32x4){kp[0], kp[1], kp[2], kp[3]}; *(f32x4*)(base + SC_K * AS + 4) = (f32x4){kp[4], kp[5], kp[6], kp[7]};
    *(f32x4*)(base + SC_KK * AS) = (f32x4){kk[0], kk[1], kk[2], kk[3]}; *(f32x4*)(base + SC_KK * AS + 4) = (f32x4){kk[4], kk[5], kk[6], kk[7]};
    *(f32x4*)(base + SC_V * AS) = (f32x4){v[0], v[1], v[2], v[3]}; *(f32x4*)(base + SC_V * AS + 4) = (f32x4){v[4], v[5], v[6], v[7]};
    if (P3) {
        *(f32x4*)(base + SC_R * AS) = (f32x4){r[0], r[1], r[2], r[3]}; *(f32x4*)(base + SC_R * AS + 4) = (f32x4){r[4], r[5], r[6], r[7]};
        const f32x4 qrk0 = *(const f32x4*)(pq + 320), qrk1 = *(const f32x4*)(pq + 324); float bc = 0.f;
#pragma unroll
        for (int e = 0; e < 8; ++e) bc += r[e] * kp[e] * ((e < 4) ? qrk0[e] : qrk1[e - 4]);
        bc = sum8(bc);
        if (bcw) bcl[tt] = bc;
    }
}
#define LD16(dst, ptr) do { const f32x4 x0_ = *(const f32x4*)(ptr), x1_ = *(const f32x4*)((ptr) + 4), x2_ = *(const f32x4*)((ptr) + 8), x3_ = *(const f32x4*)((ptr) + 12); \
        dst[0] = LO2(x0_); dst[1] = HI2(x0_); dst[2] = LO2(x1_); dst[3] = HI2(x1_); dst[4] = LO2(x2_); dst[5] = HI2(x2_); dst[6] = LO2(x3_); dst[7] = HI2(x3_); } while (0)
template <int RPL, bool WITH_O, bool REAL, int TS> __device__ __forceinline__ void scanL_run(float* su, f32x2 (&S)[RPL][8], int r, int g, int rowbase) {
    constexpr int AS = TS * 64;
#pragma unroll 1
    for (int t = 0; t < TS; ++t) {
        const float* st = su + t * 64 + 16 * g;
        f32x2 w2[8], b2[8], kk2[8], k2[8], r2[8];
        LD16(kk2, st + SC_KK * AS); LD16(w2, st + SC_W * AS); LD16(b2, st + SC_B * AS);
        if (REAL) LD16(k2, st + SC_K * AS);
        if (WITH_O) LD16(r2, st + SC_R * AS);
        float vv[RPL];
#pragma unroll
        for (int j = 0; j < RPL; ++j) vv[j] = REAL ? su[SC_V * AS + t * 64 + rowbase + 16 * j + r] : 0.f;
#pragma unroll
        for (int j = 0; j < RPL; ++j) {
            f32x2 p0 = S[j][0] * kk2[0], p1 = S[j][1] * kk2[1];
#pragma unroll
            for (int i = 2; i < 8; i += 2) { p0 = S[j][i] * kk2[i] + p0; p1 = S[j][i + 1] * kk2[i + 1] + p1; }
            p0 += p1;
            const float nsa = -rowsum4(p0[0] + p0[1]);
            const f32x2 nsa2 = (f32x2){nsa, nsa}, v2 = (f32x2){vv[j], vv[j]};
            f32x2 q0 = (f32x2){0.f, 0.f}, q1 = q0;
#pragma unroll
            for (int i = 0; i < 8; ++i) { f32x2 tt_ = nsa2 * b2[i]; if (REAL) tt_ = v2 * k2[i] + tt_; S[j][i] = S[j][i] * w2[i] + tt_;
                if (WITH_O) { if (i & 1) q1 = S[j][i] * r2[i] + q1; else q0 = S[j][i] * r2[i] + q0; } }
            if (WITH_O) { q0 += q1; const float o = rowsum4(q0[0] + q0[1]); if (g == 0) su[SC_O * AS + t * 64 + rowbase + 16 * j + r] = o; }
        }
    }
}
__device__ __forceinline__ void scanL_pass1(const Params& p, float* sm, int wave) {
    constexpr int TS = 32, SLOT = 5 * TS * 64, NPAIR = BATCH * (NCH - 1) * 8 / 2;
    float* PST = (float*)(p.ws + WS_PST); float* LST = (float*)(p.ws + WS_LST);
    const int lane = lane_id(), tid = (wave << 6) | lane, r = lane & 15, g = lane >> 4, u2 = wave >> 2, wq = wave & 3; const bool real = wq < 2; const int rowbase = (wq & 1) * 32;
    float* su = sm + u2 * SLOT;
    const int ltt = (tid >> 3) & 31, lc8 = (tid & 7) * 8;
    for (int up = blockIdx.x; up < NPAIR; up += gridDim.x) {
        const int u = 2 * up + u2, h = u & 7, bc = u >> 3, c = bc % (NCH - 1), b = bc / (NCH - 1);
        f32x2 S[2][8];
#pragma unroll
        for (int j = 0; j < 2; ++j)
#pragma unroll
            for (int i = 0; i < 8; ++i) { const int row = rowbase + 16 * j + r, col = 16 * g + 2 * i; S[j][i] = (f32x2){(!real && row == col) ? 1.f : 0.f, (!real && row == col + 1) ? 1.f : 0.f}; }
        float* parl = sm + 2 * SLOT + u2 * 512;
        __syncthreads();
        if (ltt == 0) scanL_params(parl, h * 64 + lc8, lc8);
        ScanRaw raw; scanL_issue<false>(p, raw, b, h * 64 + lc8, c * CH + ltt);
        for (int sub = 0; sub < CH / TS; ++sub) {
            __syncthreads();
            scanL_store<false, TS>(raw, parl, su, nullptr, ltt, lc8, false);
            __syncthreads();
            if (sub + 1 < CH / TS) scanL_issue<false>(p, raw, b, h * 64 + lc8, c * CH + (sub + 1) * TS + ltt);
            if (real) scanL_run<2, false, true, TS>(su, S, r, g, rowbase); else scanL_run<2, false, false, TS>(su, S, r, g, rowbase);
        }
        float* dst = (real ? LST : PST) + ((size_t)((b * NCH + c) * 8 + h)) * 4096 + 16 * g;
#pragma unroll
        for (int j = 0; j < 2; ++j) { float* d = dst + (rowbase + 16 * j + r) * 64;
#pragma unroll
            for (int i = 0; i < 4; ++i) *(f32x4*)(d + 4 * i) = (f32x4){S[j][2 * i][0], S[j][2 * i][1], S[j][2 * i + 1][0], S[j][2 * i + 1][1]}; }
    }
}
__device__ __forceinline__ void scanL_pass3(const Params& p, float* sm, int wave) {
    constexpr int TS = 16, AS = TS * 64, SLOT = 7 * AS, NQ = BATCH * NCH * 8 / 4;
    const float* LST = (const float*)(p.ws + WS_LST); const bf16* GG = (const bf16*)(p.ws + WS_GG); bf16* MIX = (bf16*)(p.ws + WS_MIX);
    const float* ln_w = inp(17); const float* ln_b = inp(18);
    const int lane = lane_id(), tid = (wave << 6) | lane, r = lane & 15, g = lane >> 4, u4 = wave >> 1, rowbase = (wave & 1) * 32;
    float* su = sm + u4 * SLOT; float* bcl = sm + 4 * SLOT + u4 * TS;
    const int tt = (tid >> 3) & 15, c8 = (tid & 7) * 8;
    for (int uq = blockIdx.x; uq < NQ; uq += gridDim.x) {
        const int u = 4 * uq + u4, h = u & 7, bc = u >> 3, c = bc % NCH, b = bc / NCH, hc = h * 64 + c8;
        f32x2 S[2][8];
#pragma unroll
        for (int j = 0; j < 2; ++j) {
            if (c > 0) { const float* src = LST + ((size_t)((b * NCH + c - 1) * 8 + h)) * 4096 + (rowbase + 16 * j + r) * 64 + 16 * g;
#pragma unroll
                for (int i = 0; i < 4; ++i) { const f32x4 s4 = *(const f32x4*)(src + 4 * i); S[j][2 * i] = LO2(s4); S[j][2 * i + 1] = HI2(s4); } }
            else {
#pragma unroll
                for (int i = 0; i < 8; ++i) S[j][i] = (f32x2){0.f, 0.f}; } }
        float* parl = sm + 4 * SLOT + 64 + u4 * 512;
        __syncthreads();
        if (tt == 0) scanL_params(parl, hc, c8);
        ScanRaw raw; scanL_issue<true>(p, raw, b, hc, c * CH + tt);
        for (int sub = 0; sub < CH / TS; ++sub) {
            __syncthreads();
            scanL_store<true, TS>(raw, parl, su, bcl, tt, c8, (tid & 7) == 0);
            const v4u gv = raw.gv;
            __syncthreads();
            if (sub + 1 < CH / TS) scanL_issue<true>(p, raw, b, hc, c * CH + (sub + 1) * TS + tt);
            scanL_run<2, true, true, TS>(su, S, r, g, rowbase);
            __syncthreads();
            const int gr = b * SEQ + c * CH + sub * TS + tt;
            const f32x4 o0 = *(const f32x4*)(su + SC_O * AS + tt * 64 + c8), o1 = *(const f32x4*)(su + SC_O * AS + tt * 64 + c8 + 4);
            const f32x4 v0 = *(const f32x4*)(su + SC_V * AS + tt * 64 + c8), v1 = *(const f32x4*)(su + SC_V * AS + tt * 64 + c8 + 4);
            const float bcv = bcl[tt];
            float mu = ((o0[0] + o0[1]) + (o0[2] + o0[3])) + ((o1[0] + o1[1]) + (o1[2] + o1[3])); mu = sum8(mu) * (1.0f / 64.0f);
            const f32x4 e0 = o0 - mu, e1 = o1 - mu;
            float var = ((e0[0] * e0[0] + e0[1] * e0[1]) + (e0[2] * e0[2] + e0[3] * e0[3])) + ((e1[0] * e1[0] + e1[1] * e1[1]) + (e1[2] * e1[2] + e1[3] * e1[3])); var = sum8(var) * (1.0f / 64.0f);
            const float rs = 1.0f / sqrtf(var + 64e-5f);
            const f32x4 lw0 = *(const f32x4*)(parl + 384 + c8), lw1 = *(const f32x4*)(parl + 388 + c8), lb0 = *(const f32x4*)(parl + 448 + c8), lb1 = *(const f32x4*)(parl + 452 + c8);
            f32x4 y0 = (e0 * rs) * lw0 + lb0 + v0 * bcv, y1 = (e1 * rs) * lw1 + lb1 + v1 * bcv;
            y0[0] *= bflo(gv[0]); y0[1] *= bfhi(gv[0]); y0[2] *= bflo(gv[1]); y0[3] *= bfhi(gv[1]); y1[0] *= bflo(gv[2]); y1[1] *= bfhi(gv[2]); y1[2] *= bflo(gv[3]); y1[3] *= bfhi(gv[3]);
            v4u w; w.x = cvt_pk_bf16(y0[0], y0[1]); w.y = cvt_pk_bf16(y0[2], y0[3]); w.z = cvt_pk_bf16(y1[0], y1[1]); w.w = cvt_pk_bf16(y1[2], y1[3]);
            *(v4u*)(MIX + (size_t)gr * DM + hc) = w;
        }
    }
}

__device__ __forceinline__ void scan_pass2(const Params& p, float* sm, int wave) {
    const float* PST = (const float*)(p.ws + WS_PST); float* LST = (float*)(p.ws + WS_LST);
    const int lane = lane_id(), tid = (wave << 6) | lane, vb = (blockIdx.x & 7) * (gridDim.x >> 3) + (blockIdx.x >> 3);
    if (vb >= 128) return;
    const int chain = vb >> 3, row = (vb & 7) * 8 + wave, b = chain >> 3, h = chain & 7;
    float* Pb = sm; float* Sw = sm + 8192 + wave * 64;
    constexpr int NS = NCH - 1;
#define UOFF(c) ((size_t)((b * NCH + (c)) * 8 + h) * 4096)
#define LDP(X0, X1, LX, c) do { X0 = *(const f32x4*)(PST + UOFF(c) + tid * 8); X1 = *(const f32x4*)(PST + UOFF(c) + tid * 8 + 4); LX = LST[UOFF(c) + row * 64 + lane]; } while (0)
    f32x4 A0, A1, B0, B1, C0, C1; float LA = 0.f, LB = 0.f, LC = 0.f, Lcur;
    __syncthreads();
    LDP(A0, A1, LA, 0);
    *(f32x4*)(Pb + tid * 8) = A0; *(f32x4*)(Pb + tid * 8 + 4) = A1; Lcur = LA;
    Sw[lane] = 0.f;
    LDP(B0, B1, LB, 1); LDP(C0, C1, LC, 2); LDP(A0, A1, LA, 3);
    __syncthreads();
#define P2STEP(c, X0, X1, LX) do { float Lnx = 0.f; \
        if ((c) + 1 < NS) { float* Pn = Pb + (((c) + 1) & 1) * 4096; *(f32x4*)(Pn + tid * 8) = X0; *(f32x4*)(Pn + tid * 8 + 4) = X1; Lnx = LX; } \
        if ((c) + 4 < NS) LDP(X0, X1, LX, (c) + 4); \
        const float* Pc = Pb + ((c) & 1) * 4096 + lane; float a0 = 0.f, a1 = 0.f, a2 = 0.f, a3 = 0.f; \
        _Pragma("unroll") for (int i = 0; i < 64; i += 4) { const f32x4 s4 = *(const f32x4*)(Sw + i); \
            a0 += s4[0] * Pc[(i + 0) * 64]; a1 += s4[1] * Pc[(i + 1) * 64]; a2 += s4[2] * Pc[(i + 2) * 64]; a3 += s4[3] * Pc[(i + 3) * 64]; } \
        const float sn = ((a0 + a1) + (a2 + a3)) + Lcur; LST[UOFF(c) + row * 64 + lane] = sn; Sw[lane] = sn; Lcur = Lnx; \
        __syncthreads(); } while (0)
    for (int c = 0; c < NS; c += 3) { P2STEP(c, B0, B1, LB); P2STEP(c + 1, C0, C1, LC); P2STEP(c + 2, A0, A1, LA); }
    static_assert(NS % 3 == 0, "pass 2 is unrolled by 3");
#undef P2STEP
#undef LDP
#undef UOFF
}
__device__ __forceinline__ void scan_pass3(const Params& p, float* sm, int wave, int lane) {
    const float* LST = (const float*)(p.ws + WS_LST); const bf16* GG = (const bf16*)(p.ws + WS_GG); bf16* MIX = (bf16*)(p.ws + WS_MIX);
    const float* ln_w = inp(17); const float* ln_b = inp(18);
    const int tid = TIDX, cs = lane & 15, rg = lane >> 4, rowbase = wave * 8 + rg * 2;
    constexpr int NU = BATCH * NCH * 8;
    for (int u = blockIdx.x; u < NU; u += gridDim.x) {
        const int h = u & 7, bc = u >> 3, c = bc % NCH, b = bc / NCH;
        f32x2 S[2][2];
        if (c > 0) { const float* src = LST + ((size_t)((b * NCH + c - 1) * 8 + h)) * 4096 + rowbase * 64 + 4 * cs;
#pragma unroll
            for (int j = 0; j < 2; ++j) { const f32x4 s4 = *(const f32x4*)(src + j * 64); S[j][0] = LO2(s4); S[j][1] = HI2(s4); } }
        else {
#pragma unroll
            for (int j = 0; j < 2; ++j) { S[j][0] = (f32x2){0.f, 0.f}; S[j][1] = (f32x2){0.f, 0.f}; } }
        for (int sub = 0; sub < 2; ++sub) {
            __syncthreads();
            scan_load<true>(p, sm, b, h, c * CH + sub * 64, wave);
            __syncthreads();
            scan_run<2, true, true>(sm, S, cs, rowbase);
            __syncthreads();
            const int tt = tid >> 3, c8 = (tid & 7) * 8, hc = h * 64 + c8; const int gr = b * SEQ + c * CH + sub * 64 + tt;
            const f32x4 o0 = *(const f32x4*)(sm + SC_O * 4096 + tt * 64 + c8), o1 = *(const f32x4*)(sm + SC_O * 4096 + tt * 64 + c8 + 4);
            const f32x4 v0 = *(const f32x4*)(sm + SC_V * 4096 + tt * 64 + c8), v1 = *(const f32x4*)(sm + SC_V * 4096 + tt * 64 + c8 + 4);
            const float bcv = sm[SC_BC * 4096 + tt];
            float mu = ((o0[0] + o0[1]) + (o0[2] + o0[3])) + ((o1[0] + o1[1]) + (o1[2] + o1[3])); mu = sum8(mu) * (1.0f / 64.0f);
            const f32x4 e0 = o0 - mu, e1 = o1 - mu;
            float var = ((e0[0] * e0[0] + e0[1] * e0[1]) + (e0[2] * e0[2] + e0[3] * e0[3])) + ((e1[0] * e1[0] + e1[1] * e1[1]) + (e1[2] * e1[2] + e1[3] * e1[3])); var = sum8(var) * (1.0f / 64.0f);
            const float rs = 1.0f / sqrtf(var + 64e-5f);
            const f32x4 lw0 = *(const f32x4*)(ln_w + hc), lw1 = *(const f32x4*)(ln_w + hc + 4), lb0 = *(const f32x4*)(ln_b + hc), lb1 = *(const f32x4*)(ln_b + hc + 4);
            const v4u gv = *(const v4u*)(GG + (size_t)gr * RW + hc);
            f32x4 y0 = (e0 * rs) * lw0 + lb0 + v0 * bcv, y1 = (e1 * rs) * lw1 + lb1 + v1 * bcv;
            y0[0] *= bflo(gv[0]); y0[1] *= bfhi(gv[0]); y0[2] *= bflo(gv[1]); y0[3] *= bfhi(gv[1]); y1[0] *= bflo(gv[2]); y1[1] *= bfhi(gv[2]); y1[2] *= bflo(gv[3]); y1[3] *= bfhi(gv[3]);
            v4u w; w.x = cvt_pk_bf16(y0[0], y0[1]); w.y = cvt_pk_bf16(y0[2], y0[3]); w.z = cvt_pk_bf16(y1[0], y1[1]); w.w = cvt_pk_bf16(y1[2], y1[3]);
            *(v4u*)(MIX + (size_t)gr * DM + hc) = w;
        }
    }
}

constexpr int AT_KS = 0, AT_VT = 256 * 72 * 2, AT_PS = AT_VT + 64 * 280 * 2, AT_PSW = 16 * 168 * 2;
__device__ __forceinline__ void attn_phase(const Params& p, unsigned char* lds, int wave, int lane) {
    const bf16* P = (const bf16*)(p.ws + WS_BIG); bf16* MIX = (bf16*)(p.ws + WS_MIX); const float* sinks = inp(19);
    const int tid = TIDX; bf16* Ks = (bf16*)(lds + AT_KS); bf16* Vt = (bf16*)(lds + AT_VT); bf16* Ps = (bf16*)(lds + AT_PS + wave * AT_PSW);
    const int fr = lane & 15, fq = lane >> 4;
    const int vb_ = (blockIdx.x & 7) * (gridDim.x >> 3) + (blockIdx.x >> 3);
    for (int u = vb_ - 128; u >= 0 && u < BATCH * 64 * 2; u += 128) {
        const int g = u & 1, qb = (u >> 1) & 63, b = u >> 7, q0 = qb * 128;
        __syncthreads();
        { const int key = tid >> 1, half = tid & 1; const bool valid = (qb > 0) || (key >= 128);
          const bf16* src = P + (size_t)(b * SEQ + q0 - 128 + key) * NIN + 1792 + 512 + g * 64 + half * 32;
#pragma unroll
          for (int i = 0; i < 4; ++i) { v4u kx = (v4u){0u, 0u, 0u, 0u}, vx = kx; if (valid) { kx = *(const v4u*)(src + 8 * i); vx = *(const v4u*)(src + 128 + 8 * i); }
              *(v4u*)(Ks + key * 72 + half * 32 + 8 * i) = kx;
#pragma unroll
              for (int e = 0; e < 4; ++e) { const int d = half * 32 + 8 * i + 2 * e; Vt[d * 280 + key] = (bf16)(vx[e] & 0xffffu); Vt[(d + 1) * 280 + key] = (bf16)(vx[e] >> 16); } }
          if (tid < 64 * 3) { const int d = tid / 3, part = tid % 3; *(v4u*)(Vt + d * 280 + 256 + 8 * part) = (v4u){0u, 0u, 0u, 0u}; } }
        __syncthreads();
        for (int hq4 = 0; hq4 < 4; ++hq4) {
            const int hq = g * 4 + hq4; const float sink = sinks[hq];
            const bf16* qp = P + (size_t)(b * SEQ + q0 + 16 * wave + fr) * NIN + 1792 + hq * 64 + 8 * fq;
            const bf16x8 qa0 = *(const bf16x8*)qp, qa1 = *(const bf16x8*)(qp + 32);
            f32x4 sc[9]; float mx[4] = {-1e30f, -1e30f, -1e30f, -1e30f};
#pragma unroll
            for (int nt = 0; nt < 9; ++nt) { const int jt = 16 * (wave + nt); const bf16* kp = Ks + (jt + fr) * 72 + 8 * fq;
                const bf16x8 kb0 = *(const bf16x8*)kp, kb1 = *(const bf16x8*)(kp + 32);
                f32x4 a = (f32x4){0.f, 0.f, 0.f, 0.f}; a = __builtin_amdgcn_mfma_f32_16x16x32_bf16(qa0, kb0, a, 0, 0, 0); a = __builtin_amdgcn_mfma_f32_16x16x32_bf16(qa1, kb1, a, 0, 0, 0);
                const int j = jt + fr;
#pragma unroll
                for (int r = 0; r < 4; ++r) { const int i = 16 * wave + 4 * fq + r, dist = i + 128 - j; const bool ok = (dist >= 0) && (dist < 128) && ((qb > 0) || (j >= 128));
                    a[r] = ok ? a[r] * 0.125f : -1e30f; mx[r] = fmaxf(mx[r], a[r]); }
                sc[nt] = a; }
            float sm_[4];
#pragma unroll
            for (int r = 0; r < 4; ++r) { mx[r] = fmaxf(max16(mx[r]), sink); sm_[r] = 0.f; }
#pragma unroll
            for (int nt = 0; nt < 9; ++nt) {
#pragma unroll
                for (int r = 0; r < 4; ++r) { const float e = __expf(sc[nt][r] - mx[r]); sm_[r] += e; Ps[(4 * fq + r) * 168 + nt * 16 + fr] = (bf16)(cvt_pk_bf16(e, 0.f) & 0xffffu); } }
#pragma unroll
            for (int r = 0; r < 4; ++r) { Ps[(4 * fq + r) * 168 + 144 + fr] = 0; sm_[r] = 1.0f / (sum16(sm_[r]) + __expf(sink - mx[r])); }
            __builtin_amdgcn_fence(__ATOMIC_RELEASE, "wavefront"); asm volatile("s_waitcnt lgkmcnt(0)" ::: "memory");
            f32x4 o[4];
#pragma unroll
            for (int dt = 0; dt < 4; ++dt) o[dt] = (f32x4){0.f, 0.f, 0.f, 0.f};
#pragma unroll
            for (int ks = 0; ks < 5; ++ks) { const bf16x8 pa = *(const bf16x8*)(Ps + fr * 168 + ks * 32 + 8 * fq);
#pragma unroll
                for (int dt = 0; dt < 4; ++dt) { const bf16x8 vb = *(const bf16x8*)(Vt + (dt * 16 + fr) * 280 + 16 * wave + ks * 32 + 8 * fq);
                    o[dt] = __builtin_amdgcn_mfma_f32_16x16x32_bf16(pa, vb, o[dt], 0, 0, 0); } }
            bf16* op = MIX + (size_t)(b * SEQ + q0 + 16 * wave + 4 * fq) * DM + 512 + hq * 64 + fr;
#pragma unroll
            for (int r = 0; r < 4; ++r)
#pragma unroll
                for (int dt = 0; dt < 4; ++dt) op[(size_t)r * DM + dt * 16] = (bf16)(cvt_pk_bf16(o[dt][r] * sm_[r], 0.f) & 0xffffu);
            asm volatile("s_waitcnt lgkmcnt(0)" ::: "memory");
        }
    }
}

__device__ __forceinline__ void final_norm(const Params& p, int wave, int lane) {
    const float* ss3 = (const float*)(p.ws + WS_SS) + (size_t)3 * M * 16; const float* gf = inp(25);
    const int gw = blockIdx.x * NWAVES + wave, NGW = gridDim.x * NWAVES;
    f32x4 gfv[4];
#pragma unroll
    for (int j = 0; j < 4; ++j) gfv[j] = ((const f32x4*)gf)[lane + 64 * j];
    for (int m = gw; m < M; m += NGW) { const float rs = pg8::row_rstd(ss3, m); f32x4* xr = (f32x4*)(p.out + (size_t)m * DM) + lane;
#pragma unroll
        for (int j = 0; j < 4; ++j) { const f32x4 v = xr[64 * j]; xr[64 * j] = v * rs * gfv[j]; } }
}


#define XB_TMO      128
#define XB_XCNT(j)  (256  + 64 * (j))
#define XB_XSUB(j)  (1280 + 64 * (j))
#define XB_XGEN(j)  (2304 + 64 * (j))
#define XB_TOP      3328
#define XB_TOPGEN   3392
#define XCD_BAR_WORDS 3456
#define XB_SPIN_CAP (1u << 18)

__device__ __forceinline__ unsigned xb_ld(unsigned* p)              { return __hip_atomic_load(p, __ATOMIC_RELAXED, __HIP_MEMORY_SCOPE_AGENT); }
__device__ __forceinline__ unsigned xb_add(unsigned* p, unsigned v) { return __hip_atomic_fetch_add(p, v, __ATOMIC_RELAXED, __HIP_MEMORY_SCOPE_AGENT); }
__device__ __forceinline__ unsigned xb_xcc_id() { return (unsigned)__builtin_amdgcn_s_getreg((3 << 11) | 20) & 0xFu; }
#define XB_SPIN(cond, bar) do { unsigned _sp = 0; while (cond) { __builtin_amdgcn_s_sleep(1); \
    if ((++_sp & 255u) == 0u) { if (xb_ld(&(bar)[XB_TMO])) break; if (_sp > XB_SPIN_CAP) { atomicAdd(&(bar)[XB_TMO], 1u); break; } } } } while (0)

struct XcdBarrier {
    unsigned* bar; unsigned x;
    volatile LAS unsigned* st; int wave;
};

__device__ __forceinline__ XcdBarrier xcd_barrier_post(unsigned* bar, volatile LAS unsigned* st, int wave) {
    XcdBarrier b; b.bar = bar; b.x = xb_xcc_id(); b.st = st; b.wave = wave;
    if (wave == 0 && lane_id() == 0) (void)xb_add(&bar[XB_XCNT(b.x)], 1u);
    return b;
}
__device__ __forceinline__ void xcd_barrier_complete(unsigned* bar, unsigned x, unsigned& nloc, unsigned& nx) {
    const unsigned G = gridDim.x * gridDim.y * gridDim.z;
    unsigned sum, cnt, mine, sp = 0u;
    for (;;) {
        sum = 0u; cnt = 0u; mine = 0u;
#pragma unroll
        for (unsigned j = 0; j < 16; ++j) { const unsigned c = xb_ld(&bar[XB_XCNT(j)]); sum += c; cnt += (c > 0u) ? 1u : 0u; mine = (j == x) ? c : mine; }
        if (sum == G) break;
        __builtin_amdgcn_s_sleep(1);
        if ((++sp & 255u) == 0u) { if (xb_ld(&bar[XB_TMO])) break; if (sp > XB_SPIN_CAP) { atomicAdd(&bar[XB_TMO], 1u); break; } }
    }
    nloc = mine > 0u ? mine : 1u; nx = cnt > 0u ? cnt : 1u;
}

__device__ __forceinline__ void xcd_barrier(const XcdBarrier& b) {
    asm volatile("s_waitcnt vmcnt(0)" ::: "memory");
    __syncthreads();
    if (b.wave == 0 && lane_id() == 0) {
        unsigned* bar = b.bar;
        __builtin_amdgcn_s_waitcnt(0);
        unsigned nloc = b.st[0], nx = b.st[1];
        if (nloc == 0u) { xcd_barrier_complete(bar, b.x, nloc, nx); b.st[0] = nloc; b.st[1] = nx; }
        const unsigned old = xb_add(&bar[XB_XSUB(b.x)], 1u);
        const unsigned gen = old / nloc;
        if (old + 1u == (gen + 1u) * nloc) {
            __builtin_amdgcn_fence(__ATOMIC_RELEASE, "agent");
            asm volatile("s_waitcnt vmcnt(0)" ::: "memory");
            const unsigned og = xb_add(&bar[XB_TOP], 1u);
            const unsigned tg = og / nx;
            if (og + 1u == (tg + 1u) * nx) xb_add(&bar[XB_TOPGEN], 1u);
            else XB_SPIN(xb_ld(&bar[XB_TOPGEN]) == tg, bar);
            __builtin_amdgcn_fence(__ATOMIC_ACQUIRE, "agent");
            xb_add(&bar[XB_XGEN(b.x)], 1u);
            asm volatile("s_waitcnt vmcnt(0)" ::: "memory");
        } else {
            XB_SPIN(xb_ld(&bar[XB_XGEN(b.x)]) == gen, bar);
            __builtin_amdgcn_fence(__ATOMIC_ACQUIRE, "agent");
            asm volatile("s_waitcnt vmcnt(0)" ::: "memory");
        }
    }
    __syncthreads();
}

constexpr int LDS_BYTES = 147456;
constexpr int NPHASE = 12;
#ifndef DUPMASK
#define DUPMASK 0
#endif
__global__ void __launch_bounds__(NTHR, 2) hymba_fwd(Params p) {
    extern __shared__ __attribute__((aligned(16))) unsigned char lds[];
    cg::grid_group grid = cg::this_grid();
    const int wave = __builtin_amdgcn_readfirstlane((int)threadIdx.x >> 6); const int lane = lane_id(); const int tid = (wave << 6) | lane;
    unsigned char* ws = p.ws;
    PG8_LAS unsigned char* lds3 = (PG8_LAS unsigned char*)lds;
    float* ss = (float*)(ws + WS_SS);
    bf16* XB = (bf16*)(ws + WS_XB); bf16* ACT = (bf16*)(ws + WS_BIG); bf16* PB = (bf16*)(ws + WS_BIG);
    const int lo = p.ph_lo, hi = p.ph_hi;
#define IN(k) (lo <= (k) && (k) < hi)
#define REP(k) for (int rep_ = 0; rep_ < 1 + ((DUPMASK >> (k)) & 1); ++rep_)
#ifndef DUPBAR
#define DUPBAR 0
#endif
#define SEAM(k) do { if (IN(k) && IN((k) + 1)) { for (int rb_ = 0; rb_ <= DUPBAR; ++rb_) xcd_barrier(xbar); } } while (0)
    unsigned* bctr = (unsigned*)(ws + WS_CTL);
    volatile LAS unsigned* misc = (volatile LAS unsigned*)(lds3 + 131072 + 1024);
    if (wave == 0 && lane < 2) misc[lane] = 0u;
    if (blockIdx.x == 0) for (int i = tid; i < XCD_BAR_WORDS; i += NTHR) __hip_atomic_store(bctr + i, 0u, __ATOMIC_RELAXED, __HIP_MEMORY_SCOPE_AGENT);
    if (IN(0)) REP(0) { p0_prologue(p, lds, wave, lane_id()); p0_late_weights(p, lds, wave, lane_id(), blockIdx.x, gridDim.x); }
    grid.sync();
    XcdBarrier xbar = xcd_barrier_post(bctr, misc, wave);
    if (IN(1)) REP(1) { pg8::Gemm g{XB, (const bf16*)(ws + WS_WGU1), M, 2 * FF, DM}; pg8::StaticOrder S; S.init(M, 2 * FF, gridDim.x, blockIdx.x);
        pg8::EpiSwiGLU E{ACT, ss, FF}; pg8::gemm_phase<pg8::EpiSwiGLU, pg8::StaticOrder, true, true>(lds3, g, S, E, wave); } SEAM(1);
    if (IN(2)) REP(2) { pg8::Gemm g{ACT, (const bf16*)(ws + WS_WD1), M, DM, FF}; pg8::StaticOrder S; S.init(M, DM, gridDim.x, blockIdx.x);
        pg8::EpiRes E{inp(0), p.out, XB, ss + (size_t)M * 16, 0.5f}; pg8::gemm_phase<pg8::EpiRes, pg8::StaticOrder, true, true>(lds3, g, S, E, wave); } SEAM(2);
    if (IN(3)) REP(3) { pg8::Gemm g{XB, (const bf16*)(ws + WS_WIN), M, NIN, DM}; pg8::StaticOrder S; S.init(M, NIN, gridDim.x, blockIdx.x);
        pg8::EpiWin E{PB, ss + (size_t)M * 16, inp(7), 1792, NIN}; pg8::gemm_phase<pg8::EpiWin, pg8::StaticOrder, true, true>(lds3, g, S, E, wave); } SEAM(3);
    if (IN(4)) REP(4) { r1_phase(p, wave); } SEAM(4);
    if (IN(5)) REP(5) { pg8::Gemm g{(const bf16*)(ws + WS_LIN), (const bf16*)(ws + WS_WL), M, 1536, 256}; pg8::StaticOrder S; S.init(M, 1536, gridDim.x, blockIdx.x);
        pg8::EpiLora E{(float*)(ws + WS_DEC), (bf16*)(ws + WS_AA), (bf16*)(ws + WS_GG), inp(9), inp(11)}; pg8::gemm_phase<pg8::EpiLora, pg8::StaticOrder, true, true>(lds3, g, S, E, wave); } SEAM(5);
    if (IN(6)) REP(6) { scanL_pass1(p, (float*)lds, wave); } SEAM(6);
    if (IN(7)) REP(7) { scan_pass2(p, (float*)lds, wave); attn_phase(p, lds, wave, lane_id()); } SEAM(7);
    if (IN(8)) REP(8) { scanL_pass3(p, (float*)lds, wave); __syncthreads(); } SEAM(8);
    if (IN(9)) REP(9) { pg8::Gemm g{(const bf16*)(ws + WS_MIX), (const bf16*)(ws + WS_WOUT), M, DM, DM}; pg8::StaticOrder S; S.init(M, DM, gridDim.x, blockIdx.x);
        pg8::EpiRes E{p.out, p.out, XB, ss + (size_t)2 * M * 16, 1.0f}; pg8::gemm_phase<pg8::EpiRes, pg8::StaticOrder, true, true>(lds3, g, S, E, wave); } SEAM(9);
    if (IN(10)) REP(10) { pg8::Gemm g{XB, (const bf16*)(ws + WS_WGU2), M, 2 * FF, DM}; pg8::StaticOrder S; S.init(M, 2 * FF, gridDim.x, blockIdx.x);
        pg8::EpiSwiGLU E{ACT, ss + (size_t)2 * M * 16, FF}; pg8::gemm_phase<pg8::EpiSwiGLU, pg8::StaticOrder, true, true>(lds3, g, S, E, wave); } SEAM(10);
    if (IN(11)) REP(11) { pg8::Gemm g{ACT, (const bf16*)(ws + WS_WD2), M, DM, FF}; pg8::StaticOrder S; S.init(M, DM, gridDim.x, blockIdx.x);
        pg8::EpiRes E{p.out, p.out, nullptr, ss + (size_t)3 * M * 16, 0.5f}; pg8::gemm_phase<pg8::EpiRes, pg8::StaticOrder, true, true>(lds3, g, S, E, wave); } SEAM(11);
    if (IN(12)) REP(12) { final_norm(p, wave, lane_id()); }
#undef IN
#undef SEAM
}

extern "C" void kernel_launch(void* const* d_in, const int* in_sizes, int n_in, void* d_out, int out_size, void* d_ws, size_t ws_size, hipStream_t stream) {
    static int grid = 0;
    if (grid == 0) {
        if (n_in != 26 || out_size != M * DM || ws_size < WS_END) { fprintf(stderr, "kernel_launch: unexpected sizes n_in %d out %d ws %zu\n", n_in, out_size, ws_size); grid = -1; return; }
        int dev = 0, cus = 0, per_cu = 0;
        hipGetDevice(&dev); hipDeviceGetAttribute(&cus, hipDeviceAttributeMultiprocessorCount, dev);
        hipFuncSetAttribute((const void*)hymba_fwd, hipFuncAttributeMaxDynamicSharedMemorySize, LDS_BYTES);
        hipOccupancyMaxActiveBlocksPerMultiprocessor(&per_cu, (const void*)hymba_fwd, NTHR, LDS_BYTES);
        (void)hipGetLastError();
        if (per_cu < 1) per_cu = 1;
        grid = cus * per_cu; if (grid > 256) grid = 256;
        if (grid != 256) fprintf(stderr, "kernel_launch: grid %d (cus %d per_cu %d), kernel assumes 256\n", grid, cus, per_cu);
    }
    if (grid < 0) return;
    Params p{};
    for (int i = 0; i < 26; ++i) p.in[i] = (const float*)d_in[i];
    p.out = (float*)d_out; p.ws = (unsigned char*)d_ws; p.ph_lo = 0; p.ph_hi = NPHASE + 1;
    void* args[] = {&p};
    hipError_t e = hipLaunchCooperativeKernel((const void*)hymba_fwd, dim3(grid), dim3(NTHR), args, LDS_BYTES, stream);
    if (e != hipSuccess) fprintf(stderr, "cooperative launch failed: %s (grid %d)\n", hipGetErrorString(e), grid);
}
```

```cpp
#include <hip/hip_runtime.h>
#include <hip/hip_cooperative_groups.h>
#include <cstdio>
#include <cstdint>
namespace cg = cooperative_groups;
namespace pg8 {
#define PG8_LAS __attribute__((address_space(3)))
typedef unsigned short bf16_t;
typedef short bf16x8 __attribute__((ext_vector_type(8)));
typedef float f32x4 __attribute__((ext_vector_type(4)));
typedef unsigned u32x4 __attribute__((ext_vector_type(4)));
constexpr int BM = 256, BK = 64, HALF = 128, HTB = HALF * BK * 2  , STAGE_BYTES = 8 * HTB, NXCD = 8, WGM = 8;

__host__ __device__ __forceinline__ int lds_byte(int r, int c) { const int st = (r >> 4) * 2 + (c >> 5), rr = r & 15, cc = c & 31, ob = rr * 64 + cc * 2; return st * 1024 + (ob ^ (((ob >> 9) & 1) << 5)); }
__host__ __device__ __forceinline__ void stage_rc(int b, int& R, int& C) { const int st = b / 1024, sb = b % 1024, swz = sb ^ (((sb >> 9) & 1) << 5); R = (st >> 1) * 16 + swz / 64; C = (st & 1) * 32 + (swz % 64) / 2; }
__host__ __device__ __forceinline__ int perm32(int rho) { const int n = rho >> 4, i = rho & 15; return 8 * (i >> 2) + 4 * n + (i & 3); }

struct Unit { int pm, pn; };
struct Gemm { const bf16_t* A; const bf16_t* Bt; int M, N, K; };

struct StaticOrder {
    int nM, nN, nwg, G, c;
    __host__ __device__ void init(int M, int N, int G_, int c_) { nM = M / BM; nN = N / BM; nwg = nM * nN; G = G_; c = c_; }
    __host__ __device__ bool next(int i, Unit& u) const {
        const long L = (long)i * G + c; if (L >= nwg) return false;
        int wgid = (int)L; { const int q = nwg / NXCD, r = nwg % NXCD, xcd = wgid % NXCD, off = wgid / NXCD; wgid = (xcd < r ? xcd * (q + 1) : r * (q + 1) + (xcd - r) * q) + off; }
        const int nig = WGM * nN, gid = wgid / nig, fm = gid * WGM, gsz = (nM - fm) < WGM ? (nM - fm) : WGM;
        u.pm = fm + ((wgid % nig) % gsz); u.pn = (wgid % nig) / gsz; return true;
    }
    __device__ __forceinline__ void a_ready(const Unit&) const {}
    __device__ __forceinline__ void done(const Unit&) const {}
};

typedef float f32x2 __attribute__((ext_vector_type(2)));
typedef __bf16 bf16x2_t __attribute__((ext_vector_type(2)));
typedef unsigned u32x2 __attribute__((ext_vector_type(2)));
__device__ __forceinline__ unsigned cvt_pk_bf16(float lo, float hi) { f32x2 v = {lo, hi}; bf16x2_t b = __builtin_convertvector(v, bf16x2_t); return __builtin_bit_cast(unsigned, b); }
__device__ __forceinline__ float row_rstd(const float* ss, int row) {
    const f32x4* p = (const f32x4*)(ss + (size_t)row * 16); const f32x4 a = p[0], b = p[1], c = p[2], d = p[3];
    const float s = (((a[0] + a[1]) + (a[2] + a[3])) + ((b[0] + b[1]) + (b[2] + b[3]))) + (((c[0] + c[1]) + (c[2] + c[3])) + ((d[0] + d[1]) + (d[2] + d[3])));
    return 1.0f / sqrtf(s * (1.0f / 1024.0f) + 1e-5f);
}
__device__ __forceinline__ float silu_mul(float g, float u) { return g * __builtin_amdgcn_rcpf(1.0f + __expf(-g)) * u; }

struct EpiSwiGLU {
    static constexpr bool PERM = true, AFTER_DRAIN = false;
    bf16_t* O; const float* ss; int ldo;
    __device__ __forceinline__ void operator()(const f32x4 (&acc)[2][2][4][2], const Unit& u, int wr, int wc, int fr, int fq) const {
        const int row0 = u.pm * BM + wr * 64 + fr; const int col0 = u.pn * HALF + wc * 32 + 8 * fq;
#pragma unroll
        for (int ai = 0; ai < 2; ++ai)
#pragma unroll
            for (int m = 0; m < 4; ++m) { const int row = row0 + ai * HALF + m * 16; const float rs = row_rstd(ss, row);
                const f32x4 g0 = acc[ai][0][m][0] * rs, g1 = acc[ai][0][m][1] * rs, u0 = acc[ai][1][m][0] * rs, u1 = acc[ai][1][m][1] * rs;
                u32x4 w; w.x = cvt_pk_bf16(silu_mul(g0[0], u0[0]), silu_mul(g0[1], u0[1])); w.y = cvt_pk_bf16(silu_mul(g0[2], u0[2]), silu_mul(g0[3], u0[3]));
                w.z = cvt_pk_bf16(silu_mul(g1[0], u1[0]), silu_mul(g1[1], u1[1])); w.w = cvt_pk_bf16(silu_mul(g1[2], u1[2]), silu_mul(g1[3], u1[3]));
                *(u32x4*)(O + (size_t)row * ldo + col0) = w; }
    }
};
struct EpiRes {
    static constexpr bool PERM = false, AFTER_DRAIN = false;
    const float* base; float* out; bf16_t* xb; float* ss; float alpha;
    __device__ __forceinline__ void operator()(const f32x4 (&acc)[2][2][4][2], const Unit& u, int wr, int wc, int fr, int fq) const {
        const int row0 = u.pm * BM + wr * 64 + fr; const int col0 = u.pn * BM + wc * 32 + 4 * fq;
#pragma unroll
        for (int ai = 0; ai < 2; ++ai)
#pragma unroll
            for (int m = 0; m < 4; ++m) { const int row = row0 + ai * HALF + m * 16; const size_t off = (size_t)row * 1024 + col0; float sq = 0.f;
#pragma unroll
                for (int bj = 0; bj < 2; ++bj)
#pragma unroll
                    for (int n = 0; n < 2; ++n) { const f32x4 bs = *(const f32x4*)(base + off + bj * HALF + n * 16); const f32x4 o = bs + acc[ai][bj][m][n] * alpha;
                        *(f32x4*)(out + off + bj * HALF + n * 16) = o; sq += (o[0] * o[0] + o[1] * o[1]) + (o[2] * o[2] + o[3] * o[3]);
                        if (xb) { u32x2 w; w.x = cvt_pk_bf16(o[0], o[1]); w.y = cvt_pk_bf16(o[2], o[3]); *(u32x2*)(xb + off + bj * HALF + n * 16) = w; } }
                sq += __shfl_xor(sq, 16); sq += __shfl_xor(sq, 32);
                if (fq == 0) ss[(size_t)row * 16 + u.pn * 4 + wc] = sq; }
    }
};
struct EpiWin {
    static constexpr bool PERM = true, AFTER_DRAIN = false;
    bf16_t* O; const float* ss; const float* bias; int bias_from; int ldo;
    __device__ __forceinline__ void operator()(const f32x4 (&acc)[2][2][4][2], const Unit& u, int wr, int wc, int fr, int fq) const {
        const int row0 = u.pm * BM + wr * 64 + fr; const int col0 = u.pn * BM + wc * 32 + 8 * fq;
        f32x4 bv[2][2];
#pragma unroll
        for (int bj = 0; bj < 2; ++bj)
#pragma unroll
            for (int n = 0; n < 2; ++n) { const int c = col0 + bj * HALF + 4 * n; bv[bj][n] = (c >= bias_from) ? *(const f32x4*)(bias + (c - bias_from)) : (f32x4){0.f, 0.f, 0.f, 0.f}; }
#pragma unroll
        for (int ai = 0; ai < 2; ++ai)
#pragma unroll
            for (int m = 0; m < 4; ++m) { const int row = row0 + ai * HALF + m * 16; const float rs = row_rstd(ss, row);
#pragma unroll
                for (int bj = 0; bj < 2; ++bj) { const f32x4 v0 = acc[ai][bj][m][0] * rs + bv[bj][0], v1 = acc[ai][bj][m][1] * rs + bv[bj][1];
                    u32x4 w; w.x = cvt_pk_bf16(v0[0], v0[1]); w.y = cvt_pk_bf16(v0[2], v0[3]); w.z = cvt_pk_bf16(v1[0], v1[1]); w.w = cvt_pk_bf16(v1[2], v1[3]);
                    *(u32x4*)(O + (size_t)row * ldo + col0 + bj * HALF) = w; } }
    }
};
struct EpiLora {
    static constexpr bool PERM = true, AFTER_DRAIN = false;
    float* DEC; bf16_t* AA; bf16_t* GG; const float* w0; const float* a0;
    __device__ __forceinline__ void operator()(const f32x4 (&acc)[2][2][4][2], const Unit& u, int wr, int wc, int fr, int fq) const {
        const int row0 = u.pm * BM + wr * 64 + fr; const int kind = u.pn >> 1; const int col0 = (u.pn & 1) * BM + wc * 32 + 8 * fq;
#pragma unroll
        for (int bj = 0; bj < 2; ++bj) { const int c = col0 + bj * HALF;
            f32x4 b0 = (f32x4){0.f, 0.f, 0.f, 0.f}, b1 = b0;
            if (kind == 0) { b0 = *(const f32x4*)(w0 + c); b1 = *(const f32x4*)(w0 + c + 4); } else if (kind == 1) { b0 = *(const f32x4*)(a0 + c); b1 = *(const f32x4*)(a0 + c + 4); }
#pragma unroll
            for (int ai = 0; ai < 2; ++ai)
#pragma unroll
                for (int m = 0; m < 4; ++m) { const int row = row0 + ai * HALF + m * 16; f32x4 v0 = acc[ai][bj][m][0] + b0, v1 = acc[ai][bj][m][1] + b1;
                    if (kind == 0) {
#pragma unroll
                        for (int e = 0; e < 4; ++e) { v0[e] = expf(-0.60653065971f / (1.0f + expf(-v0[e]))); v1[e] = expf(-0.60653065971f / (1.0f + expf(-v1[e]))); }
                        *(f32x4*)(DEC + (size_t)row * 512 + c) = v0; *(f32x4*)(DEC + (size_t)row * 512 + c + 4) = v1;
                    } else {
                        if (kind == 1) {
#pragma unroll
                            for (int e = 0; e < 4; ++e) { v0[e] = 1.0f / (1.0f + expf(-v0[e])); v1[e] = 1.0f / (1.0f + expf(-v1[e])); } }
                        u32x4 w; w.x = cvt_pk_bf16(v0[0], v0[1]); w.y = cvt_pk_bf16(v0[2], v0[3]); w.z = cvt_pk_bf16(v1[0], v1[1]); w.w = cvt_pk_bf16(v1[2], v1[3]);
                        *(u32x4*)((kind == 1 ? AA : GG) + (size_t)row * 512 + c) = w; } }
        }
    }
};

template <class Epi, class Sched, bool ALIGN_EPI = false, bool SP2 = false>
__device__ __forceinline__ void gemm_phase(PG8_LAS unsigned char* lds, const Gemm g, const Sched& S, const Epi& E, const int wid) {
    const int lane = (int)__builtin_amdgcn_mbcnt_hi(~0u, __builtin_amdgcn_mbcnt_lo(~0u, 0u)), tid = (wid << 6) | lane, wr = wid >> 2, wc = wid & 3, fr = lane & 15, fq = lane >> 4;
    int K = g.K; asm volatile("" : "+s"(K)); const int nt = K / BK;
    unsigned voffA[2], voffB[2];
#pragma unroll
    for (int i = 0; i < 2; ++i) { int R, C; stage_rc(tid * 16 + i * 8192, R, C); const int Rb = Epi::PERM ? ((R & ~31) + perm32(R & 31)) : R;
        voffA[i] = (unsigned)(R * K + C) * 2u; voffB[i] = (unsigned)(Rb * K + C) * 2u; }
    const size_t kstep = (size_t)(BK * 2);
    const size_t hstep = (size_t)HALF * K * 2;
    const size_t tstep = 2 * hstep;
    const unsigned ldsw = (unsigned)wid * 1024u;
    const int aoff = lds_byte(wr * 64 + fr, fq * 8), boff = lds_byte(wc * 32 + fr, fq * 8);
#define PG8_SA(b, h) (((b) * 2 + (h)) * HTB)
#define PG8_SB(b, h) ((4 + (b) * 2 + (h)) * HTB)
#define PG8_STAGE(bufoff, gbase, voff) do { _Pragma("unroll") for (int _i = 0; _i < 2; ++_i) \
        __builtin_amdgcn_global_load_lds((const unsigned*)((const char*)(gbase) + (voff)[_i]), (PG8_LAS unsigned*)(lds + (bufoff) + ldsw + _i * 8192), 16, 0, 0); } while (0)
#define PG8_LDA(dst, b, h) do { _Pragma("unroll") for (int m = 0; m < 4; ++m) _Pragma("unroll") for (int k = 0; k < 2; ++k) dst[m][k] = *(const PG8_LAS bf16x8*)(lds + PG8_SA(b, h) + aoff + m * 2048 + k * 1024); } while (0)
#define PG8_LDB(dst, b, h) do { _Pragma("unroll") for (int n = 0; n < 2; ++n) _Pragma("unroll") for (int k = 0; k < 2; ++k) dst[n][k] = *(const PG8_LAS bf16x8*)(lds + PG8_SB(b, h) + boff + n * 2048 + k * 1024); } while (0)
#define PG8_MMA(ai, bj, At, Bt) do { __builtin_amdgcn_s_setprio(1); _Pragma("unroll") for (int m = 0; m < 4; ++m) _Pragma("unroll") for (int n = 0; n < 2; ++n) _Pragma("unroll") for (int k = 0; k < 2; ++k) \
        acc[ai][bj][m][n] = __builtin_amdgcn_mfma_f32_16x16x32_bf16(Bt[n][k], At[m][k], acc[ai][bj][m][n], 0, 0, 0); __builtin_amdgcn_s_setprio(0); } while (0)
#define PG8_WAIT_V(n) asm volatile("s_waitcnt vmcnt(" #n ")" ::: "memory")
#define PG8_WAIT_L(n) asm volatile("s_waitcnt lgkmcnt(" #n ")" ::: "memory")
#define PG8_BAR __builtin_amdgcn_s_barrier()
#define PG8_SCHED __builtin_amdgcn_sched_barrier(0)
    Unit cur, nxt; int ui = 0;
    if (!S.next(0, cur)) return;
    f32x4 acc[2][2][4][2];
#pragma unroll
    for (int a = 0; a < 2; ++a)
#pragma unroll
        for (int b = 0; b < 2; ++b)
#pragma unroll
            for (int m = 0; m < 4; ++m)
#pragma unroll
                for (int n = 0; n < 2; ++n) acc[a][b][m][n] = (f32x4){0.f, 0.f, 0.f, 0.f};
    bf16x8 At[4][2], B0[2][2], B1[2][2];
    const char* cA = (const char*)g.A + (size_t)cur.pm * tstep; const char* cB = (const char*)g.Bt + (size_t)cur.pn * tstep;
    S.a_ready(cur);
    if constexpr (SP2) {
        PG8_STAGE(PG8_SB(0, 0), cB, voffB); PG8_STAGE(PG8_SB(0, 1), cB + hstep, voffB); PG8_STAGE(PG8_SA(0, 0), cA, voffA); PG8_STAGE(PG8_SA(0, 1), cA + hstep, voffA);
        if (wr == 1) PG8_BAR;
        PG8_WAIT_V(2); PG8_BAR;
        PG8_STAGE(PG8_SB(1, 0), cB + kstep, voffB); PG8_STAGE(PG8_SA(1, 0), cA + kstep, voffA); PG8_STAGE(PG8_SB(1, 1), cB + hstep + kstep, voffB);
        PG8_WAIT_V(6); PG8_BAR;
    } else {
        PG8_STAGE(PG8_SB(0, 0), cB, voffB); PG8_STAGE(PG8_SA(0, 0), cA, voffA); PG8_STAGE(PG8_SB(0, 1), cB + hstep, voffB); PG8_STAGE(PG8_SA(0, 1), cA + hstep, voffA);
        if (wr == 1) PG8_BAR;
        PG8_WAIT_V(4); PG8_BAR;
        PG8_STAGE(PG8_SB(1, 0), cB + kstep, voffB); PG8_STAGE(PG8_SA(1, 0), cA + kstep, voffA); PG8_STAGE(PG8_SB(1, 1), cB + hstep + kstep, voffB);
        PG8_WAIT_V(6); PG8_BAR;
    }
    for (;;) {
        const bool has_next = S.next(ui + 1, nxt);
        const char* nA = has_next ? (const char*)g.A + (size_t)nxt.pm * tstep : cA; const char* nB = has_next ? (const char*)g.Bt + (size_t)nxt.pn * tstep : cB;
        for (int t = 0; t < nt; t += 2) {
            const bool last = (t == nt - 2);
            const char* a1 = cA + (size_t)(t + 1) * kstep;
            const char* a2 = last ? nA : cA + (size_t)(t + 2) * kstep; const char* b2 = last ? nB : cB + (size_t)(t + 2) * kstep;
            const char* a3 = a2 + kstep; const char* b3 = b2 + kstep;
            if (last && has_next) S.a_ready(nxt);
            if constexpr (SP2) {
            PG8_LDB(B0, 0, 0); PG8_LDB(B1, 0, 1); PG8_SCHED; PG8_LDA(At, 0, 0); PG8_STAGE(PG8_SA(1, 1), a1 + hstep, voffA);
            PG8_WAIT_V(8); PG8_WAIT_L(0); PG8_BAR; PG8_MMA(0, 0, At, B0); PG8_MMA(0, 1, At, B1); PG8_BAR; PG8_SCHED;
            PG8_LDA(At, 0, 1); PG8_STAGE(PG8_SB(0, 0), b2, voffB); PG8_STAGE(PG8_SB(0, 1), b2 + hstep, voffB); PG8_STAGE(PG8_SA(0, 0), a2, voffA);
            PG8_WAIT_V(8); PG8_WAIT_L(0); PG8_BAR; PG8_MMA(1, 0, At, B0); PG8_MMA(1, 1, At, B1); PG8_BAR; PG8_SCHED;
            PG8_LDB(B0, 1, 0); PG8_LDB(B1, 1, 1); PG8_SCHED; PG8_LDA(At, 1, 0); PG8_STAGE(PG8_SA(0, 1), a2 + hstep, voffA);
            PG8_WAIT_V(8); PG8_WAIT_L(0); PG8_BAR; PG8_MMA(0, 0, At, B0); PG8_MMA(0, 1, At, B1); PG8_BAR; PG8_SCHED;
            PG8_LDA(At, 1, 1); PG8_STAGE(PG8_SB(1, 0), b3, voffB); PG8_STAGE(PG8_SB(1, 1), b3 + hstep, voffB); PG8_STAGE(PG8_SA(1, 0), a3, voffA);
            PG8_WAIT_V(8); PG8_WAIT_L(0); PG8_BAR; PG8_MMA(1, 0, At, B0); PG8_MMA(1, 1, At, B1); PG8_BAR; PG8_SCHED;
            } else {
            PG8_LDB(B0, 0, 0); PG8_SCHED; PG8_LDA(At, 0, 0); PG8_STAGE(PG8_SA(1, 1), a1 + hstep, voffA);
            PG8_WAIT_L(8); PG8_BAR; PG8_WAIT_L(0); PG8_MMA(0, 0, At, B0); PG8_BAR; PG8_SCHED;
            PG8_LDB(B1, 0, 1); PG8_STAGE(PG8_SB(0, 0), b2, voffB);
            PG8_BAR; PG8_WAIT_L(0); PG8_MMA(0, 1, At, B1); PG8_BAR;
            PG8_LDA(At, 0, 1); PG8_STAGE(PG8_SA(0, 0), a2, voffA);
            PG8_BAR; PG8_WAIT_L(0); PG8_MMA(1, 0, At, B0); PG8_BAR; PG8_SCHED;
            PG8_STAGE(PG8_SB(0, 1), b2 + hstep, voffB);
            PG8_WAIT_V(6); PG8_BAR; PG8_MMA(1, 1, At, B1); PG8_BAR;
            PG8_LDB(B0, 1, 0); PG8_SCHED; PG8_LDA(At, 1, 0); PG8_STAGE(PG8_SA(0, 1), a2 + hstep, voffA);
            PG8_WAIT_L(8); PG8_BAR; PG8_WAIT_L(0); PG8_MMA(0, 0, At, B0); PG8_BAR; PG8_SCHED;
            PG8_LDB(B1, 1, 1); PG8_STAGE(PG8_SB(1, 0), b3, voffB);
            PG8_BAR; PG8_WAIT_L(0); PG8_MMA(0, 1, At, B1); PG8_BAR;
            PG8_LDA(At, 1, 1); PG8_STAGE(PG8_SA(1, 0), a3, voffA);
            PG8_BAR; PG8_WAIT_L(0); PG8_MMA(1, 0, At, B0); PG8_BAR; PG8_SCHED;
            PG8_STAGE(PG8_SB(1, 1), b3 + hstep, voffB);
            PG8_WAIT_V(6); PG8_BAR; PG8_MMA(1, 1, At, B1); PG8_BAR;
            }
        }
        if constexpr (ALIGN_EPI) { if (wr == 0) PG8_BAR; }
        if constexpr (!Epi::AFTER_DRAIN) { E(acc, cur, wr, wc, fr, fq); S.done(cur); }
        if (!has_next) break;
#pragma unroll
        for (int a = 0; a < 2; ++a)
#pragma unroll
            for (int b = 0; b < 2; ++b)
#pragma unroll
                for (int m = 0; m < 4; ++m)
#pragma unroll
                    for (int n = 0; n < 2; ++n) acc[a][b][m][n] = (f32x4){0.f, 0.f, 0.f, 0.f};
        cur = nxt; cA = nA; cB = nB; ++ui;
        if constexpr (ALIGN_EPI) { if (wr == 1) PG8_BAR; }
    }
    PG8_WAIT_V(0);
    if constexpr (!ALIGN_EPI) { if (wr == 0) PG8_BAR; }
    PG8_BAR;
    if constexpr (Epi::AFTER_DRAIN) { E.fused(acc, cur, wr, wc, fr, fq, lds, wid, lane); S.done(cur); }
#undef PG8_SA
#undef PG8_SB
#undef PG8_STAGE
#undef PG8_LDA
#undef PG8_LDB
#undef PG8_MMA
#undef PG8_WAIT_V
#undef PG8_WAIT_L
#undef PG8_BAR
#undef PG8_SCHED
}
}

constexpr int BATCH = 2, SEQ = 8192, DM = 1024, FF = 2816, NIN = 2560, RW = 512, M = BATCH * SEQ;
constexpr int NWAVES = 8, NTHR = 512;
constexpr int CH = 128, NCH = SEQ / CH;
constexpr size_t MiB = 1u << 20;
constexpr size_t WS_WGU1 = 0, WS_WD1 = 11 * MiB, WS_WIN = WS_WD1 + 11 * MiB / 2, WS_WOUT = WS_WIN + 5 * MiB, WS_WGU2 = WS_WOUT + 2 * MiB, WS_WD2 = WS_WGU2 + 11 * MiB, WS_WL = 40 * MiB;
constexpr size_t WS_GG = 0;
constexpr size_t WS_XB = 44 * MiB;
constexpr size_t WS_PST = 44 * MiB, WS_LST = 60 * MiB;
constexpr size_t WS_BIG = 76 * MiB;
constexpr size_t WS_LIN = WS_BIG + 80 * MiB;
constexpr size_t WS_DEC = 164 * MiB, WS_AA = 196 * MiB, WS_MIX = 212 * MiB, WS_SS = 244 * MiB, WS_CTL = 248 * MiB, WS_END = 249 * MiB;
static_assert(WS_WD2 + 11 * MiB / 2 <= WS_WL && WS_WL + MiB <= WS_XB, "weights map");

#define LAS __attribute__((address_space(3)))
typedef unsigned short bf16;
typedef unsigned v4u __attribute__((ext_vector_type(4)));
typedef unsigned v2u __attribute__((ext_vector_type(2)));
typedef float f32x4 __attribute__((ext_vector_type(4)));
typedef float f32x2 __attribute__((ext_vector_type(2)));
typedef short bf16x8 __attribute__((ext_vector_type(8)));
using pg8::cvt_pk_bf16;
__device__ __forceinline__ float bflo(unsigned u) { return __uint_as_float(u << 16); }
__device__ __forceinline__ float bfhi(unsigned u) { return __uint_as_float(u & 0xffff0000u); }
template <int CTRL> __device__ __forceinline__ float dpp_mov(float x) { return __builtin_bit_cast(float, __builtin_amdgcn_update_dpp(0, __builtin_bit_cast(int, x), CTRL, 0xF, 0xF, true)); }
__device__ __forceinline__ float sum16(float x) { x += dpp_mov<0xB1>(x); x += dpp_mov<0x4E>(x); x += dpp_mov<0x141>(x); x += dpp_mov<0x140>(x); return x; }
__device__ __forceinline__ float max16(float x) { x = fmaxf(x, dpp_mov<0xB1>(x)); x = fmaxf(x, dpp_mov<0x4E>(x)); x = fmaxf(x, dpp_mov<0x141>(x)); x = fmaxf(x, dpp_mov<0x140>(x)); return x; }
__device__ __forceinline__ float sum8(float x) { x += dpp_mov<0xB1>(x); x += dpp_mov<0x4E>(x); x += dpp_mov<0x141>(x); return x; }
__device__ __forceinline__ float wave_sum(float v) {
#pragma unroll
    for (int o = 1; o < 64; o <<= 1) v += __shfl_xor(v, o);
    return v;
}

__device__ __forceinline__ int lane_id() { return (int)__builtin_amdgcn_mbcnt_hi(~0u, __builtin_amdgcn_mbcnt_lo(~0u, 0u)); }
#define TIDX ((wave << 6) | lane_id())
struct Params {
    const float* in[26]; float* out; unsigned char* ws; int ph_lo, ph_hi;
};


#define GAS __attribute__((address_space(1)))
__device__ __forceinline__ const float* inp(int i) {
    const __attribute__((address_space(4))) char* ka = (const __attribute__((address_space(4))) char*)__builtin_amdgcn_kernarg_segment_ptr();
    int off = i * 8; asm volatile("" : "+s"(off));
    const float* q = *(const float* const __attribute__((address_space(4)))*)(ka + off);
    return (const float*)(const GAS float*)q;
}

__device__ __forceinline__ void conv_item(const float* W, int K, int N, const float* sc, bf16* WT, int k0, int n0, int drow0, float* scr, int lane) {
    float wv[32];
#pragma unroll
    for (int i = 0; i < 32; ++i) wv[i] = W[(size_t)(k0 + 2 * i + (lane >> 5)) * N + n0 + (lane & 31)];
    if (sc) { const float s0 = sc[k0 + lane];
#pragma unroll
        for (int i = 0; i < 32; ++i) wv[i] *= __shfl(s0, 2 * i + (lane >> 5)); }
#pragma unroll
    for (int i = 0; i < 32; ++i) scr[(2 * i + (lane >> 5)) * 33 + (lane & 31)] = wv[i];
    __builtin_amdgcn_fence(__ATOMIC_RELEASE, "wavefront"); asm volatile("s_waitcnt lgkmcnt(0)" ::: "memory");
    const int c = lane & 7;
#pragma unroll
    for (int j = 0; j < 4; ++j) { const int n = (lane >> 3) + 8 * j; const float* s = scr + (8 * c) * 33 + n;
        v4u o; o.x = cvt_pk_bf16(s[0 * 33], s[1 * 33]); o.y = cvt_pk_bf16(s[2 * 33], s[3 * 33]); o.z = cvt_pk_bf16(s[4 * 33], s[5 * 33]); o.w = cvt_pk_bf16(s[6 * 33], s[7 * 33]);
        *(v4u*)(WT + (size_t)(drow0 + n) * K + k0 + 8 * c) = o; }
    asm volatile("s_waitcnt lgkmcnt(0)" ::: "memory");
}
__device__ __forceinline__ void conv_plain(const float* W, int K, int N, const float* sc, bf16* WT, int item, float* scr, int lane) {
    const int nblk = N / 32, kb = item / nblk, nb = item % nblk; conv_item(W, K, N, sc, WT, 64 * kb, 32 * nb, 32 * nb, scr, lane);
}
__device__ __forceinline__ void conv_gu(const float* W, const float* sc, bf16* WT, int item, int up, float* scr, int lane) {
    const int nblk = FF / 32, kb = item / nblk, nb = item % nblk, n0 = 32 * nb; conv_item(W, DM, FF, sc, WT, 64 * kb, n0, (n0 >> 7) * 256 + up * 128 + (n0 & 127), scr, lane);
}
__device__ __forceinline__ void p0_late_weights(const Params& p, unsigned char* lds, int wave, int lane, int bidx, int NB) {
    float* scr = (float*)(lds + wave * 16384);
    unsigned char* ws = p.ws;
    const int gw = bidx * NWAVES + wave, NGW = NB * NWAVES;
    constexpr int I_GU = (DM / 64) * (FF / 32), I_DN = (FF / 64) * (DM / 32), I_IN = (DM / 64) * (NIN / 32), I_OUT = (DM / 64) * (DM / 32);
    constexpr int NITEMS = 2 * I_GU + I_DN + I_IN + I_OUT;
    for (int it = gw; it < NITEMS; it += NGW) {
        int r = it;
        if (r < I_IN) { conv_plain(inp(6), DM, NIN, inp(5), (bf16*)(ws + WS_WIN), r, scr, lane); continue; } r -= I_IN;
        if (r < I_OUT) { conv_plain(inp(20), DM, DM, nullptr, (bf16*)(ws + WS_WOUT), r, scr, lane); continue; } r -= I_OUT;
        if (r < I_GU) { conv_gu(inp(22), inp(21), (bf16*)(ws + WS_WGU2), r, 0, scr, lane); continue; } r -= I_GU;
        if (r < I_GU) { conv_gu(inp(23), inp(21), (bf16*)(ws + WS_WGU2), r, 1, scr, lane); continue; } r -= I_GU;
        conv_plain(inp(24), FF, DM, nullptr, (bf16*)(ws + WS_WD2), r, scr, lane);
    }
}
__device__ __forceinline__ void p0_prologue(const Params& p, unsigned char* lds, int wave, int lane) {
    float* scr = (float*)(lds + wave * 16384);
    unsigned char* ws = p.ws;
    const int gw = blockIdx.x * NWAVES + wave, NGW = gridDim.x * NWAVES;
    constexpr int I_GU = (DM / 64) * (FF / 32), I_DN = (FF / 64) * (DM / 32);
    constexpr int NITEMS = 2 * I_GU + I_DN;
    for (int it = gw; it < NITEMS; it += NGW) {
        int r = it;
        if (r < I_GU) { conv_gu(inp(2), inp(1), (bf16*)(ws + WS_WGU1), r, 0, scr, lane); continue; } r -= I_GU;
        if (r < I_GU) { conv_gu(inp(3), inp(1), (bf16*)(ws + WS_WGU1), r, 1, scr, lane); continue; } r -= I_GU;
        conv_plain(inp(4), FF, DM, nullptr, (bf16*)(ws + WS_WD1), r, scr, lane);
    }
    { bf16* WL = (bf16*)(ws + WS_WL); const float* w2 = inp(10); const float* a2 = inp(12); const float* g2 = inp(13);
      for (int idx = (blockIdx.x * NTHR + TIDX); idx < 1536 * 128; idx += gridDim.x * NTHR) {
          const int n = idx >> 7, k = (idx & 127) * 2; float v0 = 0.f, v1 = 0.f;
          if (n < 512) { if (k < 64) { v0 = w2[k * 512 + n]; v1 = w2[(k + 1) * 512 + n]; } }
          else if (n < 1024) { if (k >= 64 && k < 128) { v0 = a2[(k - 64) * 512 + n - 512]; v1 = a2[(k - 63) * 512 + n - 512]; } }
          else { if (k >= 128) { v0 = g2[(k - 128) * 512 + n - 1024]; v1 = g2[(k - 127) * 512 + n - 1024]; } }
          *(unsigned*)(WL + (size_t)n * 256 + k) = cvt_pk_bf16(v0, v1); } }
    { const float* x = inp(0); bf16* XB = (bf16*)(ws + WS_XB); float* ss0 = (float*)(ws + WS_SS);
      for (int m = gw; m < M; m += NGW) { const f32x4* xr = (const f32x4*)(x + (size_t)m * DM) + lane; float s = 0.f; f32x4 v[4];
#pragma unroll
          for (int j = 0; j < 4; ++j) { v[j] = xr[64 * j]; s += (v[j][0] * v[j][0] + v[j][1] * v[j][1]) + (v[j][2] * v[j][2] + v[j][3] * v[j][3]); }
          s = wave_sum(s);
          v2u* o8 = (v2u*)(XB + (size_t)m * DM) + lane;
#pragma unroll
          for (int j = 0; j < 4; ++j) { v2u w; w.x = cvt_pk_bf16(v[j][0], v[j][1]); w.y = cvt_pk_bf16(v[j][2], v[j][3]); o8[64 * j] = w; }
          if (lane < 16) ss0[(size_t)m * 16 + lane] = (lane == 0) ? s : 0.f; } }
}

__device__ __forceinline__ void r1_phase(const Params& p, int wave) {
    const bf16* P = (const bf16*)(p.ws + WS_BIG); bf16* LIN = (bf16*)(p.ws + WS_LIN); const float* mix = inp(8);
    for (int idx = blockIdx.x * NTHR + TIDX; idx < M * 32; idx += gridDim.x * NTHR) {
        const int row = idx >> 5, g8 = idx & 31, col = 1536 + 8 * g8; const bool hp = (row & (SEQ - 1)) != 0;
        const v4u c = *(const v4u*)(P + (size_t)row * NIN + col); v4u q = (v4u){0u, 0u, 0u, 0u}; if (hp) q = *(const v4u*)(P + (size_t)(row - 1) * NIN + col);
        const f32x4 m0 = *(const f32x4*)(mix + col), m1 = *(const f32x4*)(mix + col + 4);
        float x[8];
#pragma unroll
        for (int e = 0; e < 4; ++e) { const float c0 = bflo(c[e]), c1 = bfhi(c[e]), q0 = bflo(q[e]), q1 = bfhi(q[e]); const float ma = (e < 2) ? m0[2 * e] : m1[2 * e - 4], mb = (e < 2) ? m0[2 * e + 1] : m1[2 * e - 3];
            x[2 * e] = c0 + (q0 - c0) * ma; x[2 * e + 1] = c1 + (q1 - c1) * mb; }
        if (g8 < 8) {
#pragma unroll
            for (int e = 0; e < 8; ++e) x[e] = tanhf(x[e]);
        } else if (g8 >= 16) {
#pragma unroll
            for (int e = 0; e < 8; ++e) x[e] = 1.0f / (1.0f + expf(-x[e]));
        }
        v4u o; o.x = cvt_pk_bf16(x[0], x[1]); o.y = cvt_pk_bf16(x[2], x[3]); o.z = cvt_pk_bf16(x[4], x[5]); o.w = cvt_pk_bf16(x[6], x[7]);
        *(v4u*)(LIN + (size_t)row * 256 + 8 * g8) = o;
    }
}

constexpr int SC_W = 0, SC_B = 1, SC_K = 2, SC_KK = 3, SC_V = 4, SC_R = 5, SC_O = 6, SC_BC = 7;
template <bool P3> __device__ __forceinline__ void scan_load(const Params& p, float* sm, int b, int h, int t0, int wave) {
    const int tid = TIDX, tt = tid >> 3, c8 = (tid & 7) * 8, hc = h * 64 + c8;
    const bf16* P = (const bf16*)(p.ws + WS_BIG); const float* DEC = (const float*)(p.ws + WS_DEC); const bf16* AA = (const bf16*)(p.ws + WS_AA);
    const float* mix = inp(8); const float* k_k = inp(14); const float* k_a = inp(15); const float* r_k = inp(16);
    const int gr = b * SEQ + t0 + tt; const bool hp = (t0 + tt) > 0;
    const bf16* prow = P + (size_t)gr * NIN + hc;
    float r[8], k[8], v[8];
#define SHIFT_LOAD(dst, off) do { const v4u c_ = *(const v4u*)(prow + (off)); v4u q_ = (v4u){0u, 0u, 0u, 0u}; if (hp) q_ = *(const v4u*)(prow + (off) - NIN); \
        const f32x4 m0_ = *(const f32x4*)(mix + hc + (off)), m1_ = *(const f32x4*)(mix + hc + (off) + 4); \
        _Pragma("unroll") for (int e = 0; e < 4; ++e) { const float c0 = bflo(c_[e]), c1 = bfhi(c_[e]), q0 = bflo(q_[e]), q1 = bfhi(q_[e]); const float ma = (e < 2) ? m0_[2 * e] : m1_[2 * e - 4], mb = (e < 2) ? m0_[2 * e + 1] : m1_[2 * e - 3]; \
            dst[2 * e] = c0 + (q0 - c0) * ma; dst[2 * e + 1] = c1 + (q1 - c1) * mb; } } while (0)
    SHIFT_LOAD(k, 512); SHIFT_LOAD(v, 1024);
    if (P3) SHIFT_LOAD(r, 0);
#undef SHIFT_LOAD
    const f32x4 d0 = *(const f32x4*)(DEC + (size_t)gr * RW + hc), d1 = *(const f32x4*)(DEC + (size_t)gr * RW + hc + 4);
    const v4u av = *(const v4u*)(AA + (size_t)gr * RW + hc);
    const f32x4 kk0 = *(const f32x4*)(k_k + hc), kk1 = *(const f32x4*)(k_k + hc + 4), ka0 = *(const f32x4*)(k_a + hc), ka1 = *(const f32x4*)(k_a + hc + 4);
    float a[8], kk[8], kp[8], bb[8]; float ssq = 0.f;
#pragma unroll
    for (int e = 0; e < 4; ++e) { a[2 * e] = bflo(av[e]); a[2 * e + 1] = bfhi(av[e]); }
#pragma unroll
    for (int e = 0; e < 8; ++e) { const float kkw = (e < 4) ? kk0[e] : kk1[e - 4], kaw = (e < 4) ? ka0[e] : ka1[e - 4];
        kk[e] = k[e] * kkw; ssq += kk[e] * kk[e]; kp[e] = k[e] * (1.0f + (a[e] - 1.0f) * kaw); }
    ssq = sum8(ssq);
    const float inv = 1.0f / fmaxf(sqrtf(ssq), 1e-12f);
#pragma unroll
    for (int e = 0; e < 8; ++e) { kk[e] *= inv; bb[e] = kk[e] * a[e]; }
    float* base = sm + tt * 64 + c8;
    *(f32x4*)(base + SC_W * 4096) = d0; *(f32x4*)(base + SC_W * 4096 + 4) = d1;
    *(f32x4*)(base + SC_B * 4096) = (f32x4){bb[0], bb[1], bb[2], bb[3]}; *(f32x4*)(base + SC_B * 4096 + 4) = (f32x4){bb[4], bb[5], bb[6], bb[7]};
    *(f32x4*)(base + SC_K * 4096) = (f32x4){kp[0], kp[1], kp[2], kp[3]}; *(f32x4*)(base + SC_K * 4096 + 4) = (f32x4){kp[4], kp[5], kp[6], kp[7]};
    *(f32x4*)(base + SC_KK * 4096) = (f32x4){kk[0], kk[1], kk[2], kk[3]}; *(f32x4*)(base + SC_KK * 4096 + 4) = (f32x4){kk[4], kk[5], kk[6], kk[7]};
    *(f32x4*)(base + SC_V * 4096) = (f32x4){v[0], v[1], v[2], v[3]}; *(f32x4*)(base + SC_V * 4096 + 4) = (f32x4){v[4], v[5], v[6], v[7]};
    if (P3) {
        *(f32x4*)(base + SC_R * 4096) = (f32x4){r[0], r[1], r[2], r[3]}; *(f32x4*)(base + SC_R * 4096 + 4) = (f32x4){r[4], r[5], r[6], r[7]};
        const f32x4 rk0 = *(const f32x4*)(r_k + hc), rk1 = *(const f32x4*)(r_k + hc + 4); float bc = 0.f;
#pragma unroll
        for (int e = 0; e < 8; ++e) bc += r[e] * kp[e] * ((e < 4) ? rk0[e] : rk1[e - 4]);
        bc = sum8(bc);
        if ((tid & 7) == 0) sm[SC_BC * 4096 + tt] = bc;
    }
}
#define LO2(v) __builtin_shufflevector(v, v, 0, 1)
#define HI2(v) __builtin_shufflevector(v, v, 2, 3)
template <int RPL, bool WITH_O, bool REAL> __device__ __forceinline__ void scan_run(const float* sm, f32x2 (&S)[RPL][2], int cs, int rowbase) {
    typedef float vrow_t __attribute__((ext_vector_type(RPL)));
    const float* st0 = sm + 4 * cs;
    f32x4 w4 = *(const f32x4*)(st0 + SC_W * 4096), b4 = *(const f32x4*)(st0 + SC_B * 4096), kk4 = *(const f32x4*)(st0 + SC_KK * 4096), k4 = w4, r4 = w4;
    if (REAL) k4 = *(const f32x4*)(st0 + SC_K * 4096);
    if (WITH_O) r4 = *(const f32x4*)(st0 + SC_R * 4096);
    vrow_t v4; if (REAL) v4 = *(const vrow_t*)(sm + SC_V * 4096 + rowbase);
#pragma unroll 2
    for (int t = 0; t < 64; ++t) {
        const int tn = (t + 1) & 63;
        const float* st = st0 + tn * 64;
        const f32x4 nw4 = *(const f32x4*)(st + SC_W * 4096), nb4 = *(const f32x4*)(st + SC_B * 4096), nkk4 = *(const f32x4*)(st + SC_KK * 4096);
        f32x4 nk4 = nw4, nr4 = nw4; vrow_t nv4;
        if (REAL) { nk4 = *(const f32x4*)(st + SC_K * 4096); nv4 = *(const vrow_t*)(sm + SC_V * 4096 + tn * 64 + rowbase); }
        if (WITH_O) nr4 = *(const f32x4*)(st + SC_R * 4096);
        const f32x2 w01 = LO2(w4), w23 = HI2(w4), b01 = LO2(b4), b23 = HI2(b4), kk01 = LO2(kk4), kk23 = HI2(kk4), k01 = LO2(k4), k23 = HI2(k4), r01 = LO2(r4), r23 = HI2(r4);
        float oo[RPL];
#pragma unroll
        for (int j = 0; j < RPL; ++j) {
            f32x2 pp = S[j][0] * kk01; pp = S[j][1] * kk23 + pp;
            const float nsa = -sum16(pp[0] + pp[1]);
            const f32x2 nsa2 = (f32x2){nsa, nsa};
            f32x2 t01 = nsa2 * b01, t23 = nsa2 * b23;
            if (REAL) { const f32x2 v2 = (f32x2){v4[j], v4[j]}; t01 = v2 * k01 + t01; t23 = v2 * k23 + t23; }
            S[j][0] = S[j][0] * w01 + t01; S[j][1] = S[j][1] * w23 + t23;
            if (WITH_O) { f32x2 qq = S[j][0] * r01; qq = S[j][1] * r23 + qq; oo[j] = sum16(qq[0] + qq[1]); }
        }
        if (WITH_O) { if (cs == 0) {
#pragma unroll
            for (int j = 0; j < RPL; ++j) ((float*)sm)[SC_O * 4096 + t * 64 + rowbase + j] = oo[j]; } }
        w4 = nw4; b4 = nb4; kk4 = nkk4; k4 = nk4; r4 = nr4; if (REAL) v4 = nv4;
    }
}
__device__ __forceinline__ void scan_pass1(const Params& p, float* sm, int wave, int lane) {
    float* PST = (float*)(p.ws + WS_PST); float* LST = (float*)(p.ws + WS_LST);
    const int cs = lane & 15, rg = lane >> 4; const bool real = wave < 4; const int rowbase = (wave & 3) * 16 + rg * 4;
    constexpr int NU = BATCH * (NCH - 1) * 8;
    for (int u = blockIdx.x; u < NU; u += gridDim.x) {
        const int h = u & 7, bc = u >> 3, c = bc % (NCH - 1), b = bc / (NCH - 1);
        f32x2 S[4][2];
#pragma unroll
        for (int j = 0; j < 4; ++j)
#pragma unroll
            for (int e = 0; e < 4; ++e) S[j][e >> 1][e & 1] = (!real && (rowbase + j == 4 * cs + e)) ? 1.0f : 0.0f;
        for (int sub = 0; sub < 2; ++sub) {
            __syncthreads();
            scan_load<false>(p, sm, b, h, c * CH + sub * 64, wave);
            __syncthreads();
            if (real) scan_run<4, false, true>(sm, S, cs, rowbase); else scan_run<4, false, false>(sm, S, cs, rowbase);
        }
        float* dst = (real ? LST : PST) + ((size_t)((b * NCH + c) * 8 + h)) * 4096 + rowbase * 64 + 4 * cs;
#pragma unroll
        for (int j = 0; j < 4; ++j) *(f32x4*)(dst + j * 64) = (f32x4){S[j][0][0], S[j][0][1], S[j][1][0], S[j][1][1]};
    }
}
__device__ __forceinline__ float rowsum4(float part) {
    const f32x4 z = (f32x4){0.f, 0.f, 0.f, 0.f};
    const f32x4 d = __builtin_amdgcn_mfma_f32_16x16x4f32(1.0f, part, z, 0, 0, 0);
    return d[0];
}
struct ScanRaw { v4u kc, kq, vc, vq, rc, rq, av, gv; f32x4 d0, d1; };
__device__ __forceinline__ void scanL_params(float* parl, int hc, int c8) {
    const float* mix = inp(8); const float* k_k = inp(14); const float* k_a = inp(15); const float* r_k = inp(16); const float* ln_w = inp(17); const float* ln_b = inp(18);
    float* d = parl + c8;
    *(f32x4*)(d) = *(const f32x4*)(mix + hc); *(f32x4*)(d + 4) = *(const f32x4*)(mix + hc + 4);
    *(f32x4*)(d + 64) = *(const f32x4*)(mix + 512 + hc); *(f32x4*)(d + 68) = *(const f32x4*)(mix + 512 + hc + 4);
    *(f32x4*)(d + 128) = *(const f32x4*)(mix + 1024 + hc); *(f32x4*)(d + 132) = *(const f32x4*)(mix + 1024 + hc + 4);
    *(f32x4*)(d + 192) = *(const f32x4*)(k_k + hc); *(f32x4*)(d + 196) = *(const f32x4*)(k_k + hc + 4);
    *(f32x4*)(d + 256) = *(const f32x4*)(k_a + hc); *(f32x4*)(d + 260) = *(const f32x4*)(k_a + hc + 4);
    *(f32x4*)(d + 320) = *(const f32x4*)(r_k + hc); *(f32x4*)(d + 324) = *(const f32x4*)(r_k + hc + 4);
    *(f32x4*)(d + 384) = *(const f32x4*)(ln_w + hc); *(f32x4*)(d + 388) = *(const f32x4*)(ln_w + hc + 4);
    *(f32x4*)(d + 448) = *(const f32x4*)(ln_b + hc); *(f32x4*)(d + 452) = *(const f32x4*)(ln_b + hc + 4);
}
template <bool P3> __device__ __forceinline__ void scanL_issue(const Params& p, ScanRaw& w, int b, int hc, int tok) {
    const bf16* P = (const bf16*)(p.ws + WS_BIG); const float* DEC = (const float*)(p.ws + WS_DEC); const bf16* AA = (const bf16*)(p.ws + WS_AA); const bf16* GG = (const bf16*)(p.ws + WS_GG);
    const int gr = b * SEQ + tok; const bool hp = tok > 0;
    const bf16* prow = P + (size_t)gr * NIN + hc; const v4u z = (v4u){0u, 0u, 0u, 0u};
    w.kc = *(const v4u*)(prow + 512); w.kq = hp ? *(const v4u*)(prow + 512 - NIN) : z;
    w.vc = *(const v4u*)(prow + 1024); w.vq = hp ? *(const v4u*)(prow + 1024 - NIN) : z;
    if (P3) { w.rc = *(const v4u*)(prow); w.rq = hp ? *(const v4u*)(prow - NIN) : z; w.gv = *(const v4u*)(GG + (size_t)gr * RW + hc); }
    w.d0 = *(const f32x4*)(DEC + (size_t)gr * RW + hc); w.d1 = *(const f32x4*)(DEC + (size_t)gr * RW + hc + 4);
    w.av = *(const v4u*)(AA + (size_t)gr * RW + hc);
}
__device__ __forceinline__ void shift8(float (&dst)[8], const v4u& c_, const v4u& q_, const f32x4& m0_, const f32x4& m1_) {
#pragma unroll
    for (int e = 0; e < 4; ++e) { const float c0 = bflo(c_[e]), c1 = bfhi(c_[e]), q0 = bflo(q_[e]), q1 = bfhi(q_[e]); const float ma = (e < 2) ? m0_[2 * e] : m1_[2 * e - 4], mb = (e < 2) ? m0_[2 * e + 1] : m1_[2 * e - 3];
        dst[2 * e] = c0 + (q0 - c0) * ma; dst[2 * e + 1] = c1 + (q1 - c1) * mb; }
}
template <bool P3, int TS> __device__ __forceinline__ void scanL_store(const ScanRaw& w, const float* parl, float* su, float* bcl, int tt, int c8, bool bcw) {
    float r[8], k[8], v[8]; const float* pq = parl + c8;
    shift8(k, w.kc, w.kq, *(const f32x4*)(pq + 64), *(const f32x4*)(pq + 68)); shift8(v, w.vc, w.vq, *(const f32x4*)(pq + 128), *(const f32x4*)(pq + 132));
    if (P3) shift8(r, w.rc, w.rq, *(const f32x4*)(pq), *(const f32x4*)(pq + 4));
    const f32x4 qkk0 = *(const f32x4*)(pq + 192), qkk1 = *(const f32x4*)(pq + 196), qka0 = *(const f32x4*)(pq + 256), qka1 = *(const f32x4*)(pq + 260);
    float a[8], kk[8], kp[8], bb[8]; float ssq = 0.f;
#pragma unroll
    for (int e = 0; e < 4; ++e) { a[2 * e] = bflo(w.av[e]); a[2 * e + 1] = bfhi(w.av[e]); }
#pragma unroll
    for (int e = 0; e < 8; ++e) { const float kkw = (e < 4) ? qkk0[e] : qkk1[e - 4], kaw = (e < 4) ? qka0[e] : qka1[e - 4];
        kk[e] = k[e] * kkw; ssq += kk[e] * kk[e]; kp[e] = k[e] * (1.0f + (a[e] - 1.0f) * kaw); }
    ssq = sum8(ssq);
    const float inv = 1.0f / fmaxf(sqrtf(ssq), 1e-12f);
#pragma unroll
    for (int e = 0; e < 8; ++e) { kk[e] *= inv; bb[e] = kk[e] * a[e]; }
    constexpr int AS = TS * 64;
    float* base = su + tt * 64 + c8;
    *(f32x4*)(base + SC_W * AS) = w.d0; *(f32x4*)(base + SC_W * AS + 4) = w.d1;
    *(f32x4*)(base + SC_B * AS) = (f32x4){bb[0], bb[1], bb[2], bb[3]}; *(f32x4*)(base + SC_B * AS + 4) = (f32x4){bb[4], bb[5], bb[6], bb[7]};
    *(f32x4*)(base + SC_K * AS) = (f32x4){kp[0], kp[1], kp[2], kp[3]}; *(f32x4*)(base + SC_K * AS + 4) = (f32x4){kp[4], kp[5], kp[6], kp[7]};
    *(f32x4*)(base + SC_KK * AS) = (f32x4){kk[0], kk[1], kk[2], kk[3]}; *(f32x4*)(base + SC_KK * AS + 4) = (f32x4){kk[4], kk[5], kk[6], kk[7]};
    *(f32x4*)(base + SC_V * AS) = (f32x4){v[0], v[1], v[2], v[3]}; *(f32x4*)(base + SC_V * AS + 4) = (f32x4){v[4], v[5], v[6], v[7]};
    if (P3) {
        *(f32x4*)(base + SC_R * AS) = (f32x4){r[0], r[1], r[2], r[3]}; *(f32x4*)(base + SC_R * AS + 4) = (f32x4){r[4], r[5], r[6], r[7]};
        const f32x4 qrk0 = *(const f32x4*)(pq + 320), qrk1 = *(const f32x4*)(pq + 324); float bc = 0.f;
#pragma unroll
        for (int e = 0; e < 8; ++e) bc += r[e] * kp[e] * ((e < 4) ? qrk0[e] : qrk1[e - 4]);
        bc = sum8(bc);
        if (bcw) bcl[tt] = bc;
    }
}
#define LD16(dst, ptr) do { const f32x4 x0_ = *(const f32x4*)(ptr), x1_ = *(const f32x4*)((ptr) + 4), x2_ = *(const f32x4*)((ptr) + 8), x3_ = *(const f32x4*)((ptr) + 12); \
        dst[0] = LO2(x0_); dst[1] = HI2(x0_); dst[2] = LO2(x1_); dst[3] = HI2(x1_); dst[4] = LO2(x2_); dst[5] = HI2(x2_); dst[6] = LO2(x3_); dst[7] = HI2(x3_); } while (0)
template <int RPL, bool WITH_O, bool REAL, int TS> __device__ __forceinline__ void scanL_run(float* su, f32x2 (&S)[RPL][8], int r, int g, int rowbase) {
    constexpr int AS = TS * 64;
#pragma unroll 1
    for (int t = 0; t < TS; ++t) {
        const float* st = su + t * 64 + 16 * g;
        f32x2 w2[8], b2[8], kk2[8], k2[8], r2[8];
        LD16(kk2, st + SC_KK * AS); LD16(w2, st + SC_W * AS); LD16(b2, st + SC_B * AS);
        if (REAL) LD16(k2, st + SC_K * AS);
        if (WITH_O) LD16(r2, st + SC_R * AS);
        float vv[RPL];
#pragma unroll
        for (int j = 0; j < RPL; ++j) vv[j] = REAL ? su[SC_V * AS + t * 64 + rowbase + 16 * j + r] : 0.f;
#pragma unroll
        for (int j = 0; j < RPL; ++j) {
            f32x2 p0 = S[j][0] * kk2[0], p1 = S[j][1] * kk2[1];
#pragma unroll
            for (int i = 2; i < 8; i += 2) { p0 = S[j][i] * kk2[i] + p0; p1 = S[j][i + 1] * kk2[i + 1] + p1; }
            p0 += p1;
            const float nsa = -rowsum4(p0[0] + p0[1]);
            const f32x2 nsa2 = (f32x2){nsa, nsa}, v2 = (f32x2){vv[j], vv[j]};
            f32x2 q0 = (f32x2){0.f, 0.f}, q1 = q0;
#pragma unroll
            for (int i = 0; i < 8; ++i) { f32x2 tt_ = nsa2 * b2[i]; if (REAL) tt_ = v2 * k2[i] + tt_; S[j][i] = S[j][i] * w2[i] + tt_;
                if (WITH_O) { if (i & 1) q1 = S[j][i] * r2[i] + q1; else q0 = S[j][i] * r2[i] + q0; } }
            if (WITH_O) { q0 += q1; const float o = rowsum4(q0[0] + q0[1]); if (g == 0) su[SC_O * AS + t * 64 + rowbase + 16 * j + r] = o; }
        }
    }
}
__device__ __forceinline__ void scanL_pass1(const Params& p, float* sm, int wave) {
    constexpr int TS = 32, SLOT = 5 * TS * 64, NPAIR = BATCH * (NCH - 1) * 8 / 2;
    float* PST = (float*)(p.ws + WS_PST); float* LST = (float*)(p.ws + WS_LST);
    const int lane = lane_id(), tid = (wave << 6) | lane, r = lane & 15, g = lane >> 4, u2 = wave >> 2, wq = wave & 3; const bool real = wq < 2; const int rowbase = (wq & 1) * 32;
    float* su = sm + u2 * SLOT;
    const int ltt = (tid >> 3) & 31, lc8 = (tid & 7) * 8;
    for (int up = blockIdx.x; up < NPAIR; up += gridDim.x) {
        const int u = 2 * up + u2, h = u & 7, bc = u >> 3, c = bc % (NCH - 1), b = bc / (NCH - 1);
        f32x2 S[2][8];
#pragma unroll
        for (int j = 0; j < 2; ++j)
#pragma unroll
            for (int i = 0; i < 8; ++i) { const int row = rowbase + 16 * j + r, col = 16 * g + 2 * i; S[j][i] = (f32x2){(!real && row == col) ? 1.f : 0.f, (!real && row == col + 1) ? 1.f : 0.f}; }
        float* parl = sm + 2 * SLOT + u2 * 512;
        __syncthreads();
        if (ltt == 0) scanL_params(parl, h * 64 + lc8, lc8);
        ScanRaw raw; scanL_issue<false>(p, raw, b, h * 64 + lc8, c * CH + ltt);
        for (int sub = 0; sub < CH / TS; ++sub) {
            __syncthreads();
            scanL_store<false, TS>(raw, parl, su, nullptr, ltt, lc8, false);
            __syncthreads();
            if (sub + 1 < CH / TS) scanL_issue<false>(p, raw, b, h * 64 + lc8, c * CH + (sub + 1) * TS + ltt);
            if (real) scanL_run<2, false, true, TS>(su, S, r, g, rowbase); else scanL_run<2, false, false, TS>(su, S, r, g, rowbase);
        }
        float* dst = (real ? LST : PST) + ((size_t)((b * NCH + c) * 8 + h)) * 4096 + 16 * g;
#pragma unroll
        for (int j = 0; j < 2; ++j) { float* d = dst + (rowbase + 16 * j + r) * 64;
#pragma unroll
            for (int i = 0; i < 4; ++i) *(f32x4*)(d + 4 * i) = (f32x4){S[j][2 * i][0], S[j][2 * i][1], S[j][2 * i + 1][0], S[j][2 * i + 1][1]}; }
    }
}
__device__ __forceinline__ void scanL_pass3(const Params& p, float* sm, int wave) {
    constexpr int TS = 16, AS = TS * 64, SLOT = 7 * AS, NQ = BATCH * NCH * 8 / 4;
    const float* LST = (const float*)(p.ws + WS_LST); const bf16* GG = (const bf16*)(p.ws + WS_GG); bf16* MIX = (bf16*)(p.ws + WS_MIX);
    const float* ln_w = inp(17); const float* ln_b = inp(18);
    const int lane = lane_id(), tid = (wave << 6) | lane, r = lane & 15, g = lane >> 4, u4 = wave >> 1, rowbase = (wave & 1) * 32;
    float* su = sm + u4 * SLOT; float* bcl = sm + 4 * SLOT + u4 * TS;
    const int tt = (tid >> 3) & 15, c8 = (tid & 7) * 8;
    for (int uq = blockIdx.x; uq < NQ; uq += gridDim.x) {
        const int u = 4 * uq + u4, h = u & 7, bc = u >> 3, c = bc % NCH, b = bc / NCH, hc = h * 64 + c8;
        f32x2 S[2][8];
#pragma unroll
        for (int j = 0; j < 2; ++j) {
            if (c > 0) { const float* src = LST + ((size_t)((b * NCH + c - 1) * 8 + h)) * 4096 + (rowbase + 16 * j + r) * 64 + 16 * g;
#pragma unroll
                for (int i = 0; i < 4; ++i) { const f32x4 s4 = *(const f32x4*)(src + 4 * i); S[j][2 * i] = LO2(s4); S[j][2 * i + 1] = HI2(s4); } }
            else {
#pragma unroll
                for (int i = 0; i < 8; ++i) S[j][i] = (f32x2){0.f, 0.f}; } }
        float* parl = sm + 4 * SLOT + 64 + u4 * 512;
        __syncthreads();
        if (tt == 0) scanL_params(parl, hc, c8);
        ScanRaw raw; scanL_issue<true>(p, raw, b, hc, c * CH + tt);
        for (int sub = 0; sub < CH / TS; ++sub) {
            __syncthreads();
            scanL_store<true, TS>(raw, parl, su, bcl, tt, c8, (tid & 7) == 0);
            const v4u gv = raw.gv;
            __syncthreads();
            if (sub + 1 < CH / TS) scanL_issue<true>(p, raw, b, hc, c * CH + (sub + 1) * TS + tt);
            scanL_run<2, true, true, TS>(su, S, r, g, rowbase);
            __syncthreads();
            const int gr = b * SEQ + c * CH + sub * TS + tt;
            const f32x4 o0 = *(const f32x4*)(su + SC_O * AS + tt * 64 + c8), o1 = *(const f32x4*)(su + SC_O * AS + tt * 64 + c8 + 4);
            const f32x4 v0 = *(const f32x4*)(su + SC_V * AS + tt * 64 + c8), v1 = *(const f32x4*)(su + SC_V * AS + tt * 64 + c8 + 4);
            const float bcv = bcl[tt];
            float mu = ((o0[0] + o0[1]) + (o0[2] + o0[3])) + ((o1[0] + o1[1]) + (o1[2] + o1[3])); mu = sum8(mu) * (1.0f / 64.0f);
            const f32x4 e0 = o0 - mu, e1 = o1 - mu;
            float var = ((e0[0] * e0[0] + e0[1] * e0[1]) + (e0[2] * e0[2] + e0[3] * e0[3])) + ((e1[0] * e1[0] + e1[1] * e1[1]) + (e1[2] * e1[2] + e1[3] * e1[3])); var = sum8(var) * (1.0f / 64.0f);
            const float rs = 1.0f / sqrtf(var + 64e-5f);
            const f32x4 lw0 = *(const f32x4*)(parl + 384 + c8), lw1 = *(const f32x4*)(parl + 388 + c8), lb0 = *(const f32x4*)(parl + 448 + c8), lb1 = *(const f32x4*)(parl + 452 + c8);
            f32x4 y0 = (e0 * rs) * lw0 + lb0 + v0 * bcv, y1 = (e1 * rs) * lw1 + lb1 + v1 * bcv;
            y0[0] *= bflo(gv[0]); y0[1] *= bfhi(gv[0]); y0[2] *= bflo(gv[1]); y0[3] *= bfhi(gv[1]); y1[0] *= bflo(gv[2]); y1[1] *= bfhi(gv[2]); y1[2] *= bflo(gv[3]); y1[3] *= bfhi(gv[3]);
            v4u w; w.x = cvt_pk_bf16(y0[0], y0[1]); w.y = cvt_pk_bf16(y0[2], y0[3]); w.z = cvt_pk_bf16(y1[0], y1[1]); w.w = cvt_pk_bf16(y1[2], y1[3]);
            *(v4u*)(MIX + (size_t)gr * DM + hc) = w;
        }
    }
}

__device__ __forceinline__ void scan_pass2(const Params& p, float* sm, int wave) {
    const float* PST = (const float*)(p.ws + WS_PST); float* LST = (float*)(p.ws + WS_LST);
    const int lane = lane_id(), tid = (wave << 6) | lane, vb = (blockIdx.x & 7) * (gridDim.x >> 3) + (blockIdx.x >> 3);
    if (vb >= 128) return;
    const int chain = vb >> 3, row = (vb & 7) * 8 + wave, b = chain >> 3, h = chain & 7;
    float* Pb = sm; float* Sw = sm + 8192 + wave * 64;
    constexpr int NS = NCH - 1;
#define UOFF(c) ((size_t)((b * NCH + (c)) * 8 + h) * 4096)
#define LDP(X0, X1, LX, c) do { X0 = *(const f32x4*)(PST + UOFF(c) + tid * 8); X1 = *(const f32x4*)(PST + UOFF(c) + tid * 8 + 4); LX = LST[UOFF(c) + row * 64 + lane]; } while (0)
    f32x4 A0, A1, B0, B1, C0, C1; float LA = 0.f, LB = 0.f, LC = 0.f, Lcur;
    __syncthreads();
    LDP(A0, A1, LA, 0);
    *(f32x4*)(Pb + tid * 8) = A0; *(f32x4*)(Pb + tid * 8 + 4) = A1; Lcur = LA;
    Sw[lane] = 0.f;
    LDP(B0, B1, LB, 1); LDP(C0, C1, LC, 2); LDP(A0, A1, LA, 3);
    __syncthreads();
#define P2STEP(c, X0, X1, LX) do { float Lnx = 0.f; \
        if ((c) + 1 < NS) { float* Pn = Pb + (((c) + 1) & 1) * 4096; *(f32x4*)(Pn + tid * 8) = X0; *(f32x4*)(Pn + tid * 8 + 4) = X1; Lnx = LX; } \
        if ((c) + 4 < NS) LDP(X0, X1, LX, (c) + 4); \
        const float* Pc = Pb + ((c) & 1) * 4096 + lane; float a0 = 0.f, a1 = 0.f, a2 = 0.f, a3 = 0.f; \
        _Pragma("unroll") for (int i = 0; i < 64; i += 4) { const f32x4 s4 = *(const f32x4*)(Sw + i); \
            a0 += s4[0] * Pc[(i + 0) * 64]; a1 += s4[1] * Pc[(i + 1) * 64]; a2 += s4[2] * Pc[(i + 2) * 64]; a3 += s4[3] * Pc[(i + 3) * 64]; } \
        const float sn = ((a0 + a1) + (a2 + a3)) + Lcur; LST[UOFF(c) + row * 64 + lane] = sn; Sw[lane] = sn; Lcur = Lnx; \
        __syncthreads(); } while (0)
    for (int c = 0; c < NS; c += 3) { P2STEP(c, B0, B1, LB); P2STEP(c + 1, C0, C1, LC); P2STEP(c + 2, A0, A1, LA); }
    static_assert(NS % 3 == 0, "pass 2 is unrolled by 3");
#undef P2STEP
#undef LDP
#undef UOFF
}
__device__ __forceinline__ void scan_pass3(const Params& p, float* sm, int wave, int lane) {
    const float* LST = (const float*)(p.ws + WS_LST); const bf16* GG = (const bf16*)(p.ws + WS_GG); bf16* MIX = (bf16*)(p.ws + WS_MIX);
    const float* ln_w = inp(17); const float* ln_b = inp(18);
    const int tid = TIDX, cs = lane & 15, rg = lane >> 4, rowbase = wave * 8 + rg * 2;
    constexpr int NU = BATCH * NCH * 8;
    for (int u = blockIdx.x; u < NU; u += gridDim.x) {
        const int h = u & 7, bc = u >> 3, c = bc % NCH, b = bc / NCH;
        f32x2 S[2][2];
        if (c > 0) { const float* src = LST + ((size_t)((b * NCH + c - 1) * 8 + h)) * 4096 + rowbase * 64 + 4 * cs;
#pragma unroll
            for (int j = 0; j < 2; ++j) { const f32x4 s4 = *(const f32x4*)(src + j * 64); S[j][0] = LO2(s4); S[j][1] = HI2(s4); } }
        else {
#pragma unroll
            for (int j = 0; j < 2; ++j) { S[j][0] = (f32x2){0.f, 0.f}; S[j][1] = (f32x2){0.f, 0.f}; } }
        for (int sub = 0; sub < 2; ++sub) {
            __syncthreads();
            scan_load<true>(p, sm, b, h, c * CH + sub * 64, wave);
            __syncthreads();
            scan_run<2, true, true>(sm, S, cs, rowbase);
            __syncthreads();
            const int tt = tid >> 3, c8 = (tid & 7) * 8, hc = h * 64 + c8; const int gr = b * SEQ + c * CH + sub * 64 + tt;
            const f32x4 o0 = *(const f32x4*)(sm + SC_O * 4096 + tt * 64 + c8), o1 = *(const f32x4*)(sm + SC_O * 4096 + tt * 64 + c8 + 4);
            const f32x4 v0 = *(const f32x4*)(sm + SC_V * 4096 + tt * 64 + c8), v1 = *(const f32x4*)(sm + SC_V * 4096 + tt * 64 + c8 + 4);
            const float bcv = sm[SC_BC * 4096 + tt];
            float mu = ((o0[0] + o0[1]) + (o0[2] + o0[3])) + ((o1[0] + o1[1]) + (o1[2] + o1[3])); mu = sum8(mu) * (1.0f / 64.0f);
            const f32x4 e0 = o0 - mu, e1 = o1 - mu;
            float var = ((e0[0] * e0[0] + e0[1] * e0[1]) + (e0[2] * e0[2] + e0[3] * e0[3])) + ((e1[0] * e1[0] + e1[1] * e1[1]) + (e1[2] * e1[2] + e1[3] * e1[3])); var = sum8(var) * (1.0f / 64.0f);
            const float rs = 1.0f / sqrtf(var + 64e-5f);
            const f32x4 lw0 = *(const f32x4*)(ln_w + hc), lw1 = *(const f32x4*)(ln_w + hc + 4), lb0 = *(const f32x4*)(ln_b + hc), lb1 = *(const f32x4*)(ln_b + hc + 4);
            const v4u gv = *(const v4u*)(GG + (size_t)gr * RW + hc);
            f32x4 y0 = (e0 * rs) * lw0 + lb0 + v0 * bcv, y1 = (e1 * rs) * lw1 + lb1 + v1 * bcv;
            y0[0] *= bflo(gv[0]); y0[1] *= bfhi(gv[0]); y0[2] *= bflo(gv[1]); y0[3] *= bfhi(gv[1]); y1[0] *= bflo(gv[2]); y1[1] *= bfhi(gv[2]); y1[2] *= bflo(gv[3]); y1[3] *= bfhi(gv[3]);
            v4u w; w.x = cvt_pk_bf16(y0[0], y0[1]); w.y = cvt_pk_bf16(y0[2], y0[3]); w.z = cvt_pk_bf16(y1[0], y1[1]); w.w = cvt_pk_bf16(y1[2], y1[3]);
            *(v4u*)(MIX + (size_t)gr * DM + hc) = w;
        }
    }
}

constexpr int AT_KS = 0, AT_VT = 256 * 72 * 2, AT_PS = AT_VT + 64 * 280 * 2, AT_PSW = 16 * 168 * 2;
__device__ __forceinline__ void attn_phase(const Params& p, unsigned char* lds, int wave, int lane) {
    const bf16* P = (const bf16*)(p.ws + WS_BIG); bf16* MIX = (bf16*)(p.ws + WS_MIX); const float* sinks = inp(19);
    const int tid = TIDX; bf16* Ks = (bf16*)(lds + AT_KS); bf16* Vt = (bf16*)(lds + AT_VT); bf16* Ps = (bf16*)(lds + AT_PS + wave * AT_PSW);
    const int fr = lane & 15, fq = lane >> 4;
    const int vb_ = (blockIdx.x & 7) * (gridDim.x >> 3) + (blockIdx.x >> 3);
    for (int u = vb_ - 128; u >= 0 && u < BATCH * 64 * 2; u += 128) {
        const int g = u & 1, qb = (u >> 1) & 63, b = u >> 7, q0 = qb * 128;
        __syncthreads();
        { const int key = tid >> 1, half = tid & 1; const bool valid = (qb > 0) || (key >= 128);
          const bf16* src = P + (size_t)(b * SEQ + q0 - 128 + key) * NIN + 1792 + 512 + g * 64 + half * 32;
#pragma unroll
          for (int i = 0; i < 4; ++i) { v4u kx = (v4u){0u, 0u, 0u, 0u}, vx = kx; if (valid) { kx = *(const v4u*)(src + 8 * i); vx = *(const v4u*)(src + 128 + 8 * i); }
              *(v4u*)(Ks + key * 72 + half * 32 + 8 * i) = kx;
#pragma unroll
              for (int e = 0; e < 4; ++e) { const int d = half * 32 + 8 * i + 2 * e; Vt[d * 280 + key] = (bf16)(vx[e] & 0xffffu); Vt[(d + 1) * 280 + key] = (bf16)(vx[e] >> 16); } }
          if (tid < 64 * 3) { const int d = tid / 3, part = tid % 3; *(v4u*)(Vt + d * 280 + 256 + 8 * part) = (v4u){0u, 0u, 0u, 0u}; } }
        __syncthreads();
        for (int hq4 = 0; hq4 < 4; ++hq4) {
            const int hq = g * 4 + hq4; const float sink = sinks[hq];
            const bf16* qp = P + (size_t)(b * SEQ + q0 + 16 * wave + fr) * NIN + 1792 + hq * 64 + 8 * fq;
            const bf16x8 qa0 = *(const bf16x8*)qp, qa1 = *(const bf16x8*)(qp + 32);
            f32x4 sc[9]; float mx[4] = {-1e30f, -1e30f, -1e30f, -1e30f};
#pragma unroll
            for (int nt = 0; nt < 9; ++nt) { const int jt = 16 * (wave + nt); const bf16* kp = Ks + (jt + fr) * 72 + 8 * fq;
                const bf16x8 kb0 = *(const bf16x8*)kp, kb1 = *(const bf16x8*)(kp + 32);
                f32x4 a = (f32x4){0.f, 0.f, 0.f, 0.f}; a = __builtin_amdgcn_mfma_f32_16x16x32_bf16(qa0, kb0, a, 0, 0, 0); a = __builtin_amdgcn_mfma_f32_16x16x32_bf16(qa1, kb1, a, 0, 0, 0);
                const int j = jt + fr;
#pragma unroll
                for (int r = 0; r < 4; ++r) { const int i = 16 * wave + 4 * fq + r, dist = i + 128 - j; const bool ok = (dist >= 0) && (dist < 128) && ((qb > 0) || (j >= 128));
                    a[r] = ok ? a[r] * 0.125f : -1e30f; mx[r] = fmaxf(mx[r], a[r]); }
                sc[nt] = a; }
            float sm_[4];
#pragma unroll
            for (int r = 0; r < 4; ++r) { mx[r] = fmaxf(max16(mx[r]), sink); sm_[r] = 0.f; }
#pragma unroll
            for (int nt = 0; nt < 9; ++nt) {
#pragma unroll
                for (int r = 0; r < 4; ++r) { const float e = __expf(sc[nt][r] - mx[r]); sm_[r] += e; Ps[(4 * fq + r) * 168 + nt * 16 + fr] = (bf16)(cvt_pk_bf16(e, 0.f) & 0xffffu); } }
#pragma unroll
            for (int r = 0; r < 4; ++r) { Ps[(4 * fq + r) * 168 + 144 + fr] = 0; sm_[r] = 1.0f / (sum16(sm_[r]) + __expf(sink - mx[r])); }
            __builtin_amdgcn_fence(__ATOMIC_RELEASE, "wavefront"); asm volatile("s_waitcnt lgkmcnt(0)" ::: "memory");
            f32x4 o[4];
#pragma unroll
            for (int dt = 0; dt < 4; ++dt) o[dt] = (f32x4){0.f, 0.f, 0.f, 0.f};
#pragma unroll
            for (int ks = 0; ks < 5; ++ks) { const bf16x8 pa = *(const bf16x8*)(Ps + fr * 168 + ks * 32 + 8 * fq);
#pragma unroll
                for (int dt = 0; dt < 4; ++dt) { const bf16x8 vb = *(const bf16x8*)(Vt + (dt * 16 + fr) * 280 + 16 * wave + ks * 32 + 8 * fq);
                    o[dt] = __builtin_amdgcn_mfma_f32_16x16x32_bf16(pa, vb, o[dt], 0, 0, 0); } }
            bf16* op = MIX + (size_t)(b * SEQ + q0 + 16 * wave + 4 * fq) * DM + 512 + hq * 64 + fr;
#pragma unroll
            for (int r = 0; r < 4; ++r)
#pragma unroll
                for (int dt = 0; dt < 4; ++dt) op[(size_t)r * DM + dt * 16] = (bf16)(cvt_pk_bf16(o[dt][r] * sm_[r], 0.f) & 0xffffu);
            asm volatile("s_waitcnt lgkmcnt(0)" ::: "memory");
        }
    }
}

__device__ __forceinline__ void final_norm(const Params& p, int wave, int lane) {
    const float* ss3 = (const float*)(p.ws + WS_SS) + (size_t)3 * M * 16; const float* gf = inp(25);
    const int gw = blockIdx.x * NWAVES + wave, NGW = gridDim.x * NWAVES;
    f32x4 gfv[4];
#pragma unroll
    for (int j = 0; j < 4; ++j) gfv[j] = ((const f32x4*)gf)[lane + 64 * j];
    for (int m = gw; m < M; m += NGW) { const float rs = pg8::row_rstd(ss3, m); f32x4* xr = (f32x4*)(p.out + (size_t)m * DM) + lane;
#pragma unroll
        for (int j = 0; j < 4; ++j) { const f32x4 v = xr[64 * j]; xr[64 * j] = v * rs * gfv[j]; } }
}


#define XB_TMO      128
#define XB_XCNT(j)  (256  + 64 * (j))
#define XB_XSUB(j)  (1280 + 64 * (j))
#define XB_XGEN(j)  (2304 + 64 * (j))
#define XB_TOP      3328
#define XB_TOPGEN   3392
#define XCD_BAR_WORDS 3456
#define XB_SPIN_CAP (1u << 18)

__device__ __forceinline__ unsigned xb_ld(unsigned* p)              { return __hip_atomic_load(p, __ATOMIC_RELAXED, __HIP_MEMORY_SCOPE_AGENT); }
__device__ __forceinline__ unsigned xb_add(unsigned* p, unsigned v) { return __hip_atomic_fetch_add(p, v, __ATOMIC_RELAXED, __HIP_MEMORY_SCOPE_AGENT); }
__device__ __forceinline__ unsigned xb_xcc_id() { return (unsigned)__builtin_amdgcn_s_getreg((3 << 11) | 20) & 0xFu; }
#define XB_SPIN(cond, bar) do { unsigned _sp = 0; while (cond) { __builtin_amdgcn_s_sleep(1); \
    if ((++_sp & 255u) == 0u) { if (xb_ld(&(bar)[XB_TMO])) break; if (_sp > XB_SPIN_CAP) { atomicAdd(&(bar)[XB_TMO], 1u); break; } } } } while (0)

struct XcdBarrier {
    unsigned* bar; unsigned x;
    volatile LAS unsigned* st; int wave;
};

__device__ __forceinline__ XcdBarrier xcd_barrier_post(unsigned* bar, volatile LAS unsigned* st, int wave) {
    XcdBarrier b; b.bar = bar; b.x = xb_xcc_id(); b.st = st; b.wave = wave;
    if (wave == 0 && lane_id() == 0) (void)xb_add(&bar[XB_XCNT(b.x)], 1u);
    return b;
}
__device__ __forceinline__ void xcd_barrier_complete(unsigned* bar, unsigned x, unsigned& nloc, unsigned& nx) {
    const unsigned G = gridDim.x * gridDim.y * gridDim.z;
    unsigned sum, cnt, mine, sp = 0u;
    for (;;) {
        sum = 0u; cnt = 0u; mine = 0u;
#pragma unroll
        for (unsigned j = 0; j < 16; ++j) { const unsigned c = xb_ld(&bar[XB_XCNT(j)]); sum += c; cnt += (c > 0u) ? 1u : 0u; mine = (j == x) ? c : mine; }
        if (sum == G) break;
        __builtin_amdgcn_s_sleep(1);
        if ((++sp & 255u) == 0u) { if (xb_ld(&bar[XB_TMO])) break; if (sp > XB_SPIN_CAP) { atomicAdd(&bar[XB_TMO], 1u); break; } }
    }
    nloc = mine > 0u ? mine : 1u; nx = cnt > 0u ? cnt : 1u;
}

__device__ __forceinline__ void xcd_barrier(const XcdBarrier& b) {
    asm volatile("s_waitcnt vmcnt(0)" ::: "memory");
    __syncthreads();
    if (b.wave == 0 && lane_id() == 0) {
        unsigned* bar = b.bar;
        __builtin_amdgcn_s_waitcnt(0);
        unsigned nloc = b.st[0], nx = b.st[1];
        if (nloc == 0u) { xcd_barrier_complete(bar, b.x, nloc, nx); b.st[0] = nloc; b.st[1] = nx; }
        const unsigned old = xb_add(&bar[XB_XSUB(b.x)], 1u);
        const unsigned gen = old / nloc;
        if (old + 1u == (gen + 1u) * nloc) {
            __builtin_amdgcn_fence(__ATOMIC_RELEASE, "agent");
            asm volatile("s_waitcnt vmcnt(0)" ::: "memory");
            const unsigned og = xb_add(&bar[XB_TOP], 1u);
            const unsigned tg = og / nx;
            if (og + 1u == (tg + 1u) * nx) xb_add(&bar[XB_TOPGEN], 1u);
            else XB_SPIN(xb_ld(&bar[XB_TOPGEN]) == tg, bar);
            __builtin_amdgcn_fence(__ATOMIC_ACQUIRE, "agent");
            xb_add(&bar[XB_XGEN(b.x)], 1u);
            asm volatile("s_waitcnt vmcnt(0)" ::: "memory");
        } else {
            XB_SPIN(xb_ld(&bar[XB_XGEN(b.x)]) == gen, bar);
            __builtin_amdgcn_fence(__ATOMIC_ACQUIRE, "agent");
            asm volatile("s_waitcnt vmcnt(0)" ::: "memory");
        }
    }
    __syncthreads();
}

constexpr int LDS_BYTES = 147456;
constexpr int NPHASE = 12;
#ifndef DUPMASK
#define DUPMASK 0
#endif
__global__ void __launch_bounds__(NTHR, 2) hymba_fwd(Params p) {
    extern __shared__ __attribute__((aligned(16))) unsigned char lds[];
    cg::grid_group grid = cg::this_grid();
    const int wave = __builtin_amdgcn_readfirstlane((int)threadIdx.x >> 6); const int lane = lane_id(); const int tid = (wave << 6) | lane;
    unsigned char* ws = p.ws;
    PG8_LAS unsigned char* lds3 = (PG8_LAS unsigned char*)lds;
    float* ss = (float*)(ws + WS_SS);
    bf16* XB = (bf16*)(ws + WS_XB); bf16* ACT = (bf16*)(ws + WS_BIG); bf16* PB = (bf16*)(ws + WS_BIG);
    const int lo = p.ph_lo, hi = p.ph_hi;
#define IN(k) (lo <= (k) && (k) < hi)
#define REP(k) for (int rep_ = 0; rep_ < 1 + ((DUPMASK >> (k)) & 1); ++rep_)
#ifndef DUPBAR
#define DUPBAR 0
#endif
#define SEAM(k) do { if (IN(k) && IN((k) + 1)) { for (int rb_ = 0; rb_ <= DUPBAR; ++rb_) xcd_barrier(xbar); } } while (0)
    unsigned* bctr = (unsigned*)(ws + WS_CTL);
    volatile LAS unsigned* misc = (volatile LAS unsigned*)(lds3 + 131072 + 1024);
    if (wave == 0 && lane < 2) misc[lane] = 0u;
    if (blockIdx.x == 0) for (int i = tid; i < XCD_BAR_WORDS; i += NTHR) __hip_atomic_store(bctr + i, 0u, __ATOMIC_RELAXED, __HIP_MEMORY_SCOPE_AGENT);
    if (IN(0)) REP(0) { p0_prologue(p, lds, wave, lane_id()); if (gridDim.x != 256) p0_late_weights(p, lds, wave, lane_id(), blockIdx.x, gridDim.x); }
    grid.sync();
    XcdBarrier xbar = xcd_barrier_post(bctr, misc, wave);
    if (IN(1)) REP(1) { pg8::Gemm g{XB, (const bf16*)(ws + WS_WGU1), M, 2 * FF, DM}; pg8::StaticOrder S; S.init(M, 2 * FF, gridDim.x, blockIdx.x);
        pg8::EpiSwiGLU E{ACT, ss, FF}; pg8::gemm_phase<pg8::EpiSwiGLU, pg8::StaticOrder, true, true>(lds3, g, S, E, wave);
        if (rep_ == 0 && gridDim.x == 256 && blockIdx.x >= 128) p0_late_weights(p, lds, wave, lane_id(), blockIdx.x - 128, 128); } SEAM(1);
    if (IN(2)) REP(2) { pg8::Gemm g{ACT, (const bf16*)(ws + WS_WD1), M, DM, FF}; pg8::StaticOrder S; S.init(M, DM, gridDim.x, blockIdx.x);
        pg8::EpiRes E{inp(0), p.out, XB, ss + (size_t)M * 16, 0.5f}; pg8::gemm_phase<pg8::EpiRes, pg8::StaticOrder, true, true>(lds3, g, S, E, wave); } SEAM(2);
    if (IN(3)) REP(3) { pg8::Gemm g{XB, (const bf16*)(ws + WS_WIN), M, NIN, DM}; pg8::StaticOrder S; S.init(M, NIN, gridDim.x, blockIdx.x);
        pg8::EpiWin E{PB, ss + (size_t)M * 16, inp(7), 1792, NIN}; pg8::gemm_phase<pg8::EpiWin, pg8::StaticOrder, true, true>(lds3, g, S, E, wave); } SEAM(3);
    if (IN(4)) REP(4) { r1_phase(p, wave); } SEAM(4);
    if (IN(5)) REP(5) { pg8::Gemm g{(const bf16*)(ws + WS_LIN), (const bf16*)(ws + WS_WL), M, 1536, 256}; pg8::StaticOrder S; S.init(M, 1536, gridDim.x, blockIdx.x);
        pg8::EpiLora E{(float*)(ws + WS_DEC), (bf16*)(ws + WS_AA), (bf16*)(ws + WS_GG), inp(9), inp(11)}; pg8::gemm_phase<pg8::EpiLora, pg8::StaticOrder, true, true>(lds3, g, S, E, wave); } SEAM(5);
    if (IN(6)) REP(6) { scanL_pass1(p, (float*)lds, wave); } SEAM(6);
    if (IN(7)) REP(7) { scan_pass2(p, (float*)lds, wave); attn_phase(p, lds, wave, lane_id()); } SEAM(7);
    if (IN(8)) REP(8) { scanL_pass3(p, (float*)lds, wave); __syncthreads(); } SEAM(8);
    if (IN(9)) REP(9) { pg8::Gemm g{(const bf16*)(ws + WS_MIX), (const bf16*)(ws + WS_WOUT), M, DM, DM}; pg8::StaticOrder S; S.init(M, DM, gridDim.x, blockIdx.x);
        pg8::EpiRes E{p.out, p.out, XB, ss + (size_t)2 * M * 16, 1.0f}; pg8::gemm_phase<pg8::EpiRes, pg8::StaticOrder, true, true>(lds3, g, S, E, wave); } SEAM(9);
    if (IN(10)) REP(10) { pg8::Gemm g{XB, (const bf16*)(ws + WS_WGU2), M, 2 * FF, DM}; pg8::StaticOrder S; S.init(M, 2 * FF, gridDim.x, blockIdx.x);
        pg8::EpiSwiGLU E{ACT, ss + (size_t)2 * M * 16, FF}; pg8::gemm_phase<pg8::EpiSwiGLU, pg8::StaticOrder, true, true>(lds3, g, S, E, wave); } SEAM(10);
    if (IN(11)) REP(11) { pg8::Gemm g{ACT, (const bf16*)(ws + WS_WD2), M, DM, FF}; pg8::StaticOrder S; S.init(M, DM, gridDim.x, blockIdx.x);
        pg8::EpiRes E{p.out, p.out, nullptr, ss + (size_t)3 * M * 16, 0.5f}; pg8::gemm_phase<pg8::EpiRes, pg8::StaticOrder, true, true>(lds3, g, S, E, wave); } SEAM(11);
    if (IN(12)) REP(12) { final_norm(p, wave, lane_id()); }
#undef IN
#undef SEAM
}

extern "C" void kernel_launch(void* const* d_in, const int* in_sizes, int n_in, void* d_out, int out_size, void* d_ws, size_t ws_size, hipStream_t stream) {
    static int grid = 0;
    if (grid == 0) {
        if (n_in != 26 || out_size != M * DM || ws_size < WS_END) { fprintf(stderr, "kernel_launch: unexpected sizes n_in %d out %d ws %zu\n", n_in, out_size, ws_size); grid = -1; return; }
        int dev = 0, cus = 0, per_cu = 0;
        hipGetDevice(&dev); hipDeviceGetAttribute(&cus, hipDeviceAttributeMultiprocessorCount, dev);
        hipFuncSetAttribute((const void*)hymba_fwd, hipFuncAttributeMaxDynamicSharedMemorySize, LDS_BYTES);
        hipOccupancyMaxActiveBlocksPerMultiprocessor(&per_cu, (const void*)hymba_fwd, NTHR, LDS_BYTES);
        (void)hipGetLastError();
        if (per_cu < 1) per_cu = 1;
        grid = cus * per_cu; if (grid > 256) grid = 256;
        if (grid != 256) fprintf(stderr, "kernel_launch: grid %d (cus %d per_cu %d), kernel assumes 256\n", grid, cus, per_cu);
    }
    if (grid < 0) return;
    Params p{};
    for (int i = 0; i < 26; ++i) p.in[i] = (const float*)d_in[i];
    p.out = (float*)d_out; p.ws = (unsigned char*)d_ws; p.ph_lo = 0; p.ph_hi = NPHASE + 1;
    void* args[] = {&p};
    hipError_t e = hipLaunchCooperativeKernel((const void*)hymba_fwd, dim3(grid), dim3(NTHR), args, LDS_BYTES, stream);
    if (e != hipSuccess) fprintf(stderr, "cooperative launch failed: %s (grid %d)\n", hipGetErrorString(e), grid);
}
```

```cpp
#include <hip/hip_runtime.h>
#include <hip/hip_cooperative_groups.h>
#include <cstdio>
#include <cstdint>
namespace cg = cooperative_groups;
namespace pg8 {
#define PG8_LAS __attribute__((address_space(3)))
typedef unsigned short bf16_t;
typedef short bf16x8 __attribute__((ext_vector_type(8)));
typedef float f32x4 __attribute__((ext_vector_type(4)));
typedef unsigned u32x4 __attribute__((ext_vector_type(4)));
constexpr int BM = 256, BK = 64, HALF = 128, HTB = HALF * BK * 2  , STAGE_BYTES = 8 * HTB, NXCD = 8, WGM = 8;

__host__ __device__ __forceinline__ int lds_byte(int r, int c) { const int st = (r >> 4) * 2 + (c >> 5), rr = r & 15, cc = c & 31, ob = rr * 64 + cc * 2; return st * 1024 + (ob ^ (((ob >> 9) & 1) << 5)); }
__host__ __device__ __forceinline__ void stage_rc(int b, int& R, int& C) { const int st = b / 1024, sb = b % 1024, swz = sb ^ (((sb >> 9) & 1) << 5); R = (st >> 1) * 16 + swz / 64; C = (st & 1) * 32 + (swz % 64) / 2; }
__host__ __device__ __forceinline__ int perm32(int rho) { const int n = rho >> 4, i = rho & 15; return 8 * (i >> 2) + 4 * n + (i & 3); }

struct Unit { int pm, pn; };
struct Gemm { const bf16_t* A; const bf16_t* Bt; int M, N, K; };

struct StaticOrder {
    int nM, nN, nwg, G, c;
    __host__ __device__ void init(int M, int N, int G_, int c_) { nM = M / BM; nN = N / BM; nwg = nM * nN; G = G_; c = c_; }
    __host__ __device__ bool next(int i, Unit& u) const {
        const long L = (long)i * G + c; if (L >= nwg) return false;
        int wgid = (int)L; { const int q = nwg / NXCD, r = nwg % NXCD, xcd = wgid % NXCD, off = wgid / NXCD; wgid = (xcd < r ? xcd * (q + 1) : r * (q + 1) + (xcd - r) * q) + off; }
        const int nig = WGM * nN, gid = wgid / nig, fm = gid * WGM, gsz = (nM - fm) < WGM ? (nM - fm) : WGM;
        u.pm = fm + ((wgid % nig) % gsz); u.pn = (wgid % nig) / gsz; return true;
    }
    __device__ __forceinline__ void a_ready(const Unit&) const {}
    __device__ __forceinline__ void done(const Unit&) const {}
};

typedef float f32x2 __attribute__((ext_vector_type(2)));
typedef __bf16 bf16x2_t __attribute__((ext_vector_type(2)));
typedef unsigned u32x2 __attribute__((ext_vector_type(2)));
__device__ __forceinline__ unsigned cvt_pk_bf16(float lo, float hi) { f32x2 v = {lo, hi}; bf16x2_t b = __builtin_convertvector(v, bf16x2_t); return __builtin_bit_cast(unsigned, b); }
__device__ __forceinline__ float row_rstd(const float* ss, int row) {
    const f32x4* p = (const f32x4*)(ss + (size_t)row * 16); const f32x4 a = p[0], b = p[1], c = p[2], d = p[3];
    const float s = (((a[0] + a[1]) + (a[2] + a[3])) + ((b[0] + b[1]) + (b[2] + b[3]))) + (((c[0] + c[1]) + (c[2] + c[3])) + ((d[0] + d[1]) + (d[2] + d[3])));
    return 1.0f / sqrtf(s * (1.0f / 1024.0f) + 1e-5f);
}
__device__ __forceinline__ float silu_mul(float g, float u) { return g * __builtin_amdgcn_rcpf(1.0f + __expf(-g)) * u; }

struct EpiSwiGLU {
    static constexpr bool PERM = true, AFTER_DRAIN = false;
    bf16_t* O; const float* ss; int ldo;
    __device__ __forceinline__ void operator()(const f32x4 (&acc)[2][2][4][2], const Unit& u, int wr, int wc, int fr, int fq) const {
        const int row0 = u.pm * BM + wr * 64 + fr; const int col0 = u.pn * HALF + wc * 32 + 8 * fq;
#pragma unroll
        for (int ai = 0; ai < 2; ++ai)
#pragma unroll
            for (int m = 0; m < 4; ++m) { const int row = row0 + ai * HALF + m * 16; const float rs = row_rstd(ss, row);
                const f32x4 g0 = acc[ai][0][m][0] * rs, g1 = acc[ai][0][m][1] * rs, u0 = acc[ai][1][m][0] * rs, u1 = acc[ai][1][m][1] * rs;
                u32x4 w; w.x = cvt_pk_bf16(silu_mul(g0[0], u0[0]), silu_mul(g0[1], u0[1])); w.y = cvt_pk_bf16(silu_mul(g0[2], u0[2]), silu_mul(g0[3], u0[3]));
                w.z = cvt_pk_bf16(silu_mul(g1[0], u1[0]), silu_mul(g1[1], u1[1])); w.w = cvt_pk_bf16(silu_mul(g1[2], u1[2]), silu_mul(g1[3], u1[3]));
                *(u32x4*)(O + (size_t)row * ldo + col0) = w; }
    }
};
struct EpiRes {
    static constexpr bool PERM = false, AFTER_DRAIN = false;
    const float* base; float* out; bf16_t* xb; float* ss; float alpha;
    __device__ __forceinline__ void operator()(const f32x4 (&acc)[2][2][4][2], const Unit& u, int wr, int wc, int fr, int fq) const {
        const int row0 = u.pm * BM + wr * 64 + fr; const int col0 = u.pn * BM + wc * 32 + 4 * fq;
#pragma unroll
        for (int ai = 0; ai < 2; ++ai)
#pragma unroll
            for (int m = 0; m < 4; ++m) { const int row = row0 + ai * HALF + m * 16; const size_t off = (size_t)row * 1024 + col0; float sq = 0.f;
#pragma unroll
                for (int bj = 0; bj < 2; ++bj)
#pragma unroll
                    for (int n = 0; n < 2; ++n) { const f32x4 bs = *(const f32x4*)(base + off + bj * HALF + n * 16); const f32x4 o = bs + acc[ai][bj][m][n] * alpha;
                        if (out) *(f32x4*)(out + off + bj * HALF + n * 16) = o; sq += (o[0] * o[0] + o[1] * o[1]) + (o[2] * o[2] + o[3] * o[3]);
                        if (xb) { u32x2 w; w.x = cvt_pk_bf16(o[0], o[1]); w.y = cvt_pk_bf16(o[2], o[3]); *(u32x2*)(xb + off + bj * HALF + n * 16) = w; } }
                sq += __shfl_xor(sq, 16); sq += __shfl_xor(sq, 32);
                if (fq == 0) ss[(size_t)row * 16 + u.pn * 4 + wc] = sq; }
    }
};
struct EpiWin {
    static constexpr bool PERM = true, AFTER_DRAIN = false;
    bf16_t* O; const float* ss; const float* bias; int bias_from; int ldo;
    __device__ __forceinline__ void operator()(const f32x4 (&acc)[2][2][4][2], const Unit& u, int wr, int wc, int fr, int fq) const {
        const int row0 = u.pm * BM + wr * 64 + fr; const int col0 = u.pn * BM + wc * 32 + 8 * fq;
        f32x4 bv[2][2];
#pragma unroll
        for (int bj = 0; bj < 2; ++bj)
#pragma unroll
            for (int n = 0; n < 2; ++n) { const int c = col0 + bj * HALF + 4 * n; bv[bj][n] = (c >= bias_from) ? *(const f32x4*)(bias + (c - bias_from)) : (f32x4){0.f, 0.f, 0.f, 0.f}; }
#pragma unroll
        for (int ai = 0; ai < 2; ++ai)
#pragma unroll
            for (int m = 0; m < 4; ++m) { const int row = row0 + ai * HALF + m * 16; const float rs = row_rstd(ss, row);
#pragma unroll
                for (int bj = 0; bj < 2; ++bj) { const f32x4 v0 = acc[ai][bj][m][0] * rs + bv[bj][0], v1 = acc[ai][bj][m][1] * rs + bv[bj][1];
                    u32x4 w; w.x = cvt_pk_bf16(v0[0], v0[1]); w.y = cvt_pk_bf16(v0[2], v0[3]); w.z = cvt_pk_bf16(v1[0], v1[1]); w.w = cvt_pk_bf16(v1[2], v1[3]);
                    *(u32x4*)(O + (size_t)row * ldo + col0 + bj * HALF) = w; } }
    }
};
struct EpiLora {
    static constexpr bool PERM = true, AFTER_DRAIN = false;
    float* DEC; bf16_t* AA; bf16_t* GG; const float* w0; const float* a0;
    __device__ __forceinline__ void operator()(const f32x4 (&acc)[2][2][4][2], const Unit& u, int wr, int wc, int fr, int fq) const {
        const int row0 = u.pm * BM + wr * 64 + fr; const int kind = u.pn >> 1; const int col0 = (u.pn & 1) * BM + wc * 32 + 8 * fq;
#pragma unroll
        for (int bj = 0; bj < 2; ++bj) { const int c = col0 + bj * HALF;
            f32x4 b0 = (f32x4){0.f, 0.f, 0.f, 0.f}, b1 = b0;
            if (kind == 0) { b0 = *(const f32x4*)(w0 + c); b1 = *(const f32x4*)(w0 + c + 4); } else if (kind == 1) { b0 = *(const f32x4*)(a0 + c); b1 = *(const f32x4*)(a0 + c + 4); }
#pragma unroll
            for (int ai = 0; ai < 2; ++ai)
#pragma unroll
                for (int m = 0; m < 4; ++m) { const int row = row0 + ai * HALF + m * 16; f32x4 v0 = acc[ai][bj][m][0] + b0, v1 = acc[ai][bj][m][1] + b1;
                    if (kind == 0) {
#pragma unroll
                        for (int e = 0; e < 4; ++e) { v0[e] = expf(-0.60653065971f / (1.0f + expf(-v0[e]))); v1[e] = expf(-0.60653065971f / (1.0f + expf(-v1[e]))); }
                        *(f32x4*)(DEC + (size_t)row * 512 + c) = v0; *(f32x4*)(DEC + (size_t)row * 512 + c + 4) = v1;
                    } else {
                        if (kind == 1) {
#pragma unroll
                            for (int e = 0; e < 4; ++e) { v0[e] = 1.0f / (1.0f + expf(-v0[e])); v1[e] = 1.0f / (1.0f + expf(-v1[e])); } }
                        u32x4 w; w.x = cvt_pk_bf16(v0[0], v0[1]); w.y = cvt_pk_bf16(v0[2], v0[3]); w.z = cvt_pk_bf16(v1[0], v1[1]); w.w = cvt_pk_bf16(v1[2], v1[3]);
                        *(u32x4*)((kind == 1 ? AA : GG) + (size_t)row * 512 + c) = w; } }
        }
    }
};

template <class Epi, class Sched, bool ALIGN_EPI = false, bool SP2 = false>
__device__ __forceinline__ void gemm_phase(PG8_LAS unsigned char* lds, const Gemm g, const Sched& S, const Epi& E, const int wid) {
    const int lane = (int)__builtin_amdgcn_mbcnt_hi(~0u, __builtin_amdgcn_mbcnt_lo(~0u, 0u)), tid = (wid << 6) | lane, wr = wid >> 2, wc = wid & 3, fr = lane & 15, fq = lane >> 4;
    int K = g.K; asm volatile("" : "+s"(K)); const int nt = K / BK;
    unsigned voffA[2], voffB[2];
#pragma unroll
    for (int i = 0; i < 2; ++i) { int R, C; stage_rc(tid * 16 + i * 8192, R, C); const int Rb = Epi::PERM ? ((R & ~31) + perm32(R & 31)) : R;
        voffA[i] = (unsigned)(R * K + C) * 2u; voffB[i] = (unsigned)(Rb * K + C) * 2u; }
    const size_t kstep = (size_t)(BK * 2);
    const size_t hstep = (size_t)HALF * K * 2;
    const size_t tstep = 2 * hstep;
    const unsigned ldsw = (unsigned)wid * 1024u;
    const int aoff = lds_byte(wr * 64 + fr, fq * 8), boff = lds_byte(wc * 32 + fr, fq * 8);
#define PG8_SA(b, h) (((b) * 2 + (h)) * HTB)
#define PG8_SB(b, h) ((4 + (b) * 2 + (h)) * HTB)
#define PG8_STAGE(bufoff, gbase, voff) do { _Pragma("unroll") for (int _i = 0; _i < 2; ++_i) \
        __builtin_amdgcn_global_load_lds((const unsigned*)((const char*)(gbase) + (voff)[_i]), (PG8_LAS unsigned*)(lds + (bufoff) + ldsw + _i * 8192), 16, 0, 0); } while (0)
#define PG8_LDA(dst, b, h) do { _Pragma("unroll") for (int m = 0; m < 4; ++m) _Pragma("unroll") for (int k = 0; k < 2; ++k) dst[m][k] = *(const PG8_LAS bf16x8*)(lds + PG8_SA(b, h) + aoff + m * 2048 + k * 1024); } while (0)
#define PG8_LDB(dst, b, h) do { _Pragma("unroll") for (int n = 0; n < 2; ++n) _Pragma("unroll") for (int k = 0; k < 2; ++k) dst[n][k] = *(const PG8_LAS bf16x8*)(lds + PG8_SB(b, h) + boff + n * 2048 + k * 1024); } while (0)
#define PG8_MMA(ai, bj, At, Bt) do { __builtin_amdgcn_s_setprio(1); _Pragma("unroll") for (int m = 0; m < 4; ++m) _Pragma("unroll") for (int n = 0; n < 2; ++n) _Pragma("unroll") for (int k = 0; k < 2; ++k) \
        acc[ai][bj][m][n] = __builtin_amdgcn_mfma_f32_16x16x32_bf16(Bt[n][k], At[m][k], acc[ai][bj][m][n], 0, 0, 0); __builtin_amdgcn_s_setprio(0); } while (0)
#define PG8_WAIT_V(n) asm volatile("s_waitcnt vmcnt(" #n ")" ::: "memory")
#define PG8_WAIT_L(n) asm volatile("s_waitcnt lgkmcnt(" #n ")" ::: "memory")
#define PG8_BAR __builtin_amdgcn_s_barrier()
#define PG8_SCHED __builtin_amdgcn_sched_barrier(0)
    Unit cur, nxt; int ui = 0;
    if (!S.next(0, cur)) return;
    f32x4 acc[2][2][4][2];
#pragma unroll
    for (int a = 0; a < 2; ++a)
#pragma unroll
        for (int b = 0; b < 2; ++b)
#pragma unroll
            for (int m = 0; m < 4; ++m)
#pragma unroll
                for (int n = 0; n < 2; ++n) acc[a][b][m][n] = (f32x4){0.f, 0.f, 0.f, 0.f};
    bf16x8 At[4][2], B0[2][2], B1[2][2];
    const char* cA = (const char*)g.A + (size_t)cur.pm * tstep; const char* cB = (const char*)g.Bt + (size_t)cur.pn * tstep;
    S.a_ready(cur);
    if constexpr (SP2) {
        PG8_STAGE(PG8_SB(0, 0), cB, voffB); PG8_STAGE(PG8_SB(0, 1), cB + hstep, voffB); PG8_STAGE(PG8_SA(0, 0), cA, voffA); PG8_STAGE(PG8_SA(0, 1), cA + hstep, voffA);
        if (wr == 1) PG8_BAR;
        PG8_WAIT_V(2); PG8_BAR;
        PG8_STAGE(PG8_SB(1, 0), cB + kstep, voffB); PG8_STAGE(PG8_SA(1, 0), cA + kstep, voffA); PG8_STAGE(PG8_SB(1, 1), cB + hstep + kstep, voffB);
        PG8_WAIT_V(6); PG8_BAR;
    } else {
        PG8_STAGE(PG8_SB(0, 0), cB, voffB); PG8_STAGE(PG8_SA(0, 0), cA, voffA); PG8_STAGE(PG8_SB(0, 1), cB + hstep, voffB); PG8_STAGE(PG8_SA(0, 1), cA + hstep, voffA);
        if (wr == 1) PG8_BAR;
        PG8_WAIT_V(4); PG8_BAR;
        PG8_STAGE(PG8_SB(1, 0), cB + kstep, voffB); PG8_STAGE(PG8_SA(1, 0), cA + kstep, voffA); PG8_STAGE(PG8_SB(1, 1), cB + hstep + kstep, voffB);
        PG8_WAIT_V(6); PG8_BAR;
    }
    for (;;) {
        const bool has_next = S.next(ui + 1, nxt);
        const char* nA = has_next ? (const char*)g.A + (size_t)nxt.pm * tstep : cA; const char* nB = has_next ? (const char*)g.Bt + (size_t)nxt.pn * tstep : cB;
        for (int t = 0; t < nt; t += 2) {
            const bool last = (t == nt - 2);
            const char* a1 = cA + (size_t)(t + 1) * kstep;
            const char* a2 = last ? nA : cA + (size_t)(t + 2) * kstep; const char* b2 = last ? nB : cB + (size_t)(t + 2) * kstep;
            const char* a3 = a2 + kstep; const char* b3 = b2 + kstep;
            if (last && has_next) S.a_ready(nxt);
            if constexpr (SP2) {
            PG8_LDB(B0, 0, 0); PG8_LDB(B1, 0, 1); PG8_SCHED; PG8_LDA(At, 0, 0); PG8_STAGE(PG8_SA(1, 1), a1 + hstep, voffA);
            PG8_WAIT_V(8); PG8_WAIT_L(0); PG8_BAR; PG8_MMA(0, 0, At, B0); PG8_MMA(0, 1, At, B1); PG8_BAR; PG8_SCHED;
            PG8_LDA(At, 0, 1); PG8_STAGE(PG8_SB(0, 0), b2, voffB); PG8_STAGE(PG8_SB(0, 1), b2 + hstep, voffB); PG8_STAGE(PG8_SA(0, 0), a2, voffA);
            PG8_WAIT_V(8); PG8_WAIT_L(0); PG8_BAR; PG8_MMA(1, 0, At, B0); PG8_MMA(1, 1, At, B1); PG8_BAR; PG8_SCHED;
            PG8_LDB(B0, 1, 0); PG8_LDB(B1, 1, 1); PG8_SCHED; PG8_LDA(At, 1, 0); PG8_STAGE(PG8_SA(0, 1), a2 + hstep, voffA);
            PG8_WAIT_V(8); PG8_WAIT_L(0); PG8_BAR; PG8_MMA(0, 0, At, B0); PG8_MMA(0, 1, At, B1); PG8_BAR; PG8_SCHED;
            PG8_LDA(At, 1, 1); PG8_STAGE(PG8_SB(1, 0), b3, voffB); PG8_STAGE(PG8_SB(1, 1), b3 + hstep, voffB); PG8_STAGE(PG8_SA(1, 0), a3, voffA);
            PG8_WAIT_V(8); PG8_WAIT_L(0); PG8_BAR; PG8_MMA(1, 0, At, B0); PG8_MMA(1, 1, At, B1); PG8_BAR; PG8_SCHED;
            } else {
            PG8_LDB(B0, 0, 0); PG8_SCHED; PG8_LDA(At, 0, 0); PG8_STAGE(PG8_SA(1, 1), a1 + hstep, voffA);
            PG8_WAIT_L(8); PG8_BAR; PG8_WAIT_L(0); PG8_MMA(0, 0, At, B0); PG8_BAR; PG8_SCHED;
            PG8_LDB(B1, 0, 1); PG8_STAGE(PG8_SB(0, 0), b2, voffB);
            PG8_BAR; PG8_WAIT_L(0); PG8_MMA(0, 1, At, B1); PG8_BAR;
            PG8_LDA(At, 0, 1); PG8_STAGE(PG8_SA(0, 0), a2, voffA);
            PG8_BAR; PG8_WAIT_L(0); PG8_MMA(1, 0, At, B0); PG8_BAR; PG8_SCHED;
            PG8_STAGE(PG8_SB(0, 1), b2 + hstep, voffB);
            PG8_WAIT_V(6); PG8_BAR; PG8_MMA(1, 1, At, B1); PG8_BAR;
            PG8_LDB(B0, 1, 0); PG8_SCHED; PG8_LDA(At, 1, 0); PG8_STAGE(PG8_SA(0, 1), a2 + hstep, voffA);
            PG8_WAIT_L(8); PG8_BAR; PG8_WAIT_L(0); PG8_MMA(0, 0, At, B0); PG8_BAR; PG8_SCHED;
            PG8_LDB(B1, 1, 1); PG8_STAGE(PG8_SB(1, 0), b3, voffB);
            PG8_BAR; PG8_WAIT_L(0); PG8_MMA(0, 1, At, B1); PG8_BAR;
            PG8_LDA(At, 1, 1); PG8_STAGE(PG8_SA(1, 0), a3, voffA);
            PG8_BAR; PG8_WAIT_L(0); PG8_MMA(1, 0, At, B0); PG8_BAR; PG8_SCHED;
            PG8_STAGE(PG8_SB(1, 1), b3 + hstep, voffB);
            PG8_WAIT_V(6); PG8_BAR; PG8_MMA(1, 1, At, B1); PG8_BAR;
            }
        }
        if constexpr (ALIGN_EPI) { if (wr == 0) PG8_BAR; }
        if constexpr (!Epi::AFTER_DRAIN) { E(acc, cur, wr, wc, fr, fq); S.done(cur); }
        if (!has_next) break;
#pragma unroll
        for (int a = 0; a < 2; ++a)
#pragma unroll
            for (int b = 0; b < 2; ++b)
#pragma unroll
                for (int m = 0; m < 4; ++m)
#pragma unroll
                    for (int n = 0; n < 2; ++n) acc[a][b][m][n] = (f32x4){0.f, 0.f, 0.f, 0.f};
        cur = nxt; cA = nA; cB = nB; ++ui;
        if constexpr (ALIGN_EPI) { if (wr == 1) PG8_BAR; }
    }
    PG8_WAIT_V(0);
    if constexpr (!ALIGN_EPI) { if (wr == 0) PG8_BAR; }
    PG8_BAR;
    if constexpr (Epi::AFTER_DRAIN) { E.fused(acc, cur, wr, wc, fr, fq, lds, wid, lane); S.done(cur); }
#undef PG8_SA
#undef PG8_SB
#undef PG8_STAGE
#undef PG8_LDA
#undef PG8_LDB
#undef PG8_MMA
#undef PG8_WAIT_V
#undef PG8_WAIT_L
#undef PG8_BAR
#undef PG8_SCHED
}
}

constexpr int BATCH = 2, SEQ = 8192, DM = 1024, FF = 2816, NIN = 2560, RW = 512, M = BATCH * SEQ;
constexpr int NWAVES = 8, NTHR = 512;
constexpr int CH = 128, NCH = SEQ / CH;
constexpr size_t MiB = 1u << 20;
constexpr size_t WS_WGU1 = 0, WS_WD1 = 11 * MiB, WS_WIN = WS_WD1 + 11 * MiB / 2, WS_WOUT = WS_WIN + 5 * MiB, WS_WGU2 = WS_WOUT + 2 * MiB, WS_WD2 = WS_WGU2 + 11 * MiB, WS_WL = 40 * MiB;
constexpr size_t WS_GG = 0;
constexpr size_t WS_XB = 44 * MiB;
constexpr size_t WS_PST = 44 * MiB, WS_LST = 60 * MiB;
constexpr size_t WS_BIG = 76 * MiB;
constexpr size_t WS_LIN = WS_BIG + 80 * MiB;
constexpr size_t WS_DEC = 164 * MiB, WS_AA = 196 * MiB, WS_MIX = 212 * MiB, WS_SS = 244 * MiB, WS_CTL = 248 * MiB, WS_END = 249 * MiB;
static_assert(WS_WD2 + 11 * MiB / 2 <= WS_WL && WS_WL + MiB <= WS_XB, "weights map");

#define LAS __attribute__((address_space(3)))
typedef unsigned short bf16;
typedef unsigned v4u __attribute__((ext_vector_type(4)));
typedef unsigned v2u __attribute__((ext_vector_type(2)));
typedef float f32x4 __attribute__((ext_vector_type(4)));
typedef float f32x2 __attribute__((ext_vector_type(2)));
typedef short bf16x8 __attribute__((ext_vector_type(8)));
using pg8::cvt_pk_bf16;
__device__ __forceinline__ float bflo(unsigned u) { return __uint_as_float(u << 16); }
__device__ __forceinline__ float bfhi(unsigned u) { return __uint_as_float(u & 0xffff0000u); }
template <int CTRL> __device__ __forceinline__ float dpp_mov(float x) { return __builtin_bit_cast(float, __builtin_amdgcn_update_dpp(0, __builtin_bit_cast(int, x), CTRL, 0xF, 0xF, true)); }
__device__ __forceinline__ float sum16(float x) { x += dpp_mov<0xB1>(x); x += dpp_mov<0x4E>(x); x += dpp_mov<0x141>(x); x += dpp_mov<0x140>(x); return x; }
__device__ __forceinline__ float max16(float x) { x = fmaxf(x, dpp_mov<0xB1>(x)); x = fmaxf(x, dpp_mov<0x4E>(x)); x = fmaxf(x, dpp_mov<0x141>(x)); x = fmaxf(x, dpp_mov<0x140>(x)); return x; }
__device__ __forceinline__ float sum8(float x) { x += dpp_mov<0xB1>(x); x += dpp_mov<0x4E>(x); x += dpp_mov<0x141>(x); return x; }
__device__ __forceinline__ float wave_sum(float v) {
#pragma unroll
    for (int o = 1; o < 64; o <<= 1) v += __shfl_xor(v, o);
    return v;
}

__device__ __forceinline__ int lane_id() { return (int)__builtin_amdgcn_mbcnt_hi(~0u, __builtin_amdgcn_mbcnt_lo(~0u, 0u)); }
#define TIDX ((wave << 6) | lane_id())
struct Params {
    const float* in[26]; float* out; unsigned char* ws; int ph_lo, ph_hi;
};


#define GAS __attribute__((address_space(1)))
__device__ __forceinline__ const float* inp(int i) {
    const __attribute__((address_space(4))) char* ka = (const __attribute__((address_space(4))) char*)__builtin_amdgcn_kernarg_segment_ptr();
    int off = i * 8; asm volatile("" : "+s"(off));
    const float* q = *(const float* const __attribute__((address_space(4)))*)(ka + off);
    return (const float*)(const GAS float*)q;
}

__device__ __forceinline__ void conv_item(const float* W, int K, int N, const float* sc, bf16* WT, int k0, int n0, int drow0, float* scr, int lane) {
    float wv[32];
#pragma unroll
    for (int i = 0; i < 32; ++i) wv[i] = W[(size_t)(k0 + 2 * i + (lane >> 5)) * N + n0 + (lane & 31)];
    if (sc) { const float s0 = sc[k0 + lane];
#pragma unroll
        for (int i = 0; i < 32; ++i) wv[i] *= __shfl(s0, 2 * i + (lane >> 5)); }
#pragma unroll
    for (int i = 0; i < 32; ++i) scr[(2 * i + (lane >> 5)) * 33 + (lane & 31)] = wv[i];
    __builtin_amdgcn_fence(__ATOMIC_RELEASE, "wavefront"); asm volatile("s_waitcnt lgkmcnt(0)" ::: "memory");
    const int c = lane & 7;
#pragma unroll
    for (int j = 0; j < 4; ++j) { const int n = (lane >> 3) + 8 * j; const float* s = scr + (8 * c) * 33 + n;
        v4u o; o.x = cvt_pk_bf16(s[0 * 33], s[1 * 33]); o.y = cvt_pk_bf16(s[2 * 33], s[3 * 33]); o.z = cvt_pk_bf16(s[4 * 33], s[5 * 33]); o.w = cvt_pk_bf16(s[6 * 33], s[7 * 33]);
        *(v4u*)(WT + (size_t)(drow0 + n) * K + k0 + 8 * c) = o; }
    asm volatile("s_waitcnt lgkmcnt(0)" ::: "memory");
}
__device__ __forceinline__ void conv_plain(const float* W, int K, int N, const float* sc, bf16* WT, int item, float* scr, int lane) {
    const int nblk = N / 32, kb = item / nblk, nb = item % nblk; conv_item(W, K, N, sc, WT, 64 * kb, 32 * nb, 32 * nb, scr, lane);
}
__device__ __forceinline__ void conv_gu(const float* W, const float* sc, bf16* WT, int item, int up, float* scr, int lane) {
    const int nblk = FF / 32, kb = item / nblk, nb = item % nblk, n0 = 32 * nb; conv_item(W, DM, FF, sc, WT, 64 * kb, n0, (n0 >> 7) * 256 + up * 128 + (n0 & 127), scr, lane);
}
__device__ __forceinline__ void p0_late_weights(const Params& p, unsigned char* lds, int wave, int lane, int bidx, int NB) {
    float* scr = (float*)(lds + wave * 16384);
    unsigned char* ws = p.ws;
    const int gw = bidx * NWAVES + wave, NGW = NB * NWAVES;
    constexpr int I_GU = (DM / 64) * (FF / 32), I_DN = (FF / 64) * (DM / 32), I_IN = (DM / 64) * (NIN / 32), I_OUT = (DM / 64) * (DM / 32);
    constexpr int NITEMS = 2 * I_GU + I_DN + I_IN + I_OUT;
    for (int it = gw; it < NITEMS; it += NGW) {
        int r = it;
        if (r < I_IN) { conv_plain(inp(6), DM, NIN, inp(5), (bf16*)(ws + WS_WIN), r, scr, lane); continue; } r -= I_IN;
        if (r < I_OUT) { conv_plain(inp(20), DM, DM, nullptr, (bf16*)(ws + WS_WOUT), r, scr, lane); continue; } r -= I_OUT;
        if (r < I_GU) { conv_gu(inp(22), inp(21), (bf16*)(ws + WS_WGU2), r, 0, scr, lane); continue; } r -= I_GU;
        if (r < I_GU) { conv_gu(inp(23), inp(21), (bf16*)(ws + WS_WGU2), r, 1, scr, lane); continue; } r -= I_GU;
        conv_plain(inp(24), FF, DM, nullptr, (bf16*)(ws + WS_WD2), r, scr, lane);
    }
}
__device__ __forceinline__ void p0_prologue(const Params& p, unsigned char* lds, int wave, int lane) {
    float* scr = (float*)(lds + wave * 16384);
    unsigned char* ws = p.ws;
    const int gw = blockIdx.x * NWAVES + wave, NGW = gridDim.x * NWAVES;
    constexpr int I_GU = (DM / 64) * (FF / 32), I_DN = (FF / 64) * (DM / 32);
    constexpr int NITEMS = 2 * I_GU + I_DN;
    for (int it = gw; it < NITEMS; it += NGW) {
        int r = it;
        if (r < I_GU) { conv_gu(inp(2), inp(1), (bf16*)(ws + WS_WGU1), r, 0, scr, lane); continue; } r -= I_GU;
        if (r < I_GU) { conv_gu(inp(3), inp(1), (bf16*)(ws + WS_WGU1), r, 1, scr, lane); continue; } r -= I_GU;
        conv_plain(inp(4), FF, DM, nullptr, (bf16*)(ws + WS_WD1), r, scr, lane);
    }
    { bf16* WL = (bf16*)(ws + WS_WL); const float* w2 = inp(10); const float* a2 = inp(12); const float* g2 = inp(13);
      for (int idx = (blockIdx.x * NTHR + TIDX); idx < 1536 * 128; idx += gridDim.x * NTHR) {
          const int n = idx >> 7, k = (idx & 127) * 2; float v0 = 0.f, v1 = 0.f;
          if (n < 512) { if (k < 64) { v0 = w2[k * 512 + n]; v1 = w2[(k + 1) * 512 + n]; } }
          else if (n < 1024) { if (k >= 64 && k < 128) { v0 = a2[(k - 64) * 512 + n - 512]; v1 = a2[(k - 63) * 512 + n - 512]; } }
          else { if (k >= 128) { v0 = g2[(k - 128) * 512 + n - 1024]; v1 = g2[(k - 127) * 512 + n - 1024]; } }
          *(unsigned*)(WL + (size_t)n * 256 + k) = cvt_pk_bf16(v0, v1); } }
    { const float* x = inp(0); bf16* XB = (bf16*)(ws + WS_XB); float* ss0 = (float*)(ws + WS_SS);
      for (int m = gw; m < M; m += NGW) { const f32x4* xr = (const f32x4*)(x + (size_t)m * DM) + lane; float s = 0.f; f32x4 v[4];
#pragma unroll
          for (int j = 0; j < 4; ++j) { v[j] = xr[64 * j]; s += (v[j][0] * v[j][0] + v[j][1] * v[j][1]) + (v[j][2] * v[j][2] + v[j][3] * v[j][3]); }
          s = wave_sum(s);
          v2u* o8 = (v2u*)(XB + (size_t)m * DM) + lane;
#pragma unroll
          for (int j = 0; j < 4; ++j) { v2u w; w.x = cvt_pk_bf16(v[j][0], v[j][1]); w.y = cvt_pk_bf16(v[j][2], v[j][3]); o8[64 * j] = w; }
          if (lane < 16) ss0[(size_t)m * 16 + lane] = (lane == 0) ? s : 0.f; } }
}

__device__ __forceinline__ void r1_phase(const Params& p, int wave) {
    const bf16* P = (const bf16*)(p.ws + WS_BIG); bf16* LIN = (bf16*)(p.ws + WS_LIN); const float* mix = inp(8);
    for (int idx = blockIdx.x * NTHR + TIDX; idx < M * 32; idx += gridDim.x * NTHR) {
        const int row = idx >> 5, g8 = idx & 31, col = 1536 + 8 * g8; const bool hp = (row & (SEQ - 1)) != 0;
        const v4u c = *(const v4u*)(P + (size_t)row * NIN + col); v4u q = (v4u){0u, 0u, 0u, 0u}; if (hp) q = *(const v4u*)(P + (size_t)(row - 1) * NIN + col);
        const f32x4 m0 = *(const f32x4*)(mix + col), m1 = *(const f32x4*)(mix + col + 4);
        float x[8];
#pragma unroll
        for (int e = 0; e < 4; ++e) { const float c0 = bflo(c[e]), c1 = bfhi(c[e]), q0 = bflo(q[e]), q1 = bfhi(q[e]); const float ma = (e < 2) ? m0[2 * e] : m1[2 * e - 4], mb = (e < 2) ? m0[2 * e + 1] : m1[2 * e - 3];
            x[2 * e] = c0 + (q0 - c0) * ma; x[2 * e + 1] = c1 + (q1 - c1) * mb; }
        if (g8 < 8) {
#pragma unroll
            for (int e = 0; e < 8; ++e) x[e] = tanhf(x[e]);
        } else if (g8 >= 16) {
#pragma unroll
            for (int e = 0; e < 8; ++e) x[e] = 1.0f / (1.0f + expf(-x[e]));
        }
        v4u o; o.x = cvt_pk_bf16(x[0], x[1]); o.y = cvt_pk_bf16(x[2], x[3]); o.z = cvt_pk_bf16(x[4], x[5]); o.w = cvt_pk_bf16(x[6], x[7]);
        *(v4u*)(LIN + (size_t)row * 256 + 8 * g8) = o;
    }
}

constexpr int SC_W = 0, SC_B = 1, SC_K = 2, SC_KK = 3, SC_V = 4, SC_R = 5, SC_O = 6, SC_BC = 7;
template <bool P3> __device__ __forceinline__ void scan_load(const Params& p, float* sm, int b, int h, int t0, int wave) {
    const int tid = TIDX, tt = tid >> 3, c8 = (tid & 7) * 8, hc = h * 64 + c8;
    const bf16* P = (const bf16*)(p.ws + WS_BIG); const float* DEC = (const float*)(p.ws + WS_DEC); const bf16* AA = (const bf16*)(p.ws + WS_AA);
    const float* mix = inp(8); const float* k_k = inp(14); const float* k_a = inp(15); const float* r_k = inp(16);
    const int gr = b * SEQ + t0 + tt; const bool hp = (t0 + tt) > 0;
    const bf16* prow = P + (size_t)gr * NIN + hc;
    float r[8], k[8], v[8];
#define SHIFT_LOAD(dst, off) do { const v4u c_ = *(const v4u*)(prow + (off)); v4u q_ = (v4u){0u, 0u, 0u, 0u}; if (hp) q_ = *(const v4u*)(prow + (off) - NIN); \
        const f32x4 m0_ = *(const f32x4*)(mix + hc + (off)), m1_ = *(const f32x4*)(mix + hc + (off) + 4); \
        _Pragma("unroll") for (int e = 0; e < 4; ++e) { const float c0 = bflo(c_[e]), c1 = bfhi(c_[e]), q0 = bflo(q_[e]), q1 = bfhi(q_[e]); const float ma = (e < 2) ? m0_[2 * e] : m1_[2 * e - 4], mb = (e < 2) ? m0_[2 * e + 1] : m1_[2 * e - 3]; \
            dst[2 * e] = c0 + (q0 - c0) * ma; dst[2 * e + 1] = c1 + (q1 - c1) * mb; } } while (0)
    SHIFT_LOAD(k, 512); SHIFT_LOAD(v, 1024);
    if (P3) SHIFT_LOAD(r, 0);
#undef SHIFT_LOAD
    const f32x4 d0 = *(const f32x4*)(DEC + (size_t)gr * RW + hc), d1 = *(const f32x4*)(DEC + (size_t)gr * RW + hc + 4);
    const v4u av = *(const v4u*)(AA + (size_t)gr * RW + hc);
    const f32x4 kk0 = *(const f32x4*)(k_k + hc), kk1 = *(const f32x4*)(k_k + hc + 4), ka0 = *(const f32x4*)(k_a + hc), ka1 = *(const f32x4*)(k_a + hc + 4);
    float a[8], kk[8], kp[8], bb[8]; float ssq = 0.f;
#pragma unroll
    for (int e = 0; e < 4; ++e) { a[2 * e] = bflo(av[e]); a[2 * e + 1] = bfhi(av[e]); }
#pragma unroll
    for (int e = 0; e < 8; ++e) { const float kkw = (e < 4) ? kk0[e] : kk1[e - 4], kaw = (e < 4) ? ka0[e] : ka1[e - 4];
        kk[e] = k[e] * kkw; ssq += kk[e] * kk[e]; kp[e] = k[e] * (1.0f + (a[e] - 1.0f) * kaw); }
    ssq = sum8(ssq);
    const float inv = 1.0f / fmaxf(sqrtf(ssq), 1e-12f);
#pragma unroll
    for (int e = 0; e < 8; ++e) { kk[e] *= inv; bb[e] = kk[e] * a[e]; }
    float* base = sm + tt * 64 + c8;
    *(f32x4*)(base + SC_W * 4096) = d0; *(f32x4*)(base + SC_W * 4096 + 4) = d1;
    *(f32x4*)(base + SC_B * 4096) = (f32x4){bb[0], bb[1], bb[2], bb[3]}; *(f32x4*)(base + SC_B * 4096 + 4) = (f32x4){bb[4], bb[5], bb[6], bb[7]};
    *(f32x4*)(base + SC_K * 4096) = (f32x4){kp[0], kp[1], kp[2], kp[3]}; *(f32x4*)(base + SC_K * 4096 + 4) = (f32x4){kp[4], kp[5], kp[6], kp[7]};
    *(f32x4*)(base + SC_KK * 4096) = (f32x4){kk[0], kk[1], kk[2], kk[3]}; *(f32x4*)(base + SC_KK * 4096 + 4) = (f32x4){kk[4], kk[5], kk[6], kk[7]};
    *(f32x4*)(base + SC_V * 4096) = (f32x4){v[0], v[1], v[2], v[3]}; *(f32x4*)(base + SC_V * 4096 + 4) = (f32x4){v[4], v[5], v[6], v[7]};
    if (P3) {
        *(f32x4*)(base + SC_R * 4096) = (f32x4){r[0], r[1], r[2], r[3]}; *(f32x4*)(base + SC_R * 4096 + 4) = (f32x4){r[4], r[5], r[6], r[7]};
        const f32x4 rk0 = *(const f32x4*)(r_k + hc), rk1 = *(const f32x4*)(r_k + hc + 4); float bc = 0.f;
#pragma unroll
        for (int e = 0; e < 8; ++e) bc += r[e] * kp[e] * ((e < 4) ? rk0[e] : rk1[e - 4]);
        bc = sum8(bc);
        if ((tid & 7) == 0) sm[SC_BC * 4096 + tt] = bc;
    }
}
#define LO2(v) __builtin_shufflevector(v, v, 0, 1)
#define HI2(v) __builtin_shufflevector(v, v, 2, 3)
template <int RPL, bool WITH_O, bool REAL> __device__ __forceinline__ void scan_run(const float* sm, f32x2 (&S)[RPL][2], int cs, int rowbase) {
    typedef float vrow_t __attribute__((ext_vector_type(RPL)));
    const float* st0 = sm + 4 * cs;
    f32x4 w4 = *(const f32x4*)(st0 + SC_W * 4096), b4 = *(const f32x4*)(st0 + SC_B * 4096), kk4 = *(const f32x4*)(st0 + SC_KK * 4096), k4 = w4, r4 = w4;
    if (REAL) k4 = *(const f32x4*)(st0 + SC_K * 4096);
    if (WITH_O) r4 = *(const f32x4*)(st0 + SC_R * 4096);
    vrow_t v4; if (REAL) v4 = *(const vrow_t*)(sm + SC_V * 4096 + rowbase);
#pragma unroll 2
    for (int t = 0; t < 64; ++t) {
        const int tn = (t + 1) & 63;
        const float* st = st0 + tn * 64;
        const f32x4 nw4 = *(const f32x4*)(st + SC_W * 4096), nb4 = *(const f32x4*)(st + SC_B * 4096), nkk4 = *(const f32x4*)(st + SC_KK * 4096);
        f32x4 nk4 = nw4, nr4 = nw4; vrow_t nv4;
        if (REAL) { nk4 = *(const f32x4*)(st + SC_K * 4096); nv4 = *(const vrow_t*)(sm + SC_V * 4096 + tn * 64 + rowbase); }
        if (WITH_O) nr4 = *(const f32x4*)(st + SC_R * 4096);
        const f32x2 w01 = LO2(w4), w23 = HI2(w4), b01 = LO2(b4), b23 = HI2(b4), kk01 = LO2(kk4), kk23 = HI2(kk4), k01 = LO2(k4), k23 = HI2(k4), r01 = LO2(r4), r23 = HI2(r4);
        float oo[RPL];
#pragma unroll
        for (int j = 0; j < RPL; ++j) {
            f32x2 pp = S[j][0] * kk01; pp = S[j][1] * kk23 + pp;
            const float nsa = -sum16(pp[0] + pp[1]);
            const f32x2 nsa2 = (f32x2){nsa, nsa};
            f32x2 t01 = nsa2 * b01, t23 = nsa2 * b23;
            if (REAL) { const f32x2 v2 = (f32x2){v4[j], v4[j]}; t01 = v2 * k01 + t01; t23 = v2 * k23 + t23; }
            S[j][0] = S[j][0] * w01 + t01; S[j][1] = S[j][1] * w23 + t23;
            if (WITH_O) { f32x2 qq = S[j][0] * r01; qq = S[j][1] * r23 + qq; oo[j] = sum16(qq[0] + qq[1]); }
        }
        if (WITH_O) { if (cs == 0) {
#pragma unroll
            for (int j = 0; j < RPL; ++j) ((float*)sm)[SC_O * 4096 + t * 64 + rowbase + j] = oo[j]; } }
        w4 = nw4; b4 = nb4; kk4 = nkk4; k4 = nk4; r4 = nr4; if (REAL) v4 = nv4;
    }
}
__device__ __forceinline__ void scan_pass1(const Params& p, float* sm, int wave, int lane) {
    float* PST = (float*)(p.ws + WS_PST); float* LST = (float*)(p.ws + WS_LST);
    const int cs = lane & 15, rg = lane >> 4; const bool real = wave < 4; const int rowbase = (wave & 3) * 16 + rg * 4;
    constexpr int NU = BATCH * (NCH - 1) * 8;
    for (int u = blockIdx.x; u < NU; u += gridDim.x) {
        const int h = u & 7, bc = u >> 3, c = bc % (NCH - 1), b = bc / (NCH - 1);
        f32x2 S[4][2];
#pragma unroll
        for (int j = 0; j < 4; ++j)
#pragma unroll
            for (int e = 0; e < 4; ++e) S[j][e >> 1][e & 1] = (!real && (rowbase + j == 4 * cs + e)) ? 1.0f : 0.0f;
        for (int sub = 0; sub < 2; ++sub) {
            __syncthreads();
            scan_load<false>(p, sm, b, h, c * CH + sub * 64, wave);
            __syncthreads();
            if (real) scan_run<4, false, true>(sm, S, cs, rowbase); else scan_run<4, false, false>(sm, S, cs, rowbase);
        }
        float* dst = (real ? LST : PST) + ((size_t)((b * NCH + c) * 8 + h)) * 4096 + rowbase * 64 + 4 * cs;
#pragma unroll
        for (int j = 0; j < 4; ++j) *(f32x4*)(dst + j * 64) = (f32x4){S[j][0][0], S[j][0][1], S[j][1][0], S[j][1][1]};
    }
}
__device__ __forceinline__ float rowsum4(float part) {
    const f32x4 z = (f32x4){0.f, 0.f, 0.f, 0.f};
    const f32x4 d = __builtin_amdgcn_mfma_f32_16x16x4f32(1.0f, part, z, 0, 0, 0);
    return d[0];
}
struct ScanRaw { v4u kc, kq, vc, vq, rc, rq, av, gv; f32x4 d0, d1; };
__device__ __forceinline__ void scanL_params(float* parl, int hc, int c8) {
    const float* mix = inp(8); const float* k_k = inp(14); const float* k_a = inp(15); const float* r_k = inp(16); const float* ln_w = inp(17); const float* ln_b = inp(18);
    float* d = parl + c8;
    *(f32x4*)(d) = *(const f32x4*)(mix + hc); *(f32x4*)(d + 4) = *(const f32x4*)(mix + hc + 4);
    *(f32x4*)(d + 64) = *(const f32x4*)(mix + 512 + hc); *(f32x4*)(d + 68) = *(const f32x4*)(mix + 512 + hc + 4);
    *(f32x4*)(d + 128) = *(const f32x4*)(mix + 1024 + hc); *(f32x4*)(d + 132) = *(const f32x4*)(mix + 1024 + hc + 4);
    *(f32x4*)(d + 192) = *(const f32x4*)(k_k + hc); *(f32x4*)(d + 196) = *(const f32x4*)(k_k + hc + 4);
    *(f32x4*)(d + 256) = *(const f32x4*)(k_a + hc); *(f32x4*)(d + 260) = *(const f32x4*)(k_a + hc + 4);
    *(f32x4*)(d + 320) = *(const f32x4*)(r_k + hc); *(f32x4*)(d + 324) = *(const f32x4*)(r_k + hc + 4);
    *(f32x4*)(d + 384) = *(const f32x4*)(ln_w + hc); *(f32x4*)(d + 388) = *(const f32x4*)(ln_w + hc + 4);
    *(f32x4*)(d + 448) = *(const f32x4*)(ln_b + hc); *(f32x4*)(d + 452) = *(const f32x4*)(ln_b + hc + 4);
}
template <bool P3> __device__ __forceinline__ void scanL_issue(const Params& p, ScanRaw& w, int b, int hc, int tok) {
    const bf16* P = (const bf16*)(p.ws + WS_BIG); const float* DEC = (const float*)(p.ws + WS_DEC); const bf16* AA = (const bf16*)(p.ws + WS_AA); const bf16* GG = (const bf16*)(p.ws + WS_GG);
    const int gr = b * SEQ + tok; const bool hp = tok > 0;
    const bf16* prow = P + (size_t)gr * NIN + hc; const v4u z = (v4u){0u, 0u, 0u, 0u};
    w.kc = *(const v4u*)(prow + 512); w.kq = hp ? *(const v4u*)(prow + 512 - NIN) : z;
    w.vc = *(const v4u*)(prow + 1024); w.vq = hp ? *(const v4u*)(prow + 1024 - NIN) : z;
    if (P3) { w.rc = *(const v4u*)(prow); w.rq = hp ? *(const v4u*)(prow - NIN) : z; w.gv = *(const v4u*)(GG + (size_t)gr * RW + hc); }
    w.d0 = *(const f32x4*)(DEC + (size_t)gr * RW + hc); w.d1 = *(const f32x4*)(DEC + (size_t)gr * RW + hc + 4);
    w.av = *(const v4u*)(AA + (size_t)gr * RW + hc);
}
__device__ __forceinline__ void shift8(float (&dst)[8], const v4u& c_, const v4u& q_, const f32x4& m0_, const f32x4& m1_) {
#pragma unroll
    for (int e = 0; e < 4; ++e) { const float c0 = bflo(c_[e]), c1 = bfhi(c_[e]), q0 = bflo(q_[e]), q1 = bfhi(q_[e]); const float ma = (e < 2) ? m0_[2 * e] : m1_[2 * e - 4], mb = (e < 2) ? m0_[2 * e + 1] : m1_[2 * e - 3];
        dst[2 * e] = c0 + (q0 - c0) * ma; dst[2 * e + 1] = c1 + (q1 - c1) * mb; }
}
template <bool P3, int TS> __device__ __forceinline__ void scanL_store(const ScanRaw& w, const float* parl, float* su, float* bcl, int tt, int c8, bool bcw) {
    float r[8], k[8], v[8]; const float* pq = parl + c8;
    shift8(k, w.kc, w.kq, *(const f32x4*)(pq + 64), *(const f32x4*)(pq + 68)); shift8(v, w.vc, w.vq, *(const f32x4*)(pq + 128), *(const f32x4*)(pq + 132));
    if (P3) shift8(r, w.rc, w.rq, *(const f32x4*)(pq), *(const f32x4*)(pq + 4));
    const f32x4 qkk0 = *(const f32x4*)(pq + 192), qkk1 = *(const f32x4*)(pq + 196), qka0 = *(const f32x4*)(pq + 256), qka1 = *(const f32x4*)(pq + 260);
    float a[8], kk[8], kp[8], bb[8]; float ssq = 0.f;
#pragma unroll
    for (int e = 0; e < 4; ++e) { a[2 * e] = bflo(w.av[e]); a[2 * e + 1] = bfhi(w.av[e]); }
#pragma unroll
    for (int e = 0; e < 8; ++e) { const float kkw = (e < 4) ? qkk0[e] : qkk1[e - 4], kaw = (e < 4) ? qka0[e] : qka1[e - 4];
        kk[e] = k[e] * kkw; ssq += kk[e] * kk[e]; kp[e] = k[e] * (1.0f + (a[e] - 1.0f) * kaw); }
    ssq = sum8(ssq);
    const float inv = 1.0f / fmaxf(sqrtf(ssq), 1e-12f);
#pragma unroll
    for (int e = 0; e < 8; ++e) { kk[e] *= inv; bb[e] = kk[e] * a[e]; }
    constexpr int AS = TS * 64;
    float* base = su + tt * 64 + c8;
    *(f32x4*)(base + SC_W * AS) = w.d0; *(f32x4*)(base + SC_W * AS + 4) = w.d1;
    *(f32x4*)(base + SC_B * AS) = (f32x4){bb[0], bb[1], bb[2], bb[3]}; *(f32x4*)(base + SC_B * AS + 4) = (f32x4){bb[4], bb[5], bb[6], bb[7]};
    *(f32x4*)(base + SC_K * AS) = (f32x4){kp[0], kp[1], kp[2], kp[3]}; *(f32x4*)(base + SC_K * AS + 4) = (f32x4){kp[4], kp[5], kp[6], kp[7]};
    *(f32x4*)(base + SC_KK * AS) = (f32x4){kk[0], kk[1], kk[2], kk[3]}; *(f32x4*)(base + SC_KK * AS + 4) = (f32x4){kk[4], kk[5], kk[6], kk[7]};
    *(f32x4*)(base + SC_V * AS) = (f32x4){v[0], v[1], v[2], v[3]}; *(f32x4*)(base + SC_V * AS + 4) = (f32x4){v[4], v[5], v[6], v[7]};
    if (P3) {
        *(f32x4*)(base + SC_R * AS) = (f32x4){r[0], r[1], r[2], r[3]}; *(f32x4*)(base + SC_R * AS + 4) = (f32x4){r[4], r[5], r[6], r[7]};
        const f32x4 qrk0 = *(const f32x4*)(pq + 320), qrk1 = *(const f32x4*)(pq + 324); float bc = 0.f;
#pragma unroll
        for (int e = 0; e < 8; ++e) bc += r[e] * kp[e] * ((e < 4) ? qrk0[e] : qrk1[e - 4]);
        bc = sum8(bc);
        if (bcw) bcl[tt] = bc;
    }
}
#define LD16(dst, ptr) do { const f32x4 x0_ = *(const f32x4*)(ptr), x1_ = *(const f32x4*)((ptr) + 4), x2_ = *(const f32x4*)((ptr) + 8), x3_ = *(const f32x4*)((ptr) + 12); \
        dst[0] = LO2(x0_); dst[1] = HI2(x0_); dst[2] = LO2(x1_); dst[3] = HI2(x1_); dst[4] = LO2(x2_); dst[5] = HI2(x2_); dst[6] = LO2(x3_); dst[7] = HI2(x3_); } while (0)
template <int RPL, bool WITH_O, bool REAL, int TS> __device__ __forceinline__ void scanL_run(float* su, f32x2 (&S)[RPL][8], int r, int g, int rowbase) {
    constexpr int AS = TS * 64;
#pragma unroll 1
    for (int t = 0; t < TS; ++t) {
        const float* st = su + t * 64 + 16 * g;
        f32x2 w2[8], b2[8], kk2[8], k2[8], r2[8];
        LD16(kk2, st + SC_KK * AS); LD16(w2, st + SC_W * AS); LD16(b2, st + SC_B * AS);
        if (REAL) LD16(k2, st + SC_K * AS);
        if (WITH_O) LD16(r2, st + SC_R * AS);
        float vv[RPL];
#pragma unroll
        for (int j = 0; j < RPL; ++j) vv[j] = REAL ? su[SC_V * AS + t * 64 + rowbase + 16 * j + r] : 0.f;
#pragma unroll
        for (int j = 0; j < RPL; ++j) {
            f32x2 p0 = S[j][0] * kk2[0], p1 = S[j][1] * kk2[1];
#pragma unroll
            for (int i = 2; i < 8; i += 2) { p0 = S[j][i] * kk2[i] + p0; p1 = S[j][i + 1] * kk2[i + 1] + p1; }
            p0 += p1;
            const float nsa = -rowsum4(p0[0] + p0[1]);
            const f32x2 nsa2 = (f32x2){nsa, nsa}, v2 = (f32x2){vv[j], vv[j]};
            f32x2 q0 = (f32x2){0.f, 0.f}, q1 = q0;
#pragma unroll
            for (int i = 0; i < 8; ++i) { f32x2 tt_ = nsa2 * b2[i]; if (REAL) tt_ = v2 * k2[i] + tt_; S[j][i] = S[j][i] * w2[i] + tt_;
                if (WITH_O) { if (i & 1) q1 = S[j][i] * r2[i] + q1; else q0 = S[j][i] * r2[i] + q0; } }
            if (WITH_O) { q0 += q1; const float o = rowsum4(q0[0] + q0[1]); if (g == 0) su[SC_O * AS + t * 64 + rowbase + 16 * j + r] = o; }
        }
    }
}
__device__ __forceinline__ void scanL_pass1(const Params& p, float* sm, int wave) {
    constexpr int TS = 32, SLOT = 5 * TS * 64, NPAIR = BATCH * (NCH - 1) * 8 / 2;
    float* PST = (float*)(p.ws + WS_PST); float* LST = (float*)(p.ws + WS_LST);
    const int lane = lane_id(), tid = (wave << 6) | lane, r = lane & 15, g = lane >> 4, u2 = wave >> 2, wq = wave & 3; const bool real = wq < 2; const int rowbase = (wq & 1) * 32;
    float* su = sm + u2 * SLOT;
    const int ltt = (tid >> 3) & 31, lc8 = (tid & 7) * 8;
    for (int up = blockIdx.x; up < NPAIR; up += gridDim.x) {
        const int u = 2 * up + u2, h = u & 7, bc = u >> 3, c = bc % (NCH - 1), b = bc / (NCH - 1);
        f32x2 S[2][8];
#pragma unroll
        for (int j = 0; j < 2; ++j)
#pragma unroll
            for (int i = 0; i < 8; ++i) { const int row = rowbase + 16 * j + r, col = 16 * g + 2 * i; S[j][i] = (f32x2){(!real && row == col) ? 1.f : 0.f, (!real && row == col + 1) ? 1.f : 0.f}; }
        float* parl = sm + 2 * SLOT + u2 * 512;
        __syncthreads();
        if (ltt == 0) scanL_params(parl, h * 64 + lc8, lc8);
        ScanRaw raw; scanL_issue<false>(p, raw, b, h * 64 + lc8, c * CH + ltt);
        for (int sub = 0; sub < CH / TS; ++sub) {
            __syncthreads();
            scanL_store<false, TS>(raw, parl, su, nullptr, ltt, lc8, false);
            __syncthreads();
            if (sub + 1 < CH / TS) scanL_issue<false>(p, raw, b, h * 64 + lc8, c * CH + (sub + 1) * TS + ltt);
            if (real) scanL_run<2, false, true, TS>(su, S, r, g, rowbase); else scanL_run<2, false, false, TS>(su, S, r, g, rowbase);
        }
        float* dst = (real ? LST : PST) + ((size_t)((b * NCH + c) * 8 + h)) * 4096 + 16 * g;
#pragma unroll
        for (int j = 0; j < 2; ++j) { float* d = dst + (rowbase + 16 * j + r) * 64;
#pragma unroll
            for (int i = 0; i < 4; ++i) *(f32x4*)(d + 4 * i) = (f32x4){S[j][2 * i][0], S[j][2 * i][1], S[j][2 * i + 1][0], S[j][2 * i + 1][1]}; }
    }
}
__device__ __forceinline__ void scanL_pass3(const Params& p, float* sm, int wave) {
    constexpr int TS = 16, AS = TS * 64, SLOT = 7 * AS, NQ = BATCH * NCH * 8 / 4;
    const float* LST = (const float*)(p.ws + WS_LST); const bf16* GG = (const bf16*)(p.ws + WS_GG); bf16* MIX = (bf16*)(p.ws + WS_MIX);
    const float* ln_w = inp(17); const float* ln_b = inp(18);
    const int lane = lane_id(), tid = (wave << 6) | lane, r = lane & 15, g = lane >> 4, u4 = wave >> 1, rowbase = (wave & 1) * 32;
    float* su = sm + u4 * SLOT; float* bcl = sm + 4 * SLOT + u4 * TS;
    const int tt = (tid >> 3) & 15, c8 = (tid & 7) * 8;
    for (int uq = blockIdx.x; uq < NQ; uq += gridDim.x) {
        const int u = 4 * uq + u4, h = u & 7, bc = u >> 3, c = bc % NCH, b = bc / NCH, hc = h * 64 + c8;
        f32x2 S[2][8];
#pragma unroll
        for (int j = 0; j < 2; ++j) {
            if (c > 0) { const float* src = LST + ((size_t)((b * NCH + c - 1) * 8 + h)) * 4096 + (rowbase + 16 * j + r) * 64 + 16 * g;
#pragma unroll
                for (int i = 0; i < 4; ++i) { const f32x4 s4 = *(const f32x4*)(src + 4 * i); S[j][2 * i] = LO2(s4); S[j][2 * i + 1] = HI2(s4); } }
            else {
#pragma unroll
                for (int i = 0; i < 8; ++i) S[j][i] = (f32x2){0.f, 0.f}; } }
        float* parl = sm + 4 * SLOT + 64 + u4 * 512;
        __syncthreads();
        if (tt == 0) scanL_params(parl, hc, c8);
        ScanRaw raw; scanL_issue<true>(p, raw, b, hc, c * CH + tt);
        for (int sub = 0; sub < CH / TS; ++sub) {
            __syncthreads();
            scanL_store<true, TS>(raw, parl, su, bcl, tt, c8, (tid & 7) == 0);
            const v4u gv = raw.gv;
            __syncthreads();
            if (sub + 1 < CH / TS) scanL_issue<true>(p, raw, b, hc, c * CH + (sub + 1) * TS + tt);
            scanL_run<2, true, true, TS>(su, S, r, g, rowbase);
            __syncthreads();
            const int gr = b * SEQ + c * CH + sub * TS + tt;
            const f32x4 o0 = *(const f32x4*)(su + SC_O * AS + tt * 64 + c8), o1 = *(const f32x4*)(su + SC_O * AS + tt * 64 + c8 + 4);
            const f32x4 v0 = *(const f32x4*)(su + SC_V * AS + tt * 64 + c8), v1 = *(const f32x4*)(su + SC_V * AS + tt * 64 + c8 + 4);
            const float bcv = bcl[tt];
            float mu = ((o0[0] + o0[1]) + (o0[2] + o0[3])) + ((o1[0] + o1[1]) + (o1[2] + o1[3])); mu = sum8(mu) * (1.0f / 64.0f);
            const f32x4 e0 = o0 - mu, e1 = o1 - mu;
            float var = ((e0[0] * e0[0] + e0[1] * e0[1]) + (e0[2] * e0[2] + e0[3] * e0[3])) + ((e1[0] * e1[0] + e1[1] * e1[1]) + (e1[2] * e1[2] + e1[3] * e1[3])); var = sum8(var) * (1.0f / 64.0f);
            const float rs = 1.0f / sqrtf(var + 64e-5f);
            const f32x4 lw0 = *(const f32x4*)(parl + 384 + c8), lw1 = *(const f32x4*)(parl + 388 + c8), lb0 = *(const f32x4*)(parl + 448 + c8), lb1 = *(const f32x4*)(parl + 452 + c8);
            f32x4 y0 = (e0 * rs) * lw0 + lb0 + v0 * bcv, y1 = (e1 * rs) * lw1 + lb1 + v1 * bcv;
            y0[0] *= bflo(gv[0]); y0[1] *= bfhi(gv[0]); y0[2] *= bflo(gv[1]); y0[3] *= bfhi(gv[1]); y1[0] *= bflo(gv[2]); y1[1] *= bfhi(gv[2]); y1[2] *= bflo(gv[3]); y1[3] *= bfhi(gv[3]);
            v4u w; w.x = cvt_pk_bf16(y0[0], y0[1]); w.y = cvt_pk_bf16(y0[2], y0[3]); w.z = cvt_pk_bf16(y1[0], y1[1]); w.w = cvt_pk_bf16(y1[2], y1[3]);
            *(v4u*)(MIX + (size_t)gr * DM + hc) = w;
        }
    }
}

__device__ __forceinline__ void scan_pass2(const Params& p, float* sm, int wave) {
    const float* PST = (const float*)(p.ws + WS_PST); float* LST = (float*)(p.ws + WS_LST);
    const int lane = lane_id(), tid = (wave << 6) | lane, vb = (blockIdx.x & 7) * (gridDim.x >> 3) + (blockIdx.x >> 3);
    if (vb >= 128) return;
    const int chain = vb >> 3, row = (vb & 7) * 8 + wave, b = chain >> 3, h = chain & 7;
    float* Pb = sm; float* Sw = sm + 8192 + wave * 64;
    constexpr int NS = NCH - 1;
#define UOFF(c) ((size_t)((b * NCH + (c)) * 8 + h) * 4096)
#define LDP(X0, X1, LX, c) do { X0 = *(const f32x4*)(PST + UOFF(c) + tid * 8); X1 = *(const f32x4*)(PST + UOFF(c) + tid * 8 + 4); LX = LST[UOFF(c) + row * 64 + lane]; } while (0)
    f32x4 A0, A1, B0, B1, C0, C1; float LA = 0.f, LB = 0.f, LC = 0.f, Lcur;
    __syncthreads();
    LDP(A0, A1, LA, 0);
    *(f32x4*)(Pb + tid * 8) = A0; *(f32x4*)(Pb + tid * 8 + 4) = A1; Lcur = LA;
    Sw[lane] = 0.f;
    LDP(B0, B1, LB, 1); LDP(C0, C1, LC, 2); LDP(A0, A1, LA, 3);
    __syncthreads();
#define P2STEP(c, X0, X1, LX) do { float Lnx = 0.f; \
        if ((c) + 1 < NS) { float* Pn = Pb + (((c) + 1) & 1) * 4096; *(f32x4*)(Pn + tid * 8) = X0; *(f32x4*)(Pn + tid * 8 + 4) = X1; Lnx = LX; } \
        if ((c) + 4 < NS) LDP(X0, X1, LX, (c) + 4); \
        const float* Pc = Pb + ((c) & 1) * 4096 + lane; float a0 = 0.f, a1 = 0.f, a2 = 0.f, a3 = 0.f; \
        _Pragma("unroll") for (int i = 0; i < 64; i += 4) { const f32x4 s4 = *(const f32x4*)(Sw + i); \
            a0 += s4[0] * Pc[(i + 0) * 64]; a1 += s4[1] * Pc[(i + 1) * 64]; a2 += s4[2] * Pc[(i + 2) * 64]; a3 += s4[3] * Pc[(i + 3) * 64]; } \
        const float sn = ((a0 + a1) + (a2 + a3)) + Lcur; LST[UOFF(c) + row * 64 + lane] = sn; Sw[lane] = sn; Lcur = Lnx; \
        __syncthreads(); } while (0)
    for (int c = 0; c < NS; c += 3) { P2STEP(c, B0, B1, LB); P2STEP(c + 1, C0, C1, LC); P2STEP(c + 2, A0, A1, LA); }
    static_assert(NS % 3 == 0, "pass 2 is unrolled by 3");
#undef P2STEP
#undef LDP
#undef UOFF
}
__device__ __forceinline__ void scan_pass3(const Params& p, float* sm, int wave, int lane) {
    const float* LST = (const float*)(p.ws + WS_LST); const bf16* GG = (const bf16*)(p.ws + WS_GG); bf16* MIX = (bf16*)(p.ws + WS_MIX);
    const float* ln_w = inp(17); const float* ln_b = inp(18);
    const int tid = TIDX, cs = lane & 15, rg = lane >> 4, rowbase = wave * 8 + rg * 2;
    constexpr int NU = BATCH * NCH * 8;
    for (int u = blockIdx.x; u < NU; u += gridDim.x) {
        const int h = u & 7, bc = u >> 3, c = bc % NCH, b = bc / NCH;
        f32x2 S[2][2];
        if (c > 0) { const float* src = LST + ((size_t)((b * NCH + c - 1) * 8 + h)) * 4096 + rowbase * 64 + 4 * cs;
#pragma unroll
            for (int j = 0; j < 2; ++j) { const f32x4 s4 = *(const f32x4*)(src + j * 64); S[j][0] = LO2(s4); S[j][1] = HI2(s4); } }
        else {
#pragma unroll
            for (int j = 0; j < 2; ++j) { S[j][0] = (f32x2){0.f, 0.f}; S[j][1] = (f32x2){0.f, 0.f}; } }
        for (int sub = 0; sub < 2; ++sub) {
            __syncthreads();
            scan_load<true>(p, sm, b, h, c * CH + sub * 64, wave);
            __syncthreads();
            scan_run<2, true, true>(sm, S, cs, rowbase);
            __syncthreads();
            const int tt = tid >> 3, c8 = (tid & 7) * 8, hc = h * 64 + c8; const int gr = b * SEQ + c * CH + sub * 64 + tt;
            const f32x4 o0 = *(const f32x4*)(sm + SC_O * 4096 + tt * 64 + c8), o1 = *(const f32x4*)(sm + SC_O * 4096 + tt * 64 + c8 + 4);
            const f32x4 v0 = *(const f32x4*)(sm + SC_V * 4096 + tt * 64 + c8), v1 = *(const f32x4*)(sm + SC_V * 4096 + tt * 64 + c8 + 4);
            const float bcv = sm[SC_BC * 4096 + tt];
            float mu = ((o0[0] + o0[1]) + (o0[2] + o0[3])) + ((o1[0] + o1[1]) + (o1[2] + o1[3])); mu = sum8(mu) * (1.0f / 64.0f);
            const f32x4 e0 = o0 - mu, e1 = o1 - mu;
            float var = ((e0[0] * e0[0] + e0[1] * e0[1]) + (e0[2] * e0[2] + e0[3] * e0[3])) + ((e1[0] * e1[0] + e1[1] * e1[1]) + (e1[2] * e1[2] + e1[3] * e1[3])); var = sum8(var) * (1.0f / 64.0f);
            const float rs = 1.0f / sqrtf(var + 64e-5f);
            const f32x4 lw0 = *(const f32x4*)(ln_w + hc), lw1 = *(const f32x4*)(ln_w + hc + 4), lb0 = *(const f32x4*)(ln_b + hc), lb1 = *(const f32x4*)(ln_b + hc + 4);
            const v4u gv = *(const v4u*)(GG + (size_t)gr * RW + hc);
            f32x4 y0 = (e0 * rs) * lw0 + lb0 + v0 * bcv, y1 = (e1 * rs) * lw1 + lb1 + v1 * bcv;
            y0[0] *= bflo(gv[0]); y0[1] *= bfhi(gv[0]); y0[2] *= bflo(gv[1]); y0[3] *= bfhi(gv[1]); y1[0] *= bflo(gv[2]); y1[1] *= bfhi(gv[2]); y1[2] *= bflo(gv[3]); y1[3] *= bfhi(gv[3]);
            v4u w; w.x = cvt_pk_bf16(y0[0], y0[1]); w.y = cvt_pk_bf16(y0[2], y0[3]); w.z = cvt_pk_bf16(y1[0], y1[1]); w.w = cvt_pk_bf16(y1[2], y1[3]);
            *(v4u*)(MIX + (size_t)gr * DM + hc) = w;
        }
    }
}

constexpr int AT_KS = 0, AT_VT = 256 * 72 * 2, AT_PS = AT_VT + 64 * 280 * 2, AT_PSW = 16 * 168 * 2;
__device__ __forceinline__ void attn_phase(const Params& p, unsigned char* lds, int wave, int lane) {
    const bf16* P = (const bf16*)(p.ws + WS_BIG); bf16* MIX = (bf16*)(p.ws + WS_MIX); const float* sinks = inp(19);
    const int tid = TIDX; bf16* Ks = (bf16*)(lds + AT_KS); bf16* Vt = (bf16*)(lds + AT_VT); bf16* Ps = (bf16*)(lds + AT_PS + wave * AT_PSW);
    const int fr = lane & 15, fq = lane >> 4;
    const int vb_ = (blockIdx.x & 7) * (gridDim.x >> 3) + (blockIdx.x >> 3);
    for (int u = vb_ - 128; u >= 0 && u < BATCH * 64 * 2; u += 128) {
        const int g = u & 1, qb = (u >> 1) & 63, b = u >> 7, q0 = qb * 128;
        __syncthreads();
        { const int key = tid >> 1, half = tid & 1; const bool valid = (qb > 0) || (key >= 128);
          const bf16* src = P + (size_t)(b * SEQ + q0 - 128 + key) * NIN + 1792 + 512 + g * 64 + half * 32;
#pragma unroll
          for (int i = 0; i < 4; ++i) { v4u kx = (v4u){0u, 0u, 0u, 0u}, vx = kx; if (valid) { kx = *(const v4u*)(src + 8 * i); vx = *(const v4u*)(src + 128 + 8 * i); }
              *(v4u*)(Ks + key * 72 + half * 32 + 8 * i) = kx;
#pragma unroll
              for (int e = 0; e < 4; ++e) { const int d = half * 32 + 8 * i + 2 * e; Vt[d * 280 + key] = (bf16)(vx[e] & 0xffffu); Vt[(d + 1) * 280 + key] = (bf16)(vx[e] >> 16); } }
          if (tid < 64 * 3) { const int d = tid / 3, part = tid % 3; *(v4u*)(Vt + d * 280 + 256 + 8 * part) = (v4u){0u, 0u, 0u, 0u}; } }
        __syncthreads();
        for (int hq4 = 0; hq4 < 4; ++hq4) {
            const int hq = g * 4 + hq4; const float sink = sinks[hq];
            const bf16* qp = P + (size_t)(b * SEQ + q0 + 16 * wave + fr) * NIN + 1792 + hq * 64 + 8 * fq;
            const bf16x8 qa0 = *(const bf16x8*)qp, qa1 = *(const bf16x8*)(qp + 32);
            f32x4 sc[9]; float mx[4] = {-1e30f, -1e30f, -1e30f, -1e30f};
#pragma unroll
            for (int nt = 0; nt < 9; ++nt) { const int jt = 16 * (wave + nt); const bf16* kp = Ks + (jt + fr) * 72 + 8 * fq;
                const bf16x8 kb0 = *(const bf16x8*)kp, kb1 = *(const bf16x8*)(kp + 32);
                f32x4 a = (f32x4){0.f, 0.f, 0.f, 0.f}; a = __builtin_amdgcn_mfma_f32_16x16x32_bf16(qa0, kb0, a, 0, 0, 0); a = __builtin_amdgcn_mfma_f32_16x16x32_bf16(qa1, kb1, a, 0, 0, 0);
                const int j = jt + fr;
#pragma unroll
                for (int r = 0; r < 4; ++r) { const int i = 16 * wave + 4 * fq + r, dist = i + 128 - j; const bool ok = (dist >= 0) && (dist < 128) && ((qb > 0) || (j >= 128));
                    a[r] = ok ? a[r] * 0.125f : -1e30f; mx[r] = fmaxf(mx[r], a[r]); }
                sc[nt] = a; }
            float sm_[4];
#pragma unroll
            for (int r = 0; r < 4; ++r) { mx[r] = fmaxf(max16(mx[r]), sink); sm_[r] = 0.f; }
#pragma unroll
            for (int nt = 0; nt < 9; ++nt) {
#pragma unroll
                for (int r = 0; r < 4; ++r) { const float e = __expf(sc[nt][r] - mx[r]); sm_[r] += e; Ps[(4 * fq + r) * 168 + nt * 16 + fr] = (bf16)(cvt_pk_bf16(e, 0.f) & 0xffffu); } }
#pragma unroll
            for (int r = 0; r < 4; ++r) { Ps[(4 * fq + r) * 168 + 144 + fr] = 0; sm_[r] = 1.0f / (sum16(sm_[r]) + __expf(sink - mx[r])); }
            __builtin_amdgcn_fence(__ATOMIC_RELEASE, "wavefront"); asm volatile("s_waitcnt lgkmcnt(0)" ::: "memory");
            f32x4 o[4];
#pragma unroll
            for (int dt = 0; dt < 4; ++dt) o[dt] = (f32x4){0.f, 0.f, 0.f, 0.f};
#pragma unroll
            for (int ks = 0; ks < 5; ++ks) { const bf16x8 pa = *(const bf16x8*)(Ps + fr * 168 + ks * 32 + 8 * fq);
#pragma unroll
                for (int dt = 0; dt < 4; ++dt) { const bf16x8 vb = *(const bf16x8*)(Vt + (dt * 16 + fr) * 280 + 16 * wave + ks * 32 + 8 * fq);
                    o[dt] = __builtin_amdgcn_mfma_f32_16x16x32_bf16(pa, vb, o[dt], 0, 0, 0); } }
            bf16* op = MIX + (size_t)(b * SEQ + q0 + 16 * wave + 4 * fq) * DM + 512 + hq * 64 + fr;
#pragma unroll
            for (int r = 0; r < 4; ++r)
#pragma unroll
                for (int dt = 0; dt < 4; ++dt) op[(size_t)r * DM + dt * 16] = (bf16)(cvt_pk_bf16(o[dt][r] * sm_[r], 0.f) & 0xffffu);
            asm volatile("s_waitcnt lgkmcnt(0)" ::: "memory");
        }
    }
}

__device__ __forceinline__ void final_norm(const Params& p, int wave, int lane) {
    const float* ss3 = (const float*)(p.ws + WS_SS) + (size_t)3 * M * 16; const float* gf = inp(25); const bf16* XB = (const bf16*)(p.ws + WS_XB);
    const int gw = blockIdx.x * NWAVES + wave, NGW = gridDim.x * NWAVES;
    f32x4 gfv[4];
#pragma unroll
    for (int j = 0; j < 4; ++j) gfv[j] = ((const f32x4*)gf)[lane + 64 * j];
    for (int m = gw; m < M; m += NGW) { const float rs = pg8::row_rstd(ss3, m); f32x4* xr = (f32x4*)(p.out + (size_t)m * DM) + lane; const v2u* xb = (const v2u*)(XB + (size_t)m * DM) + lane;
#pragma unroll
        for (int j = 0; j < 4; ++j) { const v2u w = xb[64 * j]; const f32x4 v = (f32x4){bflo(w.x), bfhi(w.x), bflo(w.y), bfhi(w.y)}; xr[64 * j] = v * rs * gfv[j]; } }
}

#define XB_TMO      128
#define XB_XCNT(j)  (256  + 64 * (j))
#define XB_XSUB(j)  (1280 + 64 * (j))
#define XB_XGEN(j)  (2304 + 64 * (j))
#define XB_TOP      3328
#define XB_TOPGEN   3392
#define XCD_BAR_WORDS 3456
#define XB_SPIN_CAP (1u << 18)

__device__ __forceinline__ unsigned xb_ld(unsigned* p)              { return __hip_atomic_load(p, __ATOMIC_RELAXED, __HIP_MEMORY_SCOPE_AGENT); }
__device__ __forceinline__ unsigned xb_add(unsigned* p, unsigned v) { return __hip_atomic_fetch_add(p, v, __ATOMIC_RELAXED, __HIP_MEMORY_SCOPE_AGENT); }
__device__ __forceinline__ unsigned xb_xcc_id() { return (unsigned)__builtin_amdgcn_s_getreg((3 << 11) | 20) & 0xFu; }
#define XB_SPIN(cond, bar) do { unsigned _sp = 0; while (cond) { __builtin_amdgcn_s_sleep(1); \
    if ((++_sp & 255u) == 0u) { if (xb_ld(&(bar)[XB_TMO])) break; if (_sp > XB_SPIN_CAP) { atomicAdd(&(bar)[XB_TMO], 1u); break; } } } } while (0)

struct XcdBarrier {
    unsigned* bar; unsigned x;
    volatile LAS unsigned* st; int wave;
};

__device__ __forceinline__ XcdBarrier xcd_barrier_post(unsigned* bar, volatile LAS unsigned* st, int wave) {
    XcdBarrier b; b.bar = bar; b.x = xb_xcc_id(); b.st = st; b.wave = wave;
    if (wave == 0 && lane_id() == 0) (void)xb_add(&bar[XB_XCNT(b.x)], 1u);
    return b;
}
__device__ __forceinline__ void xcd_barrier_complete(unsigned* bar, unsigned x, unsigned& nloc, unsigned& nx) {
    const unsigned G = gridDim.x * gridDim.y * gridDim.z;
    unsigned sum, cnt, mine, sp = 0u;
    for (;;) {
        sum = 0u; cnt = 0u; mine = 0u;
#pragma unroll
        for (unsigned j = 0; j < 16; ++j) { const unsigned c = xb_ld(&bar[XB_XCNT(j)]); sum += c; cnt += (c > 0u) ? 1u : 0u; mine = (j == x) ? c : mine; }
        if (sum == G) break;
        __builtin_amdgcn_s_sleep(1);
        if ((++sp & 255u) == 0u) { if (xb_ld(&bar[XB_TMO])) break; if (sp > XB_SPIN_CAP) { atomicAdd(&bar[XB_TMO], 1u); break; } }
    }
    nloc = mine > 0u ? mine : 1u; nx = cnt > 0u ? cnt : 1u;
}

__device__ __forceinline__ void xcd_barrier(const XcdBarrier& b) {
    asm volatile("s_waitcnt vmcnt(0)" ::: "memory");
    __syncthreads();
    if (b.wave == 0 && lane_id() == 0) {
        unsigned* bar = b.bar;
        __builtin_amdgcn_s_waitcnt(0);
        unsigned nloc = b.st[0], nx = b.st[1];
        if (nloc == 0u) { xcd_barrier_complete(bar, b.x, nloc, nx); b.st[0] = nloc; b.st[1] = nx; }
        const unsigned old = xb_add(&bar[XB_XSUB(b.x)], 1u);
        const unsigned gen = old / nloc;
        if (old + 1u == (gen + 1u) * nloc) {
            __builtin_amdgcn_fence(__ATOMIC_RELEASE, "agent");
            asm volatile("s_waitcnt vmcnt(0)" ::: "memory");
            const unsigned og = xb_add(&bar[XB_TOP], 1u);
            const unsigned tg = og / nx;
            if (og + 1u == (tg + 1u) * nx) xb_add(&bar[XB_TOPGEN], 1u);
            else XB_SPIN(xb_ld(&bar[XB_TOPGEN]) == tg, bar);
            __builtin_amdgcn_fence(__ATOMIC_ACQUIRE, "agent");
            xb_add(&bar[XB_XGEN(b.x)], 1u);
            asm volatile("s_waitcnt vmcnt(0)" ::: "memory");
        } else {
            XB_SPIN(xb_ld(&bar[XB_XGEN(b.x)]) == gen, bar);
            __builtin_amdgcn_fence(__ATOMIC_ACQUIRE, "agent");
            asm volatile("s_waitcnt vmcnt(0)" ::: "memory");
        }
    }
    __syncthreads();
}

constexpr int LDS_BYTES = 147456;
constexpr int NPHASE = 12;
#ifndef DUPMASK
#define DUPMASK 0
#endif
__global__ void __launch_bounds__(NTHR, 2) hymba_fwd(Params p) {
    extern __shared__ __attribute__((aligned(16))) unsigned char lds[];
    cg::grid_group grid = cg::this_grid();
    const int wave = __builtin_amdgcn_readfirstlane((int)threadIdx.x >> 6); const int lane = lane_id(); const int tid = (wave << 6) | lane;
    unsigned char* ws = p.ws;
    PG8_LAS unsigned char* lds3 = (PG8_LAS unsigned char*)lds;
    float* ss = (float*)(ws + WS_SS);
    bf16* XB = (bf16*)(ws + WS_XB); bf16* ACT = (bf16*)(ws + WS_BIG); bf16* PB = (bf16*)(ws + WS_BIG);
    const int lo = p.ph_lo, hi = p.ph_hi;
#define IN(k) (lo <= (k) && (k) < hi)
#define REP(k) for (int rep_ = 0; rep_ < 1 + ((DUPMASK >> (k)) & 1); ++rep_)
#ifndef DUPBAR
#define DUPBAR 0
#endif
#define SEAM(k) do { if (IN(k) && IN((k) + 1)) { for (int rb_ = 0; rb_ <= DUPBAR; ++rb_) xcd_barrier(xbar); } } while (0)
    unsigned* bctr = (unsigned*)(ws + WS_CTL);
    volatile LAS unsigned* misc = (volatile LAS unsigned*)(lds3 + 131072 + 1024);
    if (wave == 0 && lane < 2) misc[lane] = 0u;
    if (blockIdx.x == 0) for (int i = tid; i < XCD_BAR_WORDS; i += NTHR) __hip_atomic_store(bctr + i, 0u, __ATOMIC_RELAXED, __HIP_MEMORY_SCOPE_AGENT);
    if (IN(0)) REP(0) { p0_prologue(p, lds, wave, lane_id()); if (gridDim.x != 256) p0_late_weights(p, lds, wave, lane_id(), blockIdx.x, gridDim.x); }
    grid.sync();
    XcdBarrier xbar = xcd_barrier_post(bctr, misc, wave);
    if (IN(1)) REP(1) { pg8::Gemm g{XB, (const bf16*)(ws + WS_WGU1), M, 2 * FF, DM}; pg8::StaticOrder S; S.init(M, 2 * FF, gridDim.x, blockIdx.x);
        pg8::EpiSwiGLU E{ACT, ss, FF}; pg8::gemm_phase<pg8::EpiSwiGLU, pg8::StaticOrder, true, true>(lds3, g, S, E, wave);
        if (rep_ == 0 && gridDim.x == 256 && blockIdx.x >= 128) p0_late_weights(p, lds, wave, lane_id(), blockIdx.x - 128, 128); } SEAM(1);
    if (IN(2)) REP(2) { pg8::Gemm g{ACT, (const bf16*)(ws + WS_WD1), M, DM, FF}; pg8::StaticOrder S; S.init(M, DM, gridDim.x, blockIdx.x);
        pg8::EpiRes E{inp(0), p.out, XB, ss + (size_t)M * 16, 0.5f}; pg8::gemm_phase<pg8::EpiRes, pg8::StaticOrder, true, true>(lds3, g, S, E, wave); } SEAM(2);
    if (IN(3)) REP(3) { pg8::Gemm g{XB, (const bf16*)(ws + WS_WIN), M, NIN, DM}; pg8::StaticOrder S; S.init(M, NIN, gridDim.x, blockIdx.x);
        pg8::EpiWin E{PB, ss + (size_t)M * 16, inp(7), 1792, NIN}; pg8::gemm_phase<pg8::EpiWin, pg8::StaticOrder, true, true>(lds3, g, S, E, wave); } SEAM(3);
    if (IN(4)) REP(4) { r1_phase(p, wave); } SEAM(4);
    if (IN(5)) REP(5) { pg8::Gemm g{(const bf16*)(ws + WS_LIN), (const bf16*)(ws + WS_WL), M, 1536, 256}; pg8::StaticOrder S; S.init(M, 1536, gridDim.x, blockIdx.x);
        pg8::EpiLora E{(float*)(ws + WS_DEC), (bf16*)(ws + WS_AA), (bf16*)(ws + WS_GG), inp(9), inp(11)}; pg8::gemm_phase<pg8::EpiLora, pg8::StaticOrder, true, true>(lds3, g, S, E, wave); } SEAM(5);
    if (IN(6)) REP(6) { scanL_pass1(p, (float*)lds, wave); } SEAM(6);
    if (IN(7)) REP(7) { scan_pass2(p, (float*)lds, wave); attn_phase(p, lds, wave, lane_id()); } SEAM(7);
    if (IN(8)) REP(8) { scanL_pass3(p, (float*)lds, wave); __syncthreads(); } SEAM(8);
    if (IN(9)) REP(9) { pg8::Gemm g{(const bf16*)(ws + WS_MIX), (const bf16*)(ws + WS_WOUT), M, DM, DM}; pg8::StaticOrder S; S.init(M, DM, gridDim.x, blockIdx.x);
        pg8::EpiRes E{p.out, p.out, XB, ss + (size_t)2 * M * 16, 1.0f}; pg8::gemm_phase<pg8::EpiRes, pg8::StaticOrder, true, true>(lds3, g, S, E, wave); } SEAM(9);
    if (IN(10)) REP(10) { pg8::Gemm g{XB, (const bf16*)(ws + WS_WGU2), M, 2 * FF, DM}; pg8::StaticOrder S; S.init(M, 2 * FF, gridDim.x, blockIdx.x);
        pg8::EpiSwiGLU E{ACT, ss + (size_t)2 * M * 16, FF}; pg8::gemm_phase<pg8::EpiSwiGLU, pg8::StaticOrder, true, true>(lds3, g, S, E, wave); } SEAM(10);
    if (IN(11)) REP(11) { pg8::Gemm g{ACT, (const bf16*)(ws + WS_WD2), M, DM, FF}; pg8::StaticOrder S; S.init(M, DM, gridDim.x, blockIdx.x);
        pg8::EpiRes E{p.out, nullptr, XB, ss + (size_t)3 * M * 16, 0.5f};   pg8::gemm_phase<pg8::EpiRes, pg8::StaticOrder, true, true>(lds3, g, S, E, wave); } SEAM(11);
    if (IN(12)) REP(12) { final_norm(p, wave, lane_id()); }
#undef IN
#undef SEAM
}

extern "C" void kernel_launch(void* const* d_in, const int* in_sizes, int n_in, void* d_out, int out_size, void* d_ws, size_t ws_size, hipStream_t stream) {
    static int grid = 0;
    if (grid == 0) {
        if (n_in != 26 || out_size != M * DM || ws_size < WS_END) { fprintf(stderr, "kernel_launch: unexpected sizes n_in %d out %d ws %zu\n", n_in, out_size, ws_size); grid = -1; return; }
        int dev = 0, cus = 0, per_cu = 0;
        hipGetDevice(&dev); hipDeviceGetAttribute(&cus, hipDeviceAttributeMultiprocessorCount, dev);
        hipFuncSetAttribute((const void*)hymba_fwd, hipFuncAttributeMaxDynamicSharedMemorySize, LDS_BYTES);
        hipOccupancyMaxActiveBlocksPerMultiprocessor(&per_cu, (const void*)hymba_fwd, NTHR, LDS_BYTES);
        (void)hipGetLastError();
        if (per_cu < 1) per_cu = 1;
        grid = cus * per_cu; if (grid > 256) grid = 256;
        if (grid != 256) fprintf(stderr, "kernel_launch: grid %d (cus %d per_cu %d), kernel assumes 256\n", grid, cus, per_cu);
    }
    if (grid < 0) return;
    Params p{};
    for (int i = 0; i < 26; ++i) p.in[i] = (const float*)d_in[i];
    p.out = (float*)d_out; p.ws = (unsigned char*)d_ws; p.ph_lo = 0; p.ph_hi = NPHASE + 1;
    void* args[] = {&p};
    hipError_t e = hipLaunchCooperativeKernel((const void*)hymba_fwd, dim3(grid), dim3(NTHR), args, LDS_BYTES, stream);
    if (e != hipSuccess) fprintf(stderr, "cooperative launch failed: %s (grid %d)\n", hipGetErrorString(e), grid);
}
```
